# Optimizing an MI355X kernel written in HIP

```python
import math
import jax, jax.numpy as jnp
from jax import lax
import numpy as np

D_MODEL = 1024
BATCH = 2
SEQ = 16384
DEPTH = 4

CHUNK = 64
Q_BLOCK = 128
A_WIDTH = D_MODEL // 2
A_HEADS = 4
A_DK = A_WIDTH // A_HEADS
A_DV = A_WIDTH // A_HEADS
B_WIDTH = D_MODEL - A_WIDTH
B_HEADS = 4
B_HEAD_DIM = B_WIDTH // (2 * B_HEADS)
EVEN_IN = 4 * A_WIDTH + 3 * B_WIDTH
C_HEADS = 16
C_HEAD_DIM = D_MODEL // C_HEADS
ODD_IN = 4 * D_MODEL + C_HEADS
D_FF = -(-8 * D_MODEL // (3 * 256)) * 256
N_EVEN = (DEPTH + 1) // 2
N_ODD = DEPTH // 2
ALPHA = (2 * DEPTH) ** 0.25
BETA = (8 * DEPTH) ** -0.25
MASK_VALUE = -1e30

kernel_name = "hybrid_hgrn2_diffattn_fox_deepnorm"

F32 = jnp.float32


def _layer_norm(x, g, b, eps=1e-5):
    xf = x.astype(F32)
    mu = jnp.mean(xf, axis=-1, keepdims=True)
    var = jnp.mean(jnp.square(xf - mu), axis=-1, keepdims=True)
    return ((xf - mu) * lax.rsqrt(var + eps) * g.astype(F32) + b.astype(F32)).astype(x.dtype)


def _rms_norm(x, g, eps=1e-6):
    xf = x.astype(F32)
    return xf * lax.rsqrt(jnp.mean(xf * xf, axis=-1, keepdims=True) + eps) * g.astype(F32)


def _swiglu(x, w1, w2):
    gate, up = jnp.split(x @ w1, 2, axis=-1)
    return (jax.nn.silu(gate) * up) @ w2


def _hgrn2(q_raw, f_raw, i, lb):
    Bsz, S = q_raw.shape[:2]
    nc = S // CHUNK
    lbh = lb.reshape(A_HEADS, A_DK).astype(F32)
    z = f_raw.astype(F32)
    q = jax.nn.silu(q_raw.astype(F32))
    f = lbh + (1.0 - lbh) * jax.nn.sigmoid(z)
    k = 1.0 - f
    logf = jnp.log(f)

    def to_chunks(t):
        return t.reshape(Bsz, nc, CHUNK, A_HEADS, -1).transpose(1, 0, 3, 2, 4)

    qc, kc, ic, lc = to_chunks(q), to_chunks(k), to_chunks(i.astype(F32)), to_chunks(logf)
    causal = jnp.tril(jnp.ones((CHUNK, CHUNK), bool))[:, :, None]

    def step(state, inp):
        qt, kt, it, lt = inp
        b = jnp.cumsum(lt, axis=2)
        o_inter = jnp.einsum('bhtk,bhkv->bhtv', qt * jnp.exp(b), state)
        rel = b[:, :, :, None, :] - b[:, :, None, :, :]
        decay = jnp.where(causal, jnp.exp(jnp.minimum(rel, 0.0)), 0.0)
        scores = jnp.einsum('bhtk,bhsk,bhtsk->bhts', qt, kt, decay)
        o_intra = jnp.einsum('bhts,bhsv->bhtv', scores, it)
        b_last = b[:, :, -1, :]
        state = jnp.exp(b_last)[..., None] * state + jnp.einsum(
            'bhsk,bhsv->bhkv', kt * jnp.exp(b_last[:, :, None, :] - b), it)
        return state, o_inter + o_intra

    s0 = jnp.zeros((Bsz, A_HEADS, A_DK, A_DV), F32)
    _, o = lax.scan(step, s0, (qc, kc, ic, lc))
    return o.transpose(1, 0, 3, 2, 4).reshape(Bsz, S, A_HEADS, A_DV)


def _diff_attention(q, k, v, lam):
    Bsz, H, _, S, d = q.shape
    scale = d ** -0.5
    k_chunk = jnp.arange(S) // CHUNK

    def block(bi):
        start = bi * Q_BLOCK
        qb = lax.dynamic_slice_in_dim(q, start, Q_BLOCK, axis=3)
        s = jnp.einsum('bhcqd,bhckd->bhcqk', qb, k) * scale
        q_chunk = (start + jnp.arange(Q_BLOCK)) // CHUNK
        mask = k_chunk[None, :] <= q_chunk[:, None]
        p = jax.nn.softmax(jnp.where(mask, s, MASK_VALUE), axis=-1)
        attn = p[:, :, 0] - lam * p[:, :, 1]
        return jnp.einsum('bhqk,bhkv->bhqv', attn, v)

    o = lax.map(block, jnp.arange(S // Q_BLOCK))
    return o.transpose(1, 0, 3, 2, 4).reshape(Bsz, S, H, -1)


def _fox_attention(q, k, v, c):
    Bsz, H, S, d = q.shape
    scale = d ** -0.5
    k_pos = jnp.arange(S)

    def block(bi):
        start = bi * Q_BLOCK
        qb = lax.dynamic_slice_in_dim(q, start, Q_BLOCK, axis=2)
        cb = lax.dynamic_slice_in_dim(c, start, Q_BLOCK, axis=2)
        s = jnp.einsum('bhqd,bhkd->bhqk', qb, k) * scale + (cb[..., :, None] - c[..., None, :])
        q_pos = start + jnp.arange(Q_BLOCK)
        mask = k_pos[None, :] <= q_pos[:, None]
        p = jax.nn.softmax(jnp.where(mask, s, MASK_VALUE), axis=-1)
        return jnp.einsum('bhqk,bhkd->bhqd', p, v)

    o = lax.map(block, jnp.arange(S // Q_BLOCK))
    return o.transpose(1, 0, 3, 2, 4).reshape(Bsz, S, H, d)


def _even_mixer(x, w_in, w_out, lb, lq1, lk1, lq2, lk2, hgrn_g, diff_g, layer_idx):
    Bsz, S, _ = x.shape
    proj = x @ w_in
    cuts = [A_WIDTH, 2 * A_WIDTH, 3 * A_WIDTH, 4 * A_WIDTH,
            4 * A_WIDTH + B_WIDTH, 4 * A_WIDTH + 2 * B_WIDTH]
    a_q, a_f, a_i, a_g, b_q, b_k, b_v = jnp.split(proj, cuts, axis=-1)
    heads_a = lambda t: t.reshape(Bsz, S, A_HEADS, -1)
    o_a = _hgrn2(heads_a(a_q), heads_a(a_f), heads_a(a_i), lb)
    o_a = _rms_norm(o_a, hgrn_g) * jax.nn.silu(heads_a(a_g).astype(F32))
    lam_init = 0.8 - 0.6 * math.exp(-0.3 * layer_idx)
    lam = (jnp.exp(jnp.sum(lq1.astype(F32) * lk1.astype(F32)))
           - jnp.exp(jnp.sum(lq2.astype(F32) * lk2.astype(F32))) + lam_init)
    qd = b_q.reshape(Bsz, S, B_HEADS, 2, B_HEAD_DIM).transpose(0, 2, 3, 1, 4).astype(F32)
    kd = b_k.reshape(Bsz, S, B_HEADS, 2, B_HEAD_DIM).transpose(0, 2, 3, 1, 4).astype(F32)
    vd = b_v.reshape(Bsz, S, B_HEADS, 2 * B_HEAD_DIM).transpose(0, 2, 1, 3).astype(F32)
    o_b = _diff_attention(qd, kd, vd, lam)
    o_b = _rms_norm(o_b, diff_g) * (1.0 - lam_init)
    o = jnp.concatenate([o_a.reshape(Bsz, S, A_WIDTH), o_b.reshape(Bsz, S, B_WIDTH)], axis=-1)
    return o.astype(x.dtype) @ w_out


def _odd_mixer(x, w_in, w_out, b_f, qn_g, kn_g):
    Bsz, S, _ = x.shape
    proj = x @ w_in
    q, k, v, g, f_logit = jnp.split(proj, [D_MODEL, 2 * D_MODEL, 3 * D_MODEL, 4 * D_MODEL], axis=-1)
    heads = lambda t: t.reshape(Bsz, S, C_HEADS, C_HEAD_DIM).transpose(0, 2, 1, 3)
    qh = _rms_norm(heads(q), qn_g)
    kh = _rms_norm(heads(k), kn_g)
    vh = heads(v).astype(F32)
    logf = jax.nn.log_sigmoid(f_logit.astype(F32) + b_f.astype(F32))
    c = jnp.cumsum(logf, axis=1).transpose(0, 2, 1)
    o = _fox_attention(qh, kh, vh, c).reshape(Bsz, S, D_MODEL)
    o = o * jax.nn.sigmoid(g.astype(F32))
    return o.astype(x.dtype) @ w_out


def setup_inputs(seed: int = 0) -> dict:
    key = jax.random.key(seed)
    ks = jax.random.split(key, 21)
    nrm = lambda k, shape, s: jax.random.normal(k, shape, F32) * s
    d_in = D_MODEL ** -0.5
    return {
        "x": nrm(ks[0], (BATCH, SEQ, D_MODEL), 1.0),
        "even_w_in": nrm(ks[1], (N_EVEN, D_MODEL, EVEN_IN), d_in),
        "even_w_out": nrm(ks[2], (N_EVEN, D_MODEL, D_MODEL), d_in * BETA),
        "hgrn_lb_logits": nrm(ks[3], (N_EVEN, A_WIDTH), 0.1),
        "diff_lq1": nrm(ks[4], (N_EVEN, B_HEAD_DIM), 0.1),
        "diff_lk1": nrm(ks[5], (N_EVEN, B_HEAD_DIM), 0.1),
        "diff_lq2": nrm(ks[6], (N_EVEN, B_HEAD_DIM), 0.1),
        "diff_lk2": nrm(ks[7], (N_EVEN, B_HEAD_DIM), 0.1),
        "hgrn_norm_g": 1.0 + nrm(ks[8], (N_EVEN, A_DV), 0.02),
        "diff_norm_g": 1.0 + nrm(ks[9], (N_EVEN, 2 * B_HEAD_DIM), 0.02),
        "fox_w_in": nrm(ks[10], (N_ODD, D_MODEL, ODD_IN), d_in),
        "fox_w_out": nrm(ks[11], (N_ODD, D_MODEL, D_MODEL), d_in * BETA),
        "fox_b_f": 2.0 + nrm(ks[12], (N_ODD, C_HEADS), 0.1),
        "fox_qnorm_g": 1.0 + nrm(ks[13], (N_ODD, C_HEAD_DIM), 0.02),
        "fox_knorm_g": 1.0 + nrm(ks[14], (N_ODD, C_HEAD_DIM), 0.02),
        "ffn_w1": nrm(ks[15], (DEPTH, D_MODEL, 2 * D_FF), d_in),
        "ffn_w2": nrm(ks[16], (DEPTH, D_FF, D_MODEL), D_FF ** -0.5 * BETA),
        "ln1_g": 1.0 + nrm(ks[17], (DEPTH, D_MODEL), 0.02),
        "ln1_b": nrm(ks[18], (DEPTH, D_MODEL), 0.02),
        "ln2_g": 1.0 + nrm(ks[19], (DEPTH, D_MODEL), 0.02),
        "ln2_b": nrm(ks[20], (DEPTH, D_MODEL), 0.02),
    }


def reference(x, even_w_in, even_w_out, hgrn_lb_logits, diff_lq1, diff_lk1, diff_lq2, diff_lk2,
              hgrn_norm_g, diff_norm_g, fox_w_in, fox_w_out, fox_b_f, fox_qnorm_g, fox_knorm_g,
              ffn_w1, ffn_w2, ln1_g, ln1_b, ln2_g, ln2_b):
    lb_soft = jax.nn.softmax(hgrn_lb_logits.astype(F32), axis=0)
    lb_all = jnp.cumsum(lb_soft, axis=0) - lb_soft[0]
    for l in range(DEPTH):
        j = l // 2
        if l % 2 == 0:
            h = _even_mixer(x, even_w_in[j], even_w_out[j], lb_all[j],
                            diff_lq1[j], diff_lk1[j], diff_lq2[j], diff_lk2[j],
                            hgrn_norm_g[j], diff_norm_g[j], l)
        else:
            h = _odd_mixer(x, fox_w_in[j], fox_w_out[j], fox_b_f[j], fox_qnorm_g[j], fox_knorm_g[j])
        x = _layer_norm(ALPHA * x + h, ln1_g[l], ln1_b[l])
        x = _layer_norm(ALPHA * x + _swiglu(x, ffn_w1[l], ffn_w2[l]), ln2_g[l], ln2_b[l])
    return x
```

```cpp
#include <hip/hip_runtime.h>
#include <hip/hip_cooperative_groups.h>
#include <cstdio>
#include <cstdint>
namespace cg = cooperative_groups;

#ifndef COOP
#define COOP 1
#endif
#ifndef ONLY
#define ONLY -1
#endif
#ifndef DUPMASK
#define DUPMASK 0
#endif

typedef unsigned short bf16_t;
typedef short bf16x8 __attribute__((ext_vector_type(8)));
typedef float f32x16 __attribute__((ext_vector_type(16)));
typedef float f32x4 __attribute__((ext_vector_type(4)));
typedef float f32x2 __attribute__((ext_vector_type(2)));
typedef unsigned u32x4 __attribute__((ext_vector_type(4)));
typedef unsigned u32x2 __attribute__((ext_vector_type(2)));
typedef __bf16 bf16x2v __attribute__((ext_vector_type(2)));

#define DI __device__ __forceinline__
#define MFMA32(a, b, c) __builtin_amdgcn_mfma_f32_32x32x16_bf16((a), (b), (c), 0, 0, 0)

constexpr int D = 1024, SEQ = 16384, NTOK = 32768, DFF = 2816;
constexpr int EVEN_IN = 3584, ODD_IN = 4112, ODD_PAD = 4352;
constexpr float ALPHA = 1.6817928305074290f;
constexpr float LOG2E = 1.4426950408889634f;
constexpr size_t MiB = 1u << 20;

constexpr size_t OFF_WEI = 0;
constexpr size_t OFF_WEO = OFF_WEI + (size_t)2 * EVEN_IN * D * 2;
constexpr size_t OFF_WFI = OFF_WEO + (size_t)2 * D * D * 2;
constexpr size_t OFF_WFO = OFF_WFI + (size_t)2 * ODD_PAD * D * 2;
constexpr size_t OFF_W1  = OFF_WFO + (size_t)2 * D * D * 2;
constexpr size_t OFF_W2  = OFF_W1 + (size_t)4 * 2 * DFF * D * 2;
constexpr size_t W_END   = OFF_W2 + (size_t)4 * D * DFF * 2;
static_assert(W_END <= 105 * MiB, "weights region");
constexpr size_t OFF_R1 = 105 * MiB;
constexpr size_t OFF_AB = 361 * MiB;
constexpr size_t OFF_UT = 425 * MiB;
constexpr size_t OFF_DB = 489 * MiB;
constexpr size_t OFF_LF = 490 * MiB;
constexpr size_t OFF_C2 = 492 * MiB;
constexpr size_t OFF_MISC = 494 * MiB;
constexpr size_t OFF_CNT = OFF_MISC + 80 * 1024;
constexpr size_t OFF_XCHG = OFF_MISC + 128 * 1024;

#define GAS __attribute__((address_space(1)))
struct Params {
  const GAS float* x_in;
  const GAS float *even_w_in, *even_w_out, *lb_logits, *lq1, *lk1, *lq2, *lk2, *hgrn_g, *diff_g;
  const GAS float *fox_w_in, *fox_w_out, *fox_bf, *fox_qg, *fox_kg;
  const GAS float *w1, *w2, *ln1g, *ln1b, *ln2g, *ln2b;
  GAS float* out;
  GAS char* ws;
  int lo, hi;
};

DI unsigned pk2(float lo, float hi) { f32x2 v = {lo, hi}; bf16x2v b = __builtin_convertvector(v, bf16x2v); return __builtin_bit_cast(unsigned, b); }
DI bf16_t f2bf(float x) { return (bf16_t)(pk2(x, 0.f) & 0xffffu); }
DI float bf2f(bf16_t v) { return __uint_as_float(((unsigned)v) << 16); }
DI float sigmoidf_(float x) { return 1.f / (1.f + __expf(-x)); }
DI float siluf_(float x) { return x / (1.f + __expf(-x)); }
DI GAS char* launder(GAS char* q) { asm volatile("" : "+s"(q)); return q; }
DI int tid_l() { int t = threadIdx.x; asm volatile("" : "+v"(t)); return t; }
DI int swz32(int s) { return (s & ~12) | ((s & 4) << 1) | ((s & 8) >> 1); }
DI float xor32(float v) { return __shfl_xor(v, 32, 64); }

DI void convert_w(const float* __restrict__ w, bf16_t* __restrict__ wt, int K, int N, int Npad, int mode, float* tl) {
  const int tid = tid_l();
  const int nkt = K >> 6, nnt = Npad >> 6;
  for (int tile = blockIdx.x; tile < nkt * nnt; tile += gridDim.x) {
    const int k0 = (tile / nnt) << 6, n0 = (tile % nnt) << 6;
#pragma unroll
    for (int i = 0; i < 2; ++i) {
      const int kk = (tid >> 4) + 32 * i, n4 = (tid & 15) << 2;
      const int np = n0 + n4;
      int src = np;
      if (mode == 1) { const int grp = np >> 6, j = np & 63; src = (j < 32) ? grp * 32 + j : DFF + grp * 32 + (j - 32); }
      f32x4 v = {0.f, 0.f, 0.f, 0.f};
      if (src < N) v = *(const f32x4*)(w + (size_t)(k0 + kk) * N + src);
      tl[kk * 65 + n4 + 0] = v[0]; tl[kk * 65 + n4 + 1] = v[1]; tl[kk * 65 + n4 + 2] = v[2]; tl[kk * 65 + n4 + 3] = v[3];
    }
    __syncthreads();
    {
      const int n = tid >> 3, kc = (tid & 7) << 3;
      float f[8];
#pragma unroll
      for (int j = 0; j < 8; ++j) f[j] = tl[(kc + j) * 65 + n];
      u32x4 o = {pk2(f[0], f[1]), pk2(f[2], f[3]), pk2(f[4], f[5]), pk2(f[6], f[7])};
      *(u32x4*)(wt + (size_t)(n0 + n) * K + k0 + kc) = o;
    }
    __syncthreads();
  }
}

DI void phase0(const Params& p, char* lds) {
  float* tl = (float*)lds;
  char* ws = (char*)launder(p.ws);
  for (int j = 0; j < 2; ++j) {
    convert_w(((const float*)p.even_w_in) + (size_t)j * D * EVEN_IN, (bf16_t*)(ws + OFF_WEI) + (size_t)j * EVEN_IN * D, D, EVEN_IN, EVEN_IN, 0, tl);
    convert_w(((const float*)p.even_w_out) + (size_t)j * D * D, (bf16_t*)(ws + OFF_WEO) + (size_t)j * D * D, D, D, D, 0, tl);
    convert_w(((const float*)p.fox_w_in) + (size_t)j * D * ODD_IN, (bf16_t*)(ws + OFF_WFI) + (size_t)j * ODD_PAD * D, D, ODD_IN, ODD_PAD, 0, tl);
    convert_w(((const float*)p.fox_w_out) + (size_t)j * D * D, (bf16_t*)(ws + OFF_WFO) + (size_t)j * D * D, D, D, D, 0, tl);
  }
  for (int l = 0; l < 4; ++l) {
    convert_w(((const float*)p.w1) + (size_t)l * D * 2 * DFF, (bf16_t*)(ws + OFF_W1) + (size_t)l * 2 * DFF * D, D, 2 * DFF, 2 * DFF, 1, tl);
    convert_w(((const float*)p.w2) + (size_t)l * DFF * D, (bf16_t*)(ws + OFF_W2) + (size_t)l * D * DFF, DFF, D, D, 0, tl);
  }
  {
    bf16_t* ab = (bf16_t*)(ws + OFF_AB);
    const size_t n8 = (size_t)NTOK * D / 8;
    for (size_t i = (size_t)blockIdx.x * 512 + tid_l(); i < n8; i += (size_t)gridDim.x * 512) {
      f32x4 a = *(const f32x4*)(((const float*)p.x_in) + i * 8), b = *(const f32x4*)(((const float*)p.x_in) + i * 8 + 4);
      u32x4 o = {pk2(a[0], a[1]), pk2(a[2], a[3]), pk2(b[0], b[1]), pk2(b[2], b[3])};
      *(u32x4*)(ab + i * 8) = o;
    }
  }
  if (blockIdx.x == 0) { const int t_ = tid_l(); if (t_ < 128) ((unsigned*)(ws + OFF_CNT))[t_] = 0u; if (t_ == 128) ((unsigned*)(ws + OFF_CNT))[256] = 0u; }
  if (blockIdx.x == 0) {
    float* misc = (float*)(ws + OFF_MISC);
    const int tid = tid_l();
    {
      const float l0 = ((const float*)p.lb_logits)[tid], l1 = ((const float*)p.lb_logits)[512 + tid];
      const float mx = fmaxf(l0, l1);
      const float e0 = expf(l0 - mx), e1 = expf(l1 - mx);
      const float s0 = e0 / (e0 + e1), s1 = e1 / (e0 + e1);
      misc[tid] = s0 - s0;
      misc[512 + tid] = (s0 + s1) - s0;
    }
    if (tid < 2) {
      float d1 = 0.f, d2 = 0.f;
      for (int i = 0; i < 64; ++i) { d1 += ((const float*)p.lq1)[tid * 64 + i] * ((const float*)p.lk1)[tid * 64 + i]; d2 += ((const float*)p.lq2)[tid * 64 + i] * ((const float*)p.lk2)[tid * 64 + i]; }
      const float lam_init = 0.8f - 0.6f * expf(-0.3f * (float)(2 * tid));
      misc[1024 + tid] = expf(d1) - expf(d2) + lam_init;
      float mq = 0.f, mk = 0.f;
      for (int i = 0; i < 64; ++i) { mq = fmaxf(mq, fabsf(((const float*)p.fox_qg)[tid * 64 + i])); mk = fmaxf(mk, fabsf(((const float*)p.fox_kg)[tid * 64 + i])); }
      const float B = 0.125f * LOG2E * 64.f * mq * mk * 1.02f;
      misc[1032 + tid] = 2.f * B + 8.f;
    }
  }
}

constexpr int LROW = 144;
constexpr int G_XB = 256 * LROW, G_WB = 256 * LROW, G_STAGE = G_XB + G_WB;
constexpr int DIFF_STASH_OFF = 2 * (64 * LROW + 128 * LROW + 256);
constexpr int LDS_BYTES = 2 * G_STAGE;
static_assert(LDS_BYTES >= DIFF_STASH_OFF + 512 * 32 * 4, "lds");

template <class Epi>
DI void gemm_phase(const bf16_t* __restrict__ X, const int ldx, const bf16_t* __restrict__ Wt, const int N, const int K, const Epi& epi, char* lds) {
  const int tid = tid_l(), lane = tid & 63, wave = tid >> 6;
  const int r = lane & 31, hh = lane >> 5;
  const int tw = wave & 3, fw = wave >> 2;
  const int nNt = N >> 8;
  const int ntiles = nNt * (NTOK / 256);
  const int nk = K >> 6;
  const int lrow = tid >> 3, lch = tid & 7;
  const int xcd = blockIdx.x & 7, slot = blockIdx.x >> 3, nchunks = 4 * nNt;
  (void)ntiles;
  for (int chunk = xcd; chunk < nchunks; chunk += 8) {
    const int L = chunk * 32 + slot, band = L / (4 * nNt), rem = L % (4 * nNt);
    const int mt_ = band * 4 + (rem & 3), nt_ = rem >> 2;
    const char* Xt = (const char*)(X + (size_t)(mt_ * 256) * ldx);
    const char* Wtb = (const char*)(Wt + (size_t)(nt_ * 256) * K);
    const unsigned xoff = (unsigned)(lrow * ldx + lch * 8) * 2u, woff = (unsigned)(lrow * K + lch * 8) * 2u;
    f32x16 acc[2][2][2];
    u32x4 xr0[4], wr0[4];
#define G_GLOAD(XR, WR, KT) { _Pragma("unroll") for (int i_ = 0; i_ < 4; ++i_) XR[i_] = *(const u32x4*)(Xt + ((size_t)(64 * i_) * ldx + (KT) * 64) * 2 + xoff); \
    _Pragma("unroll") for (int i_ = 0; i_ < 4; ++i_) WR[i_] = *(const u32x4*)(Wtb + ((size_t)(64 * i_) * K + (KT) * 64) * 2 + woff); }
#define G_LSTORE(XR, WR, STG) { char* xs_ = lds + (STG) * G_STAGE; char* ws_ = xs_ + G_XB; \
    _Pragma("unroll") for (int i_ = 0; i_ < 4; ++i_) *(u32x4*)(xs_ + (lrow + 64 * i_) * LROW + lch * 16) = XR[i_]; \
    _Pragma("unroll") for (int i_ = 0; i_ < 4; ++i_) *(u32x4*)(ws_ + (lrow + 64 * i_) * LROW + lch * 16) = WR[i_]; }
#define G_PART(Q, STG, KT, DOLOAD) { char* xs_ = lds + (STG) * G_STAGE; char* ws_ = xs_ + G_XB; \
    if ((Q) < 2) { _Pragma("unroll") for (int i_ = 2 * (Q); i_ < 2 * (Q) + 2; ++i_) { *(u32x4*)(xs_ + (lrow + 64 * i_) * LROW + lch * 16) = xr0[i_]; \
        if (DOLOAD) xr0[i_] = *(const u32x4*)(Xt + ((size_t)(64 * i_) * ldx + (KT) * 64) * 2 + xoff); } } \
    else { _Pragma("unroll") for (int i_ = 2 * ((Q) - 2); i_ < 2 * ((Q) - 2) + 2; ++i_) { *(u32x4*)(ws_ + (lrow + 64 * i_) * LROW + lch * 16) = wr0[i_]; \
        if (DOLOAD) wr0[i_] = *(const u32x4*)(Wtb + ((size_t)(64 * i_) * K + (KT) * 64) * 2 + woff); } } \
    __builtin_amdgcn_sched_barrier(0); }
#define G_LDX(XF, KS) { _Pragma("unroll") for (int m = 0; m < 2; ++m) XF[m] = *(const bf16x8*)(xs + (tw * 64 + m * 32 + r) * LROW + (KS) * 32 + hh * 16); }
#define G_LDW(WF, N0, KS) { _Pragma("unroll") for (int n = 0; n < 2; ++n) WF[n] = *(const bf16x8*)(wsm + (fw * 128 + ((N0) + n) * 32 + r) * LROW + (KS) * 32 + hh * 16); }
#define G_MFMA4S(XF, WF, H) { _Pragma("unroll") for (int n = 0; n < 2; ++n) _Pragma("unroll") for (int m = 0; m < 2; ++m) acc[H][n][m] = MFMA32(XF[m], WF[n], acc[H][n][m]); }
#define G_MFMA4(XF, WF, H) { _Pragma("unroll") for (int n = 0; n < 2; ++n) _Pragma("unroll") for (int m = 0; m < 2; ++m) acc[H][n][m] = MFMA32(WF[n], XF[m], acc[H][n][m]); }
#define G_STEP(MM, KS, XC, XN) { G_LDW(wc, 2, KS); if ((KS) < 3) { G_LDX(XN, (KS) + 1); } __builtin_amdgcn_sched_barrier(0); \
    MM(XC, w01, 0); __builtin_amdgcn_sched_barrier(0); if ((KS) < 3) { G_LDW(w01, 0, (KS) + 1); } MM(XC, wc, 1); __builtin_amdgcn_sched_barrier(0); }
#define G_COMPUTE_ST(MM, STG, DOSTORE, NSTG, KTL, DOLOAD) { const char* xs = lds + (STG) * G_STAGE; const char* wsm = xs + G_XB; \
    bf16x8 xfa[2], xfb[2], w01[2], wc[2]; \
    G_LDX(xfa, 0); G_LDW(w01, 0, 0); \
    if (DOSTORE) G_PART(0, NSTG, KTL, DOLOAD); \
    G_STEP(MM, 0, xfa, xfb); if (DOSTORE) G_PART(1, NSTG, KTL, DOLOAD); \
    G_STEP(MM, 1, xfb, xfa); if (DOSTORE) G_PART(2, NSTG, KTL, DOLOAD); \
    G_STEP(MM, 2, xfa, xfb); if (DOSTORE) G_PART(3, NSTG, KTL, DOLOAD); \
    G_STEP(MM, 3, xfb, xfa); }
#define G_COMPUTE(MM, STG) { const char* xs = lds + (STG) * G_STAGE; const char* wsm = xs + G_XB; \
    bf16x8 xfa[2], xfb[2], w01[2], wc[2]; \
    G_LDX(xfa, 0); G_LDW(w01, 0, 0); \
    G_STEP(MM, 0, xfa, xfb); G_STEP(MM, 1, xfb, xfa); G_STEP(MM, 2, xfa, xfb); G_STEP(MM, 3, xfb, xfa); }
    asm volatile("" ::: "memory");
    G_GLOAD(xr0, wr0, 0);
    G_LSTORE(xr0, wr0, 0);
    __syncthreads();
    G_GLOAD(xr0, wr0, 1);
#pragma unroll
    for (int c = 0; c < 2; ++c)
#pragma unroll
      for (int a = 0; a < 2; ++a)
#pragma unroll
        for (int b = 0; b < 2; ++b)
#pragma unroll
          for (int i = 0; i < 16; ++i) acc[c][a][b][i] = 0.f;
#define G_KLOOP(MM) for (int kt = 0; kt < nk; kt += 2) { \
      { const int k2_ = (kt + 2 < nk) ? kt + 2 : nk - 1; G_COMPUTE_ST(MM, 0, true, 1, k2_, true); }     \
      __syncthreads(); \
      { const int k3_ = (kt + 3 < nk) ? kt + 3 : nk - 1; G_COMPUTE_ST(MM, 1, true, 0, k3_, true); } \
      __syncthreads(); \
    }
    const bool sw = Epi::kSwap && epi.swap_tile(nt_);
#define G_EPI_IDS const int t2 = tid_l(); const int r2 = t2 & 31, hh2 = (t2 >> 5) & 1, tw2 = (t2 >> 6) & 3, fw2 = t2 >> 8;
    if (sw) {
      G_KLOOP(G_MFMA4S)
      if constexpr (Epi::kSwap) {
        G_EPI_IDS
        epi.swapped(mt_ * 256 + tw2 * 64, nt_ * 256 + fw2 * 128, acc[0], r2, hh2);
        __builtin_amdgcn_sched_barrier(0);
        epi.swapped(mt_ * 256 + tw2 * 64, nt_ * 256 + fw2 * 128 + 64, acc[1], r2, hh2);
      }
    } else {
      G_KLOOP(G_MFMA4)
      G_EPI_IDS
      if constexpr (Epi::kFull) {
        epi.full(mt_, nt_, acc, tw2, fw2, r2, hh2, lds, t2);
      } else {
        epi(mt_ * 256 + tw2 * 64, nt_ * 256 + fw2 * 128, acc[0], r2, hh2);
        __builtin_amdgcn_sched_barrier(0);
        epi(mt_ * 256 + tw2 * 64, nt_ * 256 + fw2 * 128 + 64, acc[1], r2, hh2);
      }
    }
#undef G_EPI_IDS
#undef G_KLOOP
#undef G_GLOAD
#undef G_LSTORE
#undef G_COMPUTE
#undef G_PART
#undef G_COMPUTE_ST
#undef G_LDX
#undef G_LDW
#undef G_MFMA4
#undef G_MFMA4S
#undef G_STEP
    __builtin_amdgcn_sched_barrier(0);
  }
}

struct EpiEvenIn {
  static constexpr bool kFull = false, kSwap = false;
  DI bool swap_tile(int nt_) const { const int seg = nt_ >> 1; return seg == 2 || seg == 6; }
  char* r1; const float* lb;
#define aq  ((bf16_t*)(r1))
#define alf ((float*)(r1 + 32 * MiB))
#define aiT ((bf16_t*)(r1 + 96 * MiB))
#define ag  ((bf16_t*)(r1 + 128 * MiB))
#define bq  ((bf16_t*)(r1 + 160 * MiB))
#define bk  ((bf16_t*)(r1 + 192 * MiB))
#define bvT ((bf16_t*)(r1 + 224 * MiB))
  DI void operator()(int tok0, int feat0, f32x16 (&acc)[2][2], int r, int hh) const {
    const int seg = feat0 >> 9, c0 = feat0 & 511;
#pragma unroll
    for (int mt = 0; mt < 2; ++mt) {
      const int tok = tok0 + mt * 32 + r, b = tok >> 14, s = tok & (SEQ - 1);
#pragma unroll
      for (int nt = 0; nt < 2; ++nt)
#pragma unroll
        for (int g = 0; g < 4; ++g) {
          const int c = c0 + nt * 32 + 8 * g + 4 * hh;
          const float v0 = acc[nt][mt][4 * g], v1 = acc[nt][mt][4 * g + 1], v2 = acc[nt][mt][4 * g + 2], v3 = acc[nt][mt][4 * g + 3];
          if (seg == 0) { u32x2 o = {pk2(siluf_(v0), siluf_(v1)), pk2(siluf_(v2), siluf_(v3))}; *(u32x2*)(aq + (size_t)tok * 512 + c) = o; }
          else if (seg == 1) {
            f32x4 lbv = *(const f32x4*)(lb + c);
            f32x4 o;
            o[0] = logf(lbv[0] + (1.f - lbv[0]) * sigmoidf_(v0)); o[1] = logf(lbv[1] + (1.f - lbv[1]) * sigmoidf_(v1));
            o[2] = logf(lbv[2] + (1.f - lbv[2]) * sigmoidf_(v2)); o[3] = logf(lbv[3] + (1.f - lbv[3]) * sigmoidf_(v3));
            *(f32x4*)(alf + (size_t)tok * 512 + c) = o;
          }
          else if (seg == 3) { u32x2 o = {pk2(siluf_(v0), siluf_(v1)), pk2(siluf_(v2), siluf_(v3))}; *(u32x2*)(ag + (size_t)tok * 512 + c) = o; }
          else if (seg == 4) { const float sc = 0.125f * LOG2E; u32x2 o = {pk2(v0 * sc, v1 * sc), pk2(v2 * sc, v3 * sc)}; *(u32x2*)(bq + (size_t)tok * 512 + c) = o; }
          else if (seg == 5) { u32x2 o = {pk2(v0, v1), pk2(v2, v3)}; *(u32x2*)(bk + (size_t)tok * 512 + c) = o; }
          else if (seg == 2) {
            bf16_t* dst = aiT + ((size_t)((b * 4 + (c >> 7)) * 128 + (c & 127))) * SEQ + s;
            dst[0] = f2bf(v0); dst[SEQ] = f2bf(v1); dst[2 * SEQ] = f2bf(v2); dst[3 * SEQ] = f2bf(v3);
          }
          else if (seg == 6) {
            bf16_t* dst = bvT + ((size_t)((b * 4 + (c >> 7)) * 128 + (c & 127))) * SEQ + swz32(s);
            dst[0] = f2bf(v0); dst[SEQ] = f2bf(v1); dst[2 * SEQ] = f2bf(v2); dst[3 * SEQ] = f2bf(v3);
          }
          __builtin_amdgcn_sched_barrier(0);
        }
    }
  }
  DI void swapped(int tok0, int feat0, f32x16 (&acc)[2][2], int r, int hh) const {
    const int seg = feat0 >> 9, c0 = feat0 & 511;
#pragma unroll
    for (int nt = 0; nt < 2; ++nt) {
      const int c = c0 + nt * 32 + r;
#pragma unroll
      for (int mt = 0; mt < 2; ++mt)
#pragma unroll
        for (int g = 0; g < 4; ++g) {
          const int tok = tok0 + mt * 32 + 8 * g + 4 * hh, b = tok >> 14, s = tok & (SEQ - 1);
          u32x2 o = {pk2(acc[nt][mt][4 * g], acc[nt][mt][4 * g + 1]), pk2(acc[nt][mt][4 * g + 2], acc[nt][mt][4 * g + 3])};
          bf16_t* base = (seg == 2 ? aiT : bvT) + ((size_t)((b * 4 + (c >> 7)) * 128 + (c & 127))) * SEQ;
          *(u32x2*)(base + (seg == 2 ? s : swz32(s))) = o;
        }
    }
  }
};

#undef aq
#undef alf
#undef aiT
#undef ag
#undef bq
#undef bk
#undef bvT
struct EpiOddIn {
  static constexpr bool kFull = false, kSwap = false;
  DI bool swap_tile(int nt_) const { return (nt_ >> 2) == 2; }
  char* r1; float* lf; const float *qg, *kg, *bf;
#define fq  ((bf16_t*)(r1))
#define fk  ((bf16_t*)(r1 + 64 * MiB))
#define fvT ((bf16_t*)(r1 + 128 * MiB))
#define fg  ((bf16_t*)(r1 + 192 * MiB))
  DI void operator()(int tok0, int feat0, f32x16 (&acc)[2][2], int r, int hh) const {
    const int seg = feat0 >> 10, c0 = feat0 & 1023;
#pragma unroll
    for (int mt = 0; mt < 2; ++mt) {
      const int tok = tok0 + mt * 32 + r, b = tok >> 14, s = tok & (SEQ - 1);
      if (seg < 2) {
        float ssq = 0.f;
#pragma unroll
        for (int nt = 0; nt < 2; ++nt)
#pragma unroll
          for (int i = 0; i < 16; ++i) ssq += acc[nt][mt][i] * acc[nt][mt][i];
        ssq += xor32(ssq);
        float rs = rsqrtf(ssq * (1.f / 64.f) + 1e-6f);
        if (seg == 0) rs *= 0.125f * LOG2E;
        const float* gg = seg == 0 ? qg : kg;
        bf16_t* dstb = (seg == 0 ? fq : fk) + (size_t)tok * 1024 + c0;
#pragma unroll
        for (int nt = 0; nt < 2; ++nt)
#pragma unroll
          for (int g = 0; g < 4; ++g) {
            const int d = nt * 32 + 8 * g + 4 * hh;
            f32x4 gv = *(const f32x4*)(gg + d);
            u32x2 o = {pk2(acc[nt][mt][4 * g] * rs * gv[0], acc[nt][mt][4 * g + 1] * rs * gv[1]), pk2(acc[nt][mt][4 * g + 2] * rs * gv[2], acc[nt][mt][4 * g + 3] * rs * gv[3])};
            *(u32x2*)(dstb + d) = o;
            __builtin_amdgcn_sched_barrier(0);
          }
      } else if (seg == 2) {
        const int head = c0 >> 6;
#pragma unroll
        for (int nt = 0; nt < 2; ++nt)
#pragma unroll
          for (int g = 0; g < 4; ++g) {
            const int d = nt * 32 + 8 * g + 4 * hh;
            bf16_t* dst = fvT + ((size_t)((b * 16 + head) * 64 + d)) * SEQ + swz32(s);
            dst[0] = f2bf(acc[nt][mt][4 * g]); dst[SEQ] = f2bf(acc[nt][mt][4 * g + 1]); dst[2 * SEQ] = f2bf(acc[nt][mt][4 * g + 2]); dst[3 * SEQ] = f2bf(acc[nt][mt][4 * g + 3]);
          }
      } else if (seg == 3) {
#pragma unroll
        for (int nt = 0; nt < 2; ++nt)
#pragma unroll
          for (int g = 0; g < 4; ++g) {
            const int c = c0 + nt * 32 + 8 * g + 4 * hh;
            u32x2 o = {pk2(sigmoidf_(acc[nt][mt][4 * g]), sigmoidf_(acc[nt][mt][4 * g + 1])), pk2(sigmoidf_(acc[nt][mt][4 * g + 2]), sigmoidf_(acc[nt][mt][4 * g + 3]))};
            *(u32x2*)(fg + (size_t)tok * 1024 + c) = o;
            __builtin_amdgcn_sched_barrier(0);
          }
      } else if (feat0 == 4096) {
#pragma unroll
        for (int g = 0; g < 2; ++g)
#pragma unroll
          for (int j = 0; j < 4; ++j) {
            const int hd = 8 * g + 4 * hh + j;
            const float xv = acc[0][mt][4 * g + j] + bf[hd];
            const float ls = fminf(xv, 0.f) - log1pf(expf(-fabsf(xv)));
            lf[((size_t)(b * 16 + hd)) * SEQ + s] = ls;
          }
      }
    }
  }
  DI void swapped(int tok0, int feat0, f32x16 (&acc)[2][2], int r, int hh) const {
    const int head = (feat0 & 1023) >> 6;
#pragma unroll
    for (int nt = 0; nt < 2; ++nt) {
      const int d = nt * 32 + r;
#pragma unroll
      for (int mt = 0; mt < 2; ++mt)
#pragma unroll
        for (int g = 0; g < 4; ++g) {
          const int tok = tok0 + mt * 32 + 8 * g + 4 * hh, b = tok >> 14, s = tok & (SEQ - 1);
          u32x2 o = {pk2(acc[nt][mt][4 * g], acc[nt][mt][4 * g + 1]), pk2(acc[nt][mt][4 * g + 2], acc[nt][mt][4 * g + 3])};
          *(u32x2*)(fvT + ((size_t)((b * 16 + head) * 64 + d)) * SEQ + swz32(s)) = o;
        }
    }
  }
};

#undef fq
#undef fk
#undef fvT
#undef fg
struct EpiRes {
  static constexpr bool kFull = false;
  const float* xin; float* y;
  DI void operator()(int tok0, int feat0, f32x16 (&acc)[2][2], int r, int hh) const {
#pragma unroll
    for (int mt = 0; mt < 2; ++mt) {
      const size_t rowo = (size_t)(tok0 + mt * 32 + r) * 1024;
#pragma unroll
      for (int nt = 0; nt < 2; ++nt)
#pragma unroll
        for (int g = 0; g < 4; ++g) {
          const int c = feat0 + nt * 32 + 8 * g + 4 * hh;
          f32x4 xv = *(const f32x4*)(xin + rowo + c);
          f32x4 o = {ALPHA * xv[0] + acc[nt][mt][4 * g], ALPHA * xv[1] + acc[nt][mt][4 * g + 1], ALPHA * xv[2] + acc[nt][mt][4 * g + 2], ALPHA * xv[3] + acc[nt][mt][4 * g + 3]};
          *(f32x4*)(y + rowo + c) = o;
          if (g & 1) __builtin_amdgcn_sched_barrier(0);
        }
    }
  }
};

struct EpiResLN {
  static constexpr bool kFull = true, kSwap = false;
  DI bool swap_tile(int) const { return false; }
  const float* xin; float* xout; bf16_t* xb; const float *g, *b; float* xchg; unsigned* cnt; unsigned target;
  DI void full(const int mt_, const int nt_, f32x16 (&acc)[2][2][2], const int tw, const int fw, const int r, const int hh, char* lds, const int tid) const {
    float* part = (float*)lds;
#pragma unroll
    for (int mt = 0; mt < 2; ++mt) {
      const size_t rowo = (size_t)(mt_ * 256 + tw * 64 + mt * 32 + r) * 1024 + nt_ * 256 + fw * 128 + 4 * hh;
      float sm = 0.f, sq = 0.f;
#pragma unroll
      for (int half = 0; half < 2; ++half)
#pragma unroll
        for (int nt = 0; nt < 2; ++nt) {
#pragma unroll
          for (int gq = 0; gq < 4; ++gq) {
            f32x4 xv = *(const f32x4*)(xin + rowo + half * 64 + nt * 32 + 8 * gq);
#pragma unroll
            for (int jj = 0; jj < 4; ++jj) { const float y = ALPHA * xv[jj] + acc[half][nt][mt][4 * gq + jj]; acc[half][nt][mt][4 * gq + jj] = y; sm += y; sq += y * y; }
          }
          __builtin_amdgcn_sched_barrier(0);
        }
      sm += xor32(sm); sq += xor32(sq);
      if (hh == 0) { float* pp = part + ((fw * 256) + tw * 64 + mt * 32 + r) * 2; pp[0] = sm; pp[1] = sq; }
    }
    __syncthreads();
    if (tid < 256) {
      f32x2 a = *(const f32x2*)(part + tid * 2), c = *(const f32x2*)(part + (256 + tid) * 2);
      const unsigned long long pk = ((unsigned long long)__float_as_uint(a[1] + c[1]) << 32) | (unsigned long long)__float_as_uint(a[0] + c[0]);
      __hip_atomic_store((GAS unsigned long long*)(xchg + ((size_t)(mt_ * 4 + nt_) * 256 + tid) * 2), pk, __ATOMIC_RELAXED, __HIP_MEMORY_SCOPE_AGENT);
    }
    asm volatile("s_waitcnt vmcnt(0)" ::: "memory");
    __syncthreads();
    if (tid == 0) {
      __hip_atomic_fetch_add((GAS unsigned*)(cnt + mt_), 1u, __ATOMIC_RELAXED, __HIP_MEMORY_SCOPE_AGENT);
      while (__hip_atomic_load((GAS unsigned*)(cnt + mt_), __ATOMIC_RELAXED, __HIP_MEMORY_SCOPE_AGENT) < target) __builtin_amdgcn_s_sleep(1);
    }
    __syncthreads();
#pragma unroll
    for (int mt = 0; mt < 2; ++mt) {
      const int tl = tw * 64 + mt * 32 + r;
      float S = 0.f, Q = 0.f;
#pragma unroll
      for (int k = 0; k < 4; ++k) {
        const unsigned long long pk = __hip_atomic_load((GAS unsigned long long*)(xchg + ((size_t)(mt_ * 4 + k) * 256 + tl) * 2), __ATOMIC_RELAXED, __HIP_MEMORY_SCOPE_AGENT);
        S += __uint_as_float((unsigned)pk);
        Q += __uint_as_float((unsigned)(pk >> 32));
      }
      const float mean = S * (1.f / 1024.f);
      const float rstd = rsqrtf(fmaxf(Q * (1.f / 1024.f) - mean * mean, 0.f) + 1e-5f);
      const int c0 = nt_ * 256 + fw * 128 + 4 * hh;
      const size_t rowo = (size_t)(mt_ * 256 + tl) * 1024 + c0;
#pragma unroll
      for (int half = 0; half < 2; ++half)
#pragma unroll
        for (int nt = 0; nt < 2; ++nt) {
#pragma unroll
          for (int gq = 0; gq < 4; ++gq) {
            const int co = half * 64 + nt * 32 + 8 * gq;
            f32x4 gv = *(const f32x4*)(g + c0 + co), bv = *(const f32x4*)(b + c0 + co), o;
#pragma unroll
            for (int jj = 0; jj < 4; ++jj) o[jj] = (acc[half][nt][mt][4 * gq + jj] - mean) * rstd * gv[jj] + bv[jj];
            *(f32x4*)(xout + rowo + co) = o;
            u32x2 ob = {pk2(o[0], o[1]), pk2(o[2], o[3])};
            *(u32x2*)(xb + rowo + co) = ob;
          }
          __builtin_amdgcn_sched_barrier(0);
        }
    }
    __syncthreads();
  }
};

struct EpiW1 {
  static constexpr bool kFull = false, kSwap = false;
  DI bool swap_tile(int) const { return false; }
  DI void swapped(int, int, f32x16 (&)[2][2], int, int) const {}
  bf16_t* act;
  DI void operator()(int tok0, int feat0, f32x16 (&acc)[2][2], int r, int hh) const {
    const int u0 = (feat0 >> 6) * 32;
#pragma unroll
    for (int mt = 0; mt < 2; ++mt) {
      bf16_t* dst = act + (size_t)(tok0 + mt * 32 + r) * DFF + u0 + 4 * hh;
#pragma unroll
      for (int g = 0; g < 4; ++g) {
        u32x2 o = {pk2(siluf_(acc[0][mt][4 * g]) * acc[1][mt][4 * g], siluf_(acc[0][mt][4 * g + 1]) * acc[1][mt][4 * g + 1]),
                   pk2(siluf_(acc[0][mt][4 * g + 2]) * acc[1][mt][4 * g + 2], siluf_(acc[0][mt][4 * g + 3]) * acc[1][mt][4 * g + 3])};
        *(u32x2*)(dst + 8 * g) = o;
      }
    }
  }
};

DI float wave_sum(float v) {
#pragma unroll
  for (int o = 32; o >= 1; o >>= 1) v += __shfl_xor(v, o, 64);
  return v;
}
DI void ln_phase(float* x, bf16_t* xb, const float* __restrict__ g, const float* __restrict__ bta) {
  const int tid = tid_l(); const int lane = tid & 63, wave = tid >> 6;
  for (int row = blockIdx.x * 8 + wave; row < NTOK; row += gridDim.x * 8) {
    float* xr = x + (size_t)row * 1024;
    f32x4 v[4];
    float s = 0.f;
#pragma unroll
    for (int i = 0; i < 4; ++i) { v[i] = *(const f32x4*)(xr + (i * 64 + lane) * 4); s += v[i][0] + v[i][1] + v[i][2] + v[i][3]; }
    const float mean = wave_sum(s) * (1.f / 1024.f);
    float q = 0.f;
#pragma unroll
    for (int i = 0; i < 4; ++i)
#pragma unroll
      for (int j = 0; j < 4; ++j) { const float d = v[i][j] - mean; q += d * d; }
    const float rstd = rsqrtf(wave_sum(q) * (1.f / 1024.f) + 1e-5f);
#pragma unroll
    for (int i = 0; i < 4; ++i) {
      const int c = (i * 64 + lane) * 4;
      f32x4 gv = *(const f32x4*)(g + c), bv = *(const f32x4*)(bta + c), o;
#pragma unroll
      for (int j = 0; j < 4; ++j) o[j] = (v[i][j] - mean) * rstd * gv[j] + bv[j];
      *(f32x4*)(xr + c) = o;
      u32x2 ob = {pk2(o[0], o[1]), pk2(o[2], o[3])};
      *(u32x2*)(xb + (size_t)row * 1024 + c) = ob;
    }
  }
}

DI void cumsum_phase(const float* __restrict__ lf, float* __restrict__ c2, char* lds) {
  float* wt = (float*)lds;
  const int tid = tid_l(), lane = tid & 63, wave = tid >> 6;
  for (int row = blockIdx.x; row < 32; row += gridDim.x) {
    const float* src = lf + (size_t)row * SEQ + tid * 32;
    float v[32];
#pragma unroll
    for (int i = 0; i < 8; ++i) { f32x4 t = *(const f32x4*)(src + 4 * i); v[4 * i] = t[0]; v[4 * i + 1] = t[1]; v[4 * i + 2] = t[2]; v[4 * i + 3] = t[3]; }
    float run = 0.f;
#pragma unroll
    for (int i = 0; i < 32; ++i) { run += v[i]; v[i] = run; }
    float inc = run;
#pragma unroll
    for (int o = 1; o < 64; o <<= 1) { const float t = __shfl_up(inc, o, 64); if (lane >= o) inc += t; }
    if (lane == 63) wt[wave] = inc;
    __syncthreads();
    float pre = inc - run;
    for (int w = 0; w < wave; ++w) pre += wt[w];
    float* dst = c2 + (size_t)row * SEQ + tid * 32;
#pragma unroll
    for (int i = 0; i < 8; ++i) { f32x4 o = {(pre + v[4 * i]) * LOG2E, (pre + v[4 * i + 1]) * LOG2E, (pre + v[4 * i + 2]) * LOG2E, (pre + v[4 * i + 3]) * LOG2E}; *(f32x4*)(dst + 4 * i) = o; }
    __syncthreads();
  }
}

template <int DVT, bool FOX>
DI void attn_step(const char* kb, const bf16x8 (&qf)[4], f32x16 (&o)[DVT], float& m, float& l, const bool diag, const int j, const int tq, const int r, const int hh) {
  constexpr int VB = DVT * 32 * LROW;
  const char* vb = kb + 64 * LROW; const char* cb = vb + VB;
  f32x16 st[2];
  bf16x8 kf[8];
#pragma unroll
  for (int ks = 0; ks < 4; ++ks)
#pragma unroll
    for (int kt = 0; kt < 2; ++kt) kf[ks * 2 + kt] = *(const bf16x8*)(kb + (kt * 32 + r) * LROW + ks * 32 + hh * 16);
  if (FOX) {
#pragma unroll
    for (int kt = 0; kt < 2; ++kt)
#pragma unroll
      for (int g = 0; g < 4; ++g) {
        f32x4 cs = *(const f32x4*)(cb + (kt * 32 + 8 * g + 4 * hh) * 4);
        st[kt][4 * g] = cs[0]; st[kt][4 * g + 1] = cs[1]; st[kt][4 * g + 2] = cs[2]; st[kt][4 * g + 3] = cs[3];
      }
  } else {
#pragma unroll
    for (int kt = 0; kt < 2; ++kt)
#pragma unroll
      for (int i = 0; i < 16; ++i) st[kt][i] = 0.f;
  }
  __builtin_amdgcn_sched_barrier(0);
#pragma unroll
  for (int ks = 0; ks < 4; ++ks)
#pragma unroll
    for (int kt = 0; kt < 2; ++kt) st[kt] = MFMA32(kf[ks * 2 + kt], qf[ks], st[kt]);
  bf16x8 va[DVT], vn[DVT];
#pragma unroll
  for (int d = 0; d < DVT; ++d) va[d] = *(const bf16x8*)(vb + (d * 32 + r) * LROW + (8 * hh) * 2);
  __builtin_amdgcn_sched_barrier(0);
  {
    const f32x2 mm = {m, m};
#pragma unroll
    for (int kt = 0; kt < 2; ++kt)
#pragma unroll
      for (int i = 0; i < 8; ++i) { f32x2 z = {st[kt][2 * i], st[kt][2 * i + 1]}; z = z - mm; st[kt][2 * i] = z[0]; st[kt][2 * i + 1] = z[1]; }
  }
  if (FOX) {
    if (diag) {
#pragma unroll
      for (int kt = 0; kt < 2; ++kt)
#pragma unroll
        for (int i = 0; i < 16; ++i) {
          const int key = j * 64 + kt * 32 + (i & 3) + 8 * (i >> 2) + 4 * hh;
          if (key > tq) st[kt][i] = -INFINITY;
        }
    }
  }
  float mx;
  {
    float a0 = fmaxf(fmaxf(st[0][0], st[0][1]), st[0][2]), a1 = fmaxf(fmaxf(st[1][0], st[1][1]), st[1][2]);
#pragma unroll
    for (int i = 3; i < 15; i += 2) { a0 = fmaxf(fmaxf(a0, st[0][i]), st[0][i + 1]); a1 = fmaxf(fmaxf(a1, st[1][i]), st[1][i + 1]); }
    mx = fmaxf(fmaxf(a0, a1), fmaxf(st[0][15], st[1][15]));
  }
  mx = fmaxf(mx, xor32(mx));
  if (__any(diag || mx > 8.f)) {
    const float d = (diag || mx > 0.f) ? mx : 0.f;
    const float alpha = diag ? 0.f : __builtin_amdgcn_exp2f(-d);
    m += d;
    l *= alpha;
#pragma unroll
    for (int dd = 0; dd < DVT; ++dd)
#pragma unroll
      for (int i = 0; i < 16; ++i) o[dd][i] *= alpha;
    const f32x2 d2 = {d, d};
#pragma unroll
    for (int kt = 0; kt < 2; ++kt)
#pragma unroll
      for (int i = 0; i < 8; ++i) { f32x2 z = {st[kt][2 * i], st[kt][2 * i + 1]}; z = z - d2; st[kt][2 * i] = z[0]; st[kt][2 * i + 1] = z[1]; }
  }
  f32x2 ls2 = {0.f, 0.f};
#pragma unroll
  for (int kt = 0; kt < 2; ++kt)
#pragma unroll
    for (int i = 0; i < 8; ++i) {
      f32x2 pv = {__builtin_amdgcn_exp2f(st[kt][2 * i]), __builtin_amdgcn_exp2f(st[kt][2 * i + 1])};
      st[kt][2 * i] = pv[0]; st[kt][2 * i + 1] = pv[1];
      ls2 = ls2 + pv;
    }
  l += ls2[0] + ls2[1];
  __builtin_amdgcn_sched_barrier(0);
#define A_PVGROUP(GK, VC, VN) { constexpr int kt_ = (GK) >> 1, s2_ = (GK) & 1; \
    if ((GK) < 3) { constexpr int kt1_ = ((GK) + 1) >> 1, s21_ = ((GK) + 1) & 1; \
      _Pragma("unroll") for (int d = 0; d < DVT; ++d) VN[d] = *(const bf16x8*)(vb + (d * 32 + r) * LROW + (kt1_ * 32 + 16 * s21_ + 8 * hh) * 2); } \
    u32x4 pw_ = {pk2(st[kt_][8 * s2_], st[kt_][8 * s2_ + 1]), pk2(st[kt_][8 * s2_ + 2], st[kt_][8 * s2_ + 3]), pk2(st[kt_][8 * s2_ + 4], st[kt_][8 * s2_ + 5]), pk2(st[kt_][8 * s2_ + 6], st[kt_][8 * s2_ + 7])}; \
    const bf16x8 pf_ = __builtin_bit_cast(bf16x8, pw_); \
    __builtin_amdgcn_sched_barrier(0); \
    _Pragma("unroll") for (int d = 0; d < DVT; ++d) o[d] = MFMA32(VC[d], pf_, o[d]); \
    __builtin_amdgcn_sched_barrier(0); }
  A_PVGROUP(0, va, vn); A_PVGROUP(1, vn, va); A_PVGROUP(2, va, vn); A_PVGROUP(3, vn, va);
#undef A_PVGROUP
}

template <int DVT, bool FOX>
DI void attn_pass(const bf16_t* __restrict__ qrow, const bf16_t* __restrict__ kbase, const int ldk, const bf16_t* __restrict__ vtbase,
                  const float* __restrict__ cbase, const int j_hi, const int my_last, const int j_lo_diag, const int tq, const float prune_c,
                  f32x16 (&o)[DVT], float& l_out, char* lds) {
  constexpr int VB = DVT * 32 * LROW;
  constexpr int STAGE = 64 * LROW + VB + 256;
  const int tid = tid_l(), lane = tid & 63;
  const int r = lane & 31, hh = lane >> 5;
  const int lrow = tid >> 3, lch = tid & 7;
  bf16x8 qf[4];
#pragma unroll
  for (int ks = 0; ks < 4; ++ks) qf[ks] = *(const bf16x8*)(qrow + ks * 16 + hh * 8);
#pragma unroll
  for (int d = 0; d < DVT; ++d)
#pragma unroll
    for (int i = 0; i < 16; ++i) o[d][i] = 0.f;
  float m = 0.f, l = 0.f;
  u32x4 kr0, kr1, vr0[DVT / 2], vr1[DVT / 2]; f32x4 cr0 = {0.f, 0.f, 0.f, 0.f}, cr1 = {0.f, 0.f, 0.f, 0.f};
  const bf16_t* kp = kbase + (size_t)lrow * ldk + lch * 8;
  const bf16_t* vp = vtbase + (size_t)lrow * SEQ + lch * 8;
#define A_GLOAD(KR, VR, CR, JT) { const int s1_ = (JT) * 64; KR = *(const u32x4*)(kp + (size_t)s1_ * ldk); \
    _Pragma("unroll") for (int i_ = 0; i_ < DVT / 2; ++i_) VR[i_] = *(const u32x4*)(vp + (size_t)(64 * i_) * SEQ + s1_); \
    if (FOX) { if (tid < 16) { f32x4 t_ = *(const f32x4*)(cbase + s1_ + tid * 4); CR[0] = -t_[0]; CR[1] = -t_[1]; CR[2] = -t_[2]; CR[3] = -t_[3]; } } }
#define A_LSTORE(KR, VR, CR, STG) { char* kb_ = lds + (STG) * STAGE; char* vb_ = kb_ + 64 * LROW; char* cb_ = vb_ + VB; \
    *(u32x4*)(kb_ + lrow * LROW + lch * 16) = KR; \
    _Pragma("unroll") for (int i_ = 0; i_ < DVT / 2; ++i_) *(u32x4*)(vb_ + (lrow + 64 * i_) * LROW + lch * 16) = VR[i_]; \
    if (FOX) { if (tid < 16) *(f32x4*)(cb_ + tid * 16) = CR; } }
#define A_PRUNE(STG) (FOX && j < j_lo_diag && (prune_c + *(const float*)(lds + (STG) * STAGE + 64 * LROW + VB + 63 * 4) < -160.f))
  int j = j_hi;
  A_GLOAD(kr0, vr0, cr0, j);
  if (j >= 1) A_GLOAD(kr1, vr1, cr1, j - 1);
  A_LSTORE(kr0, vr0, cr0, 0);
  __syncthreads();
  for (;;) {
    if (A_PRUNE(0)) break;
    if (j >= 2) A_GLOAD(kr0, vr0, cr0, j - 2);
    if (j <= my_last) attn_step<DVT, FOX>(lds, qf, o, m, l, j == my_last, j, tq, r, hh);
    if (j == 0) break;
    A_LSTORE(kr1, vr1, cr1, 1);
    __syncthreads();
    --j;
    if (A_PRUNE(1)) break;
    if (j >= 2) A_GLOAD(kr1, vr1, cr1, j - 2);
    if (j <= my_last) attn_step<DVT, FOX>(lds + STAGE, qf, o, m, l, j == my_last, j, tq, r, hh);
    if (j == 0) break;
    A_LSTORE(kr0, vr0, cr0, 0);
    __syncthreads();
    --j;
  }
  __syncthreads();
#undef A_GLOAD
#undef A_LSTORE
#undef A_PRUNE
  l_out = l + xor32(l);
}

DI void fox_phase(const Params& p, const int j_odd, char* lds) {
  char* ws = (char*)launder(p.ws);
  const bf16_t* fq = (const bf16_t*)(ws + OFF_R1);
  const bf16_t* fk = (const bf16_t*)(ws + OFF_R1 + 64 * MiB);
  const bf16_t* fvT = (const bf16_t*)(ws + OFF_R1 + 128 * MiB);
  const bf16_t* fg = (const bf16_t*)(ws + OFF_R1 + 192 * MiB);
  const float* c2 = (const float*)(ws + OFF_C2);
  bf16_t* ab = (bf16_t*)(ws + OFF_AB);
  const float b2 = ((const float*)(ws + OFF_MISC))[1032 + j_odd];
  const int tid = tid_l(); const int lane = tid & 63, wave = __builtin_amdgcn_readfirstlane(tid >> 6), r = lane & 31, hh = lane >> 5;
  for (int rnd = 0; rnd < 4; ++rnd) {
    const int bh = rnd * 8 + (blockIdx.x & 7), pp = blockIdx.x >> 3, b = bh >> 4, h = bh & 15;
    for (int half = 0; half < 2; ++half) {
      const int qb = half == 0 ? 63 - pp : pp;
      const int t0 = qb * 256, tq0 = t0 + wave * 32, tq = tq0 + r;
      const int nkv = (t0 + 256) >> 6, my_last = (tq0 + 31) >> 6;
      const float prune_c = b2 + c2[(size_t)bh * SEQ + t0];
      f32x16 o[2]; float l;
      attn_pass<2, true>(fq + (size_t)(b * SEQ + tq) * 1024 + h * 64, fk + (size_t)(b * SEQ) * 1024 + h * 64, 1024,
                         fvT + (size_t)(bh * 64) * SEQ, c2 + (size_t)bh * SEQ, nkv - 1, my_last, t0 >> 6, tq, prune_c, o, l, lds);
      const float inv = 1.f / l;
      const size_t rowo = (size_t)(b * SEQ + tq) * 1024 + h * 64;
#pragma unroll
      for (int d = 0; d < 2; ++d)
#pragma unroll
        for (int g = 0; g < 4; ++g) {
          const int c = d * 32 + 8 * g + 4 * hh;
          u32x2 gv = *(const u32x2*)(fg + rowo + c);
          const float g0 = __uint_as_float(gv[0] << 16), g1 = __uint_as_float(gv[0] & 0xffff0000u), g2 = __uint_as_float(gv[1] << 16), g3 = __uint_as_float(gv[1] & 0xffff0000u);
          u32x2 ov = {pk2(o[d][4 * g] * inv * g0, o[d][4 * g + 1] * inv * g1), pk2(o[d][4 * g + 2] * inv * g2, o[d][4 * g + 3] * inv * g3)};
          *(u32x2*)(ab + rowo + c) = ov;
        }
    }
  }
}

DI void diff_phase(const Params& p, const int j_even, char* lds) {
  char* ws = (char*)launder(p.ws);
  const bf16_t* bq = (const bf16_t*)(ws + OFF_R1 + 160 * MiB);
  const bf16_t* bk = (const bf16_t*)(ws + OFF_R1 + 192 * MiB);
  const bf16_t* bvT = (const bf16_t*)(ws + OFF_R1 + 224 * MiB);
  bf16_t* ab = (bf16_t*)(ws + OFF_AB);
  const float* misc = (const float*)(ws + OFF_MISC);
  const float lam = misc[1024 + j_even];
  const float lam_init = 0.8f - 0.6f * expf(-0.3f * (float)(2 * j_even));
  const float* dg = ((const float*)p.diff_g) + j_even * 128;
  const int tid = tid_l(); const int lane = tid & 63, wave = __builtin_amdgcn_readfirstlane(tid >> 6), r = lane & 31, hh = lane >> 5;
  {
    const int bh = blockIdx.x & 7, pp = blockIdx.x >> 3, b = bh >> 2, h = bh & 3;
    for (int half = 0; half < 2; ++half) {
      const int qb = half == 0 ? 63 - pp : pp;
      const int t0 = qb * 256, tq0 = t0 + wave * 32, tq = tq0 + r;
      const int nkv = (t0 + 256) >> 6, my_last = tq0 >> 6;
      f32x16 o1[4], o2[4]; float l1, l2;
      attn_pass<4, false>(bq + (size_t)(b * SEQ + tq) * 512 + h * 128, bk + (size_t)(b * SEQ) * 512 + h * 128, 512,
                          bvT + (size_t)(bh * 128) * SEQ, nullptr, nkv - 1, my_last, 0, tq, 0.f, o1, l1, lds);
      const float i1 = 1.f / l1;
      unsigned* o1s = (unsigned*)(lds + DIFF_STASH_OFF) + tid;
#pragma unroll
      for (int d = 0; d < 4; ++d)
#pragma unroll
        for (int i = 0; i < 8; ++i) o1s[(d * 8 + i) * 512] = pk2(o1[d][2 * i] * i1, o1[d][2 * i + 1] * i1);
      attn_pass<4, false>(bq + (size_t)(b * SEQ + tq) * 512 + h * 128 + 64, bk + (size_t)(b * SEQ) * 512 + h * 128 + 64, 512,
                          bvT + (size_t)(bh * 128) * SEQ, nullptr, nkv - 1, my_last, 0, tq, 0.f, o2, l2, lds);
      const float i2 = lam / l2;
      float ssq = 0.f;
#pragma unroll
      for (int d = 0; d < 4; ++d)
#pragma unroll
        for (int i = 0; i < 8; ++i) {
          const unsigned pw = o1s[(d * 8 + i) * 512];
          const float va = __uint_as_float(pw << 16) - i2 * o2[d][2 * i], vb = __uint_as_float(pw & 0xffff0000u) - i2 * o2[d][2 * i + 1];
          o2[d][2 * i] = va; o2[d][2 * i + 1] = vb; ssq += va * va + vb * vb; }
      ssq += xor32(ssq);
      const float rs = rsqrtf(ssq * (1.f / 128.f) + 1e-6f) * (1.f - lam_init);
      const size_t rowo = (size_t)(b * SEQ + tq) * 1024 + 512 + h * 128;
#pragma unroll
      for (int d = 0; d < 4; ++d)
#pragma unroll
        for (int g = 0; g < 4; ++g) {
          const int c = d * 32 + 8 * g + 4 * hh;
          f32x4 gv = *(const f32x4*)(dg + c);
          u32x2 ov = {pk2(o2[d][4 * g] * rs * gv[0], o2[d][4 * g + 1] * rs * gv[1]), pk2(o2[d][4 * g + 2] * rs * gv[2], o2[d][4 * g + 3] * rs * gv[3])};
          *(u32x2*)(ab + rowo + c) = ov;
        }
    }
  }
}

DI void hgrn_stageA(const Params& p, char* lds) {
  char* ws = (char*)launder(p.ws);
  const float* alf = (const float*)(ws + OFF_R1 + 32 * MiB);
  const bf16_t* aiT = (const bf16_t*)(ws + OFF_R1 + 96 * MiB);
  bf16_t* UT = (bf16_t*)(ws + OFF_UT);
  float* dbuf = (float*)(ws + OFF_DB);
  float* lfT = (float*)lds;
  float* part = (float*)(lds + 32768);
  char* KT = lds + 34816;
  char* IT = KT + 18432;
  const int tid = tid_l(), lane = tid & 63, wave = tid >> 6, r = lane & 31, hh = lane >> 5;
  for (int task = blockIdx.x; task < 2048; task += gridDim.x) {
    const int bh = task >> 8, c = task & 255, b = bh >> 2, h = bh & 3;
    const int tok0 = b * SEQ + c * 64;
#pragma unroll
    for (int i = 0; i < 4; ++i) {
      const int idx = tid + 512 * i, row = idx >> 5, c4 = idx & 31;
      *(f32x4*)(lfT + row * 128 + c4 * 4) = *(const f32x4*)(alf + (size_t)(tok0 + row) * 512 + h * 128 + c4 * 4);
    }
#pragma unroll
    for (int i = 0; i < 2; ++i) {
      const int idx = tid + 512 * i, row = idx >> 3, ch = idx & 7;
      *(u32x4*)(IT + row * LROW + ch * 16) = *(const u32x4*)(aiT + (size_t)(bh * 128 + row) * SEQ + c * 64 + ch * 8);
    }
    __syncthreads();
    const int k = tid & 127, seg = tid >> 7;
    float lv[16], bv[16];
    float run = 0.f;
#pragma unroll
    for (int i = 0; i < 16; ++i) { lv[i] = lfT[(seg * 16 + i) * 128 + k]; run += lv[i]; bv[i] = run; }
    part[seg * 128 + k] = run;
    __syncthreads();
    float pre = 0.f, tot = 0.f;
#pragma unroll
    for (int s2 = 0; s2 < 4; ++s2) { const float pv = part[s2 * 128 + k]; if (s2 < seg) pre += pv; tot += pv; }
    {
      float kv[16];
#pragma unroll
      for (int i = 0; i < 16; ++i) kv[i] = (1.f - __expf(lv[i])) * __expf(tot - (pre + bv[i]));
      u32x4 w0 = {pk2(kv[0], kv[1]), pk2(kv[2], kv[3]), pk2(kv[4], kv[5]), pk2(kv[6], kv[7])};
      u32x4 w1 = {pk2(kv[8], kv[9]), pk2(kv[10], kv[11]), pk2(kv[12], kv[13]), pk2(kv[14], kv[15])};
      *(u32x4*)(KT + k * LROW + seg * 32) = w0;
      *(u32x4*)(KT + k * LROW + seg * 32 + 16) = w1;
    }
    if (seg == 0) dbuf[(size_t)task * 128 + k] = __expf(tot);
    __syncthreads();
    {
      const int ktile = wave & 3, vhalf = wave >> 2;
      f32x16 acc[2];
#pragma unroll
      for (int vt = 0; vt < 2; ++vt)
#pragma unroll
        for (int i = 0; i < 16; ++i) acc[vt][i] = 0.f;
#pragma unroll
      for (int ks = 0; ks < 4; ++ks) {
        bf16x8 a = *(const bf16x8*)(KT + (ktile * 32 + r) * LROW + ks * 32 + hh * 16);
#pragma unroll
        for (int vt = 0; vt < 2; ++vt) {
          bf16x8 bb = *(const bf16x8*)(IT + (vhalf * 64 + vt * 32 + r) * LROW + ks * 32 + hh * 16);
          acc[vt] = MFMA32(a, bb, acc[vt]);
        }
      }
#pragma unroll
      for (int vt = 0; vt < 2; ++vt) {
        bf16_t* dst = UT + ((size_t)task * 128 + vhalf * 64 + vt * 32 + r) * 128 + ktile * 32 + 4 * hh;
#pragma unroll
        for (int g = 0; g < 4; ++g) { u32x2 ov = {pk2(acc[vt][4 * g], acc[vt][4 * g + 1]), pk2(acc[vt][4 * g + 2], acc[vt][4 * g + 3])}; *(u32x2*)(dst + 8 * g) = ov; }
      }
    }
    __syncthreads();
  }
}

DI void hgrn_scan(const Params& p) {
  char* ws = (char*)launder(p.ws);
  bf16_t* UT = (bf16_t*)(ws + OFF_UT);
  const float* dbuf = (const float*)(ws + OFF_DB);
  const int gid = blockIdx.x * 512 + tid_l();
  if (gid >= 8 * 16384) return;
  const int bh = gid >> 14, e = gid & 16383;
  bf16_t* up = UT + (size_t)bh * 256 * 16384 + e;
  const float* dp = dbuf + (size_t)bh * 256 * 128 + (e & 127);
  float st = 0.f;
  for (int c0 = 0; c0 < 256; c0 += 32) {
    bf16_t u[32]; float dv[32];
#pragma unroll
    for (int i = 0; i < 32; ++i) { u[i] = up[(size_t)(c0 + i) * 16384]; dv[i] = dp[(size_t)(c0 + i) * 128]; }
#pragma unroll
    for (int i = 0; i < 32; ++i) {
      up[(size_t)(c0 + i) * 16384] = f2bf(st);
      st = dv[i] * st + bf2f(u[i]);
    }
  }
}

constexpr int QROW = 272;
DI void hgrn_stageC(const Params& p, const int j_even, char* lds) {
  char* ws = (char*)launder(p.ws);
  const bf16_t* aq = (const bf16_t*)(ws + OFF_R1);
  const float* alf = (const float*)(ws + OFF_R1 + 32 * MiB);
  const bf16_t* aiT = (const bf16_t*)(ws + OFF_R1 + 96 * MiB);
  const bf16_t* ag = (const bf16_t*)(ws + OFF_R1 + 128 * MiB);
  const bf16_t* UT = (const bf16_t*)(ws + OFF_UT);
  bf16_t* ab = (bf16_t*)(ws + OFF_AB);
  const float* hg = ((const float*)p.hgrn_g) + j_even * 128;
  float* lfT = (float*)lds;
  char* ST = lds;
  char* Q1 = lds + 34816;
  char* Q2 = Q1 + 64 * QROW;
  char* K2 = Q2 + 64 * QROW;
  char* IT = K2 + 64 * QROW;
  float* part = (float*)(IT + 128 * LROW);
  const int tid = tid_l(), lane = tid & 63, wave = tid >> 6, r = lane & 31, hh = lane >> 5;
  for (int task = blockIdx.x; task < 2048; task += gridDim.x) {
    const int bh = task >> 8, c = task & 255, b = bh >> 2, h = bh & 3;
    const int tok0 = b * SEQ + c * 64;
#pragma unroll
    for (int i = 0; i < 4; ++i) {
      const int idx = tid + 512 * i, row = idx >> 5, c4 = idx & 31;
      *(f32x4*)(lfT + row * 128 + c4 * 4) = *(const f32x4*)(alf + (size_t)(tok0 + row) * 512 + h * 128 + c4 * 4);
    }
#pragma unroll
    for (int i = 0; i < 2; ++i) {
      const int idx = tid + 512 * i, row = idx >> 3, ch = idx & 7;
      *(u32x4*)(IT + row * LROW + ch * 16) = *(const u32x4*)(aiT + (size_t)(bh * 128 + row) * SEQ + c * 64 + ch * 8);
    }
    u32x4 sreg[4];
#pragma unroll
    for (int i = 0; i < 4; ++i) sreg[i] = *(const u32x4*)(UT + (size_t)task * 16384 + (size_t)(tid + 512 * i) * 8);
    __syncthreads();
    const int k = tid & 127, seg = tid >> 7;
    float lv[16], bv[16];
    float run = 0.f;
#pragma unroll
    for (int i = 0; i < 16; ++i) { lv[i] = lfT[(seg * 16 + i) * 128 + k]; run += lv[i]; bv[i] = run; }
    part[seg * 128 + k] = run;
    __syncthreads();
    {
      const float p0 = part[k], p1 = part[128 + k], p2 = part[256 + k];
      const float pre = (seg > 0 ? p0 : 0.f) + (seg > 1 ? p1 : 0.f) + (seg > 2 ? p2 : 0.f);
      const float bmid = p0 + p1;
#pragma unroll
      for (int i = 0; i < 16; ++i) {
        const int t = seg * 16 + i;
        const float bt = pre + bv[i];
        const float qv = bf2f(aq[(size_t)(tok0 + t) * 512 + h * 128 + k]);
        const float kk = 1.f - __expf(lv[i]);
        *(bf16_t*)(Q1 + t * QROW + k * 2) = f2bf(qv * __expf(bt));
        *(bf16_t*)(Q2 + t * QROW + k * 2) = f2bf(qv * __expf(fminf(bt - bmid, 80.f)));
        *(bf16_t*)(K2 + t * QROW + k * 2) = f2bf(kk * __expf(fminf(bmid - bt, 80.f)));
      }
    }
#pragma unroll
    for (int i = 0; i < 4; ++i) { const int idx = tid + 512 * i, row = idx >> 4, ch = idx & 15; *(u32x4*)(ST + row * QROW + ch * 16) = sreg[i]; }
    __syncthreads();
    {
      const int vt = wave & 3, tt = wave >> 2;
      const int t = tt * 32 + r;
      f32x16 sc[2];
#pragma unroll
      for (int st = 0; st < 2; ++st)
#pragma unroll
        for (int i = 0; i < 16; ++i) sc[st][i] = 0.f;
#pragma unroll
      for (int ks = 0; ks < 8; ++ks) {
        bf16x8 qb = *(const bf16x8*)(Q2 + t * QROW + ks * 32 + hh * 16);
#pragma unroll
        for (int st = 0; st < 2; ++st) {
          if (st <= tt) {
            bf16x8 a = *(const bf16x8*)(K2 + (st * 32 + r) * QROW + ks * 32 + hh * 16);
            sc[st] = MFMA32(a, qb, sc[st]);
          }
        }
      }
      f32x16 acc;
#pragma unroll
      for (int i = 0; i < 16; ++i) acc[i] = 0.f;
#pragma unroll
      for (int st = 0; st < 2; ++st) {
        if (st <= tt) {
#pragma unroll
          for (int i = 0; i < 16; ++i) { const int s = st * 32 + (i & 3) + 8 * (i >> 2) + 4 * hh; if (s > t) sc[st][i] = 0.f; }
#pragma unroll
          for (int s2 = 0; s2 < 2; ++s2) {
            u32x4 pw = {pk2(sc[st][8 * s2], sc[st][8 * s2 + 1]), pk2(sc[st][8 * s2 + 2], sc[st][8 * s2 + 3]), pk2(sc[st][8 * s2 + 4], sc[st][8 * s2 + 5]), pk2(sc[st][8 * s2 + 6], sc[st][8 * s2 + 7])};
            const bf16x8 pf = __builtin_bit_cast(bf16x8, pw);
            const char* ip = IT + (vt * 32 + r) * LROW + (st * 32 + 16 * s2 + 4 * hh) * 2;
            u32x2 lo = *(const u32x2*)ip, hi = *(const u32x2*)(ip + 16);
            u32x4 aw = {lo[0], lo[1], hi[0], hi[1]};
            acc = MFMA32(__builtin_bit_cast(bf16x8, aw), pf, acc);
          }
        }
      }
#pragma unroll
      for (int ks = 0; ks < 8; ++ks) {
        bf16x8 a = *(const bf16x8*)(ST + (vt * 32 + r) * QROW + ks * 32 + hh * 16);
        bf16x8 qb = *(const bf16x8*)(Q1 + t * QROW + ks * 32 + hh * 16);
        acc = MFMA32(a, qb, acc);
      }
      float ssq = 0.f;
#pragma unroll
      for (int i = 0; i < 16; ++i) ssq += acc[i] * acc[i];
      ssq += xor32(ssq);
      if (hh == 0) part[vt * 64 + t] = ssq;
      __syncthreads();
      const float tot = part[t] + part[64 + t] + part[128 + t] + part[192 + t];
      const float rs = rsqrtf(tot * (1.f / 128.f) + 1e-6f);
      const size_t go = (size_t)(tok0 + t) * 512 + h * 128 + vt * 32 + 4 * hh;
      const size_t oo = (size_t)(tok0 + t) * 1024 + h * 128 + vt * 32 + 4 * hh;
#pragma unroll
      for (int g = 0; g < 4; ++g) {
        f32x4 gn = *(const f32x4*)(hg + vt * 32 + 4 * hh + 8 * g);
        u32x2 gv = *(const u32x2*)(ag + go + 8 * g);
        const float g0 = __uint_as_float(gv[0] << 16), g1 = __uint_as_float(gv[0] & 0xffff0000u), g2 = __uint_as_float(gv[1] << 16), g3 = __uint_as_float(gv[1] & 0xffff0000u);
        u32x2 ov = {pk2(acc[4 * g] * rs * gn[0] * g0, acc[4 * g + 1] * rs * gn[1] * g1), pk2(acc[4 * g + 2] * rs * gn[2] * g2, acc[4 * g + 3] * rs * gn[3] * g3)};
        *(u32x2*)(ab + oo + 8 * g) = ov;
      }
    }
    __syncthreads();
  }
}

DI void grid_barrier(unsigned* ctr, const unsigned target) {
  asm volatile("s_waitcnt vmcnt(0)" ::: "memory");
  __syncthreads();
  if (threadIdx.x == 0) {
    __builtin_amdgcn_fence(__ATOMIC_RELEASE, "agent");
    asm volatile("s_waitcnt vmcnt(0)" ::: "memory");
    __hip_atomic_fetch_add((GAS unsigned*)ctr, 1u, __ATOMIC_RELAXED, __HIP_MEMORY_SCOPE_AGENT);
    while (__hip_atomic_load((GAS unsigned*)ctr, __ATOMIC_RELAXED, __HIP_MEMORY_SCOPE_AGENT) < target) __builtin_amdgcn_s_sleep(1);
    __builtin_amdgcn_fence(__ATOMIC_ACQUIRE, "agent");
    asm volatile("s_waitcnt vmcnt(0)" ::: "memory");
  }
  __syncthreads();
}
typedef const __attribute__((address_space(4))) Params* kparams_t;
#if defined(__HIP_DEVICE_COMPILE__)
DI kparams_t launder_k(kparams_t q) { asm volatile("" : "+s"(q)); return q; }
#endif
#if defined(__HIP_DEVICE_COMPILE__)
#define KPARAMS (*launder_k((kparams_t)__builtin_amdgcn_kernarg_segment_ptr()))
#else
#define KPARAMS p_arg
#endif
__global__ void __launch_bounds__(512) fwd_mega(Params p_arg) {
  extern __shared__ __attribute__((aligned(16))) char lds[];
  int ph = 0;
  const int p_lo = p_arg.lo, p_hi = p_arg.hi;
#define PHASE(id, ...) { if (ph >= p_lo && ph < p_hi) { const Params p = KPARAMS; char* ws = (char*)launder(p.ws); float* outp = (float*)launder((GAS char*)p.out); bf16_t* ab = (bf16_t*)(ws + OFF_AB); (void)outp; (void)ab; \
    if (ONLY < 0 || ONLY == id) { __VA_ARGS__; } if ((DUPMASK >> id) & 1) { __syncthreads(); __VA_ARGS__; } if (ph + 1 < p_hi) { if (ph == p_lo) cg::this_grid().sync(); else grid_barrier((unsigned*)(ws + OFF_CNT) + 256, (unsigned)(ph - p_lo) * gridDim.x); } } ++ph; }
  PHASE(0, phase0(p, lds));
  for (int l = 0; l < 4; ++l) {
    const int j = l >> 1;
    if ((l & 1) == 0) {
      PHASE(1,
        EpiEvenIn e;
        e.r1 = ws + OFF_R1; e.lb = (const float*)(ws + OFF_MISC) + j * 512;
        gemm_phase(ab, 1024, (const bf16_t*)(ws + OFF_WEI) + (size_t)j * EVEN_IN * D, EVEN_IN, D, e, lds));
      PHASE(2, hgrn_stageA(p, lds));
      PHASE(3, hgrn_scan(p));
      PHASE(4, hgrn_stageC(p, j, lds); diff_phase(p, j, lds));
      PHASE(6,
        EpiResLN er; er.xin = (l == 0) ? (const float*)launder((GAS char*)p.x_in) : outp; er.xout = outp; er.xb = ab;
        er.g = ((const float*)p.ln1g) + l * D; er.b = ((const float*)p.ln1b) + l * D;
        er.xchg = (float*)(ws + OFF_XCHG); er.cnt = (unsigned*)(ws + OFF_CNT); er.target = 4u * (unsigned)(2 * l + 1);
        gemm_phase(ab, 1024, (const bf16_t*)(ws + OFF_WEO) + (size_t)j * D * D, D, D, er, lds));
    } else {
      PHASE(7,
        EpiOddIn e;
        e.r1 = ws + OFF_R1;
        e.lf = (float*)(ws + OFF_LF); e.qg = ((const float*)p.fox_qg) + j * 64; e.kg = ((const float*)p.fox_kg) + j * 64; e.bf = ((const float*)p.fox_bf) + j * 16;
        gemm_phase(ab, 1024, (const bf16_t*)(ws + OFF_WFI) + (size_t)j * ODD_PAD * D, ODD_PAD, D, e, lds));
      PHASE(8, cumsum_phase((const float*)(ws + OFF_LF), (float*)(ws + OFF_C2), lds));
      PHASE(9, fox_phase(p, j, lds));
      PHASE(6,
        EpiResLN er; er.xin = outp; er.xout = outp; er.xb = ab;
        er.g = ((const float*)p.ln1g) + l * D; er.b = ((const float*)p.ln1b) + l * D;
        er.xchg = (float*)(ws + OFF_XCHG); er.cnt = (unsigned*)(ws + OFF_CNT); er.target = 4u * (unsigned)(2 * l + 1);
        gemm_phase(ab, 1024, (const bf16_t*)(ws + OFF_WFO) + (size_t)j * D * D, D, D, er, lds));
    }
    PHASE(11,
      EpiW1 e1; e1.act = (bf16_t*)(ws + OFF_R1);
      gemm_phase(ab, 1024, (const bf16_t*)(ws + OFF_W1) + (size_t)l * 2 * DFF * D, 2 * DFF, D, e1, lds));
    PHASE(6,
      EpiResLN e2; e2.xin = outp; e2.xout = outp; e2.xb = ab;
      e2.g = ((const float*)p.ln2g) + l * D; e2.b = ((const float*)p.ln2b) + l * D;
      e2.xchg = (float*)(ws + OFF_XCHG); e2.cnt = (unsigned*)(ws + OFF_CNT); e2.target = 4u * (unsigned)(2 * l + 2);
      gemm_phase((const bf16_t*)(ws + OFF_R1), DFF, (const bf16_t*)(ws + OFF_W2) + (size_t)l * D * DFF, D, DFF, e2, lds));
  }
#undef PHASE
}
constexpr int N_PHASES = 1 + 2 * 7 + 2 * 6;

extern "C" void kernel_launch(void* const* d_in, const int* in_sizes, int n_in, void* d_out, int out_size, void* d_ws, size_t ws_size, hipStream_t stream) {
  static bool attr = false;
  if (!attr) { hipFuncSetAttribute((const void*)fwd_mega, hipFuncAttributeMaxDynamicSharedMemorySize, LDS_BYTES); attr = true; }
  Params p{};
  p.x_in = (const GAS float*)d_in[0];
  p.even_w_in = (const GAS float*)d_in[1]; p.even_w_out = (const GAS float*)d_in[2]; p.lb_logits = (const GAS float*)d_in[3];
  p.lq1 = (const GAS float*)d_in[4]; p.lk1 = (const GAS float*)d_in[5]; p.lq2 = (const GAS float*)d_in[6]; p.lk2 = (const GAS float*)d_in[7];
  p.hgrn_g = (const GAS float*)d_in[8]; p.diff_g = (const GAS float*)d_in[9];
  p.fox_w_in = (const GAS float*)d_in[10]; p.fox_w_out = (const GAS float*)d_in[11]; p.fox_bf = (const GAS float*)d_in[12];
  p.fox_qg = (const GAS float*)d_in[13]; p.fox_kg = (const GAS float*)d_in[14];
  p.w1 = (const GAS float*)d_in[15]; p.w2 = (const GAS float*)d_in[16];
  p.ln1g = (const GAS float*)d_in[17]; p.ln1b = (const GAS float*)d_in[18]; p.ln2g = (const GAS float*)d_in[19]; p.ln2b = (const GAS float*)d_in[20];
  p.out = (GAS float*)d_out; p.ws = (GAS char*)d_ws;
#if COOP
  p.lo = 0; p.hi = N_PHASES;
  void* args[] = {&p};
  hipError_t e = hipLaunchCooperativeKernel((const void*)fwd_mega, dim3(256), dim3(512), args, LDS_BYTES, stream);
  if (e != hipSuccess) fprintf(stderr, "cooperative launch failed: %s\n", hipGetErrorString(e));
#else
  for (int ph = 0; ph < N_PHASES; ++ph) {
    p.lo = ph; p.hi = ph + 1;
    hipLaunchKernelGGL(fwd_mega, dim3(256), dim3(512), LDS_BYTES, stream, p);
  }
#endif
}
```

```cpp
#include <hip/hip_runtime.h>
#include <hip/hip_cooperative_groups.h>
#include <cstdio>
#include <cstdint>
namespace cg = cooperative_groups;

#ifndef COOP
#define COOP 1
#endif
#ifndef ONLY
#define ONLY -1
#endif
#ifndef DUPMASK
#define DUPMASK 0
#endif

typedef unsigned short bf16_t;
typedef short bf16x8 __attribute__((ext_vector_type(8)));
typedef float f32x16 __attribute__((ext_vector_type(16)));
typedef float f32x4 __attribute__((ext_vector_type(4)));
typedef float f32x2 __attribute__((ext_vector_type(2)));
typedef unsigned u32x4 __attribute__((ext_vector_type(4)));
typedef unsigned u32x2 __attribute__((ext_vector_type(2)));
typedef __bf16 bf16x2v __attribute__((ext_vector_type(2)));

#define DI __device__ __forceinline__
#define MFMA32(a, b, c) __builtin_amdgcn_mfma_f32_32x32x16_bf16((a), (b), (c), 0, 0, 0)

constexpr int D = 1024, SEQ = 16384, NTOK = 32768, DFF = 2816;
constexpr int EVEN_IN = 3584, ODD_IN = 4112, ODD_PAD = 4352;
constexpr float ALPHA = 1.6817928305074290f;
constexpr float LOG2E = 1.4426950408889634f;
constexpr size_t MiB = 1u << 20;

constexpr size_t OFF_WEI = 0;
constexpr size_t OFF_WEO = OFF_WEI + (size_t)2 * EVEN_IN * D * 2;
constexpr size_t OFF_WFI = OFF_WEO + (size_t)2 * D * D * 2;
constexpr size_t OFF_WFO = OFF_WFI + (size_t)2 * ODD_PAD * D * 2;
constexpr size_t OFF_W1  = OFF_WFO + (size_t)2 * D * D * 2;
constexpr size_t OFF_W2  = OFF_W1 + (size_t)4 * 2 * DFF * D * 2;
constexpr size_t W_END   = OFF_W2 + (size_t)4 * D * DFF * 2;
static_assert(W_END <= 105 * MiB, "weights region");
constexpr size_t OFF_R1 = 105 * MiB;
constexpr size_t OFF_AB = 361 * MiB;
constexpr size_t OFF_UT = 425 * MiB;
constexpr size_t OFF_DB = 489 * MiB;
constexpr size_t OFF_LF = 490 * MiB;
constexpr size_t OFF_C2 = 492 * MiB;
constexpr size_t OFF_MISC = 494 * MiB;
constexpr size_t OFF_CNT = OFF_MISC + 80 * 1024;
constexpr size_t OFF_XCHG = OFF_MISC + 128 * 1024;

#define GAS __attribute__((address_space(1)))
struct Params {
  const GAS float* x_in;
  const GAS float *even_w_in, *even_w_out, *lb_logits, *lq1, *lk1, *lq2, *lk2, *hgrn_g, *diff_g;
  const GAS float *fox_w_in, *fox_w_out, *fox_bf, *fox_qg, *fox_kg;
  const GAS float *w1, *w2, *ln1g, *ln1b, *ln2g, *ln2b;
  GAS float* out;
  GAS char* ws;
  int lo, hi;
};

DI unsigned pk2(float lo, float hi) { f32x2 v = {lo, hi}; bf16x2v b = __builtin_convertvector(v, bf16x2v); return __builtin_bit_cast(unsigned, b); }
DI bf16_t f2bf(float x) { return (bf16_t)(pk2(x, 0.f) & 0xffffu); }
DI float bf2f(bf16_t v) { return __uint_as_float(((unsigned)v) << 16); }
DI float sigmoidf_(float x) { return __builtin_amdgcn_rcpf(1.f + __builtin_amdgcn_exp2f(-LOG2E * x)); }
DI float siluf_(float x) { return x * __builtin_amdgcn_rcpf(1.f + __builtin_amdgcn_exp2f(-LOG2E * x)); }
DI GAS char* launder(GAS char* q) { asm volatile("" : "+s"(q)); return q; }
DI int tid_l() { int t = threadIdx.x; asm volatile("" : "+v"(t)); return t; }
DI int swz32(int s) { return (s & ~12) | ((s & 4) << 1) | ((s & 8) >> 1); }
DI float xor32(float v) { return __shfl_xor(v, 32, 64); }

DI void convert_w(const float* __restrict__ w, bf16_t* __restrict__ wt, int K, int N, int Npad, int mode, float* tl) {
  const int tid = tid_l();
  const int nkt = K >> 6, nnt = Npad >> 6;
  for (int tile = blockIdx.x; tile < nkt * nnt; tile += gridDim.x) {
    const int k0 = (tile / nnt) << 6, n0 = (tile % nnt) << 6;
#pragma unroll
    for (int i = 0; i < 2; ++i) {
      const int kk = (tid >> 4) + 32 * i, n4 = (tid & 15) << 2;
      const int np = n0 + n4;
      int src = np;
      if (mode == 1) { const int grp = np >> 6, j = np & 63; src = (j < 32) ? grp * 32 + j : DFF + grp * 32 + (j - 32); }
      f32x4 v = {0.f, 0.f, 0.f, 0.f};
      if (src < N) v = *(const f32x4*)(w + (size_t)(k0 + kk) * N + src);
      tl[kk * 65 + n4 + 0] = v[0]; tl[kk * 65 + n4 + 1] = v[1]; tl[kk * 65 + n4 + 2] = v[2]; tl[kk * 65 + n4 + 3] = v[3];
    }
    __syncthreads();
    {
      const int n = tid >> 3, kc = (tid & 7) << 3;
      float f[8];
#pragma unroll
      for (int j = 0; j < 8; ++j) f[j] = tl[(kc + j) * 65 + n];
      u32x4 o = {pk2(f[0], f[1]), pk2(f[2], f[3]), pk2(f[4], f[5]), pk2(f[6], f[7])};
      *(u32x4*)(wt + (size_t)(n0 + n) * K + k0 + kc) = o;
    }
    __syncthreads();
  }
}

DI void phase0(const Params& p, char* lds) {
  float* tl = (float*)lds;
  char* ws = (char*)launder(p.ws);
  for (int j = 0; j < 2; ++j) {
    convert_w(((const float*)p.even_w_in) + (size_t)j * D * EVEN_IN, (bf16_t*)(ws + OFF_WEI) + (size_t)j * EVEN_IN * D, D, EVEN_IN, EVEN_IN, 0, tl);
    convert_w(((const float*)p.even_w_out) + (size_t)j * D * D, (bf16_t*)(ws + OFF_WEO) + (size_t)j * D * D, D, D, D, 0, tl);
    convert_w(((const float*)p.fox_w_in) + (size_t)j * D * ODD_IN, (bf16_t*)(ws + OFF_WFI) + (size_t)j * ODD_PAD * D, D, ODD_IN, ODD_PAD, 0, tl);
    convert_w(((const float*)p.fox_w_out) + (size_t)j * D * D, (bf16_t*)(ws + OFF_WFO) + (size_t)j * D * D, D, D, D, 0, tl);
  }
  for (int l = 0; l < 4; ++l) {
    convert_w(((const float*)p.w1) + (size_t)l * D * 2 * DFF, (bf16_t*)(ws + OFF_W1) + (size_t)l * 2 * DFF * D, D, 2 * DFF, 2 * DFF, 1, tl);
    convert_w(((const float*)p.w2) + (size_t)l * DFF * D, (bf16_t*)(ws + OFF_W2) + (size_t)l * D * DFF, DFF, D, D, 0, tl);
  }
  {
    bf16_t* ab = (bf16_t*)(ws + OFF_AB);
    const size_t n8 = (size_t)NTOK * D / 8;
    for (size_t i = (size_t)blockIdx.x * 512 + tid_l(); i < n8; i += (size_t)gridDim.x * 512) {
      f32x4 a = *(const f32x4*)(((const float*)p.x_in) + i * 8), b = *(const f32x4*)(((const float*)p.x_in) + i * 8 + 4);
      u32x4 o = {pk2(a[0], a[1]), pk2(a[2], a[3]), pk2(b[0], b[1]), pk2(b[2], b[3])};
      *(u32x4*)(ab + i * 8) = o;
    }
  }
  if (blockIdx.x == 0) { const int t_ = tid_l(); if (t_ < 128) ((unsigned*)(ws + OFF_CNT))[t_] = 0u; if (t_ == 128) ((unsigned*)(ws + OFF_CNT))[256] = 0u; }
  if (blockIdx.x == 0) {
    float* misc = (float*)(ws + OFF_MISC);
    const int tid = tid_l();
    {
      const float l0 = ((const float*)p.lb_logits)[tid], l1 = ((const float*)p.lb_logits)[512 + tid];
      const float mx = fmaxf(l0, l1);
      const float e0 = expf(l0 - mx), e1 = expf(l1 - mx);
      const float s0 = e0 / (e0 + e1), s1 = e1 / (e0 + e1);
      misc[tid] = s0 - s0;
      misc[512 + tid] = (s0 + s1) - s0;
    }
    if (tid < 2) {
      float d1 = 0.f, d2 = 0.f;
      for (int i = 0; i < 64; ++i) { d1 += ((const float*)p.lq1)[tid * 64 + i] * ((const float*)p.lk1)[tid * 64 + i]; d2 += ((const float*)p.lq2)[tid * 64 + i] * ((const float*)p.lk2)[tid * 64 + i]; }
      const float lam_init = 0.8f - 0.6f * expf(-0.3f * (float)(2 * tid));
      misc[1024 + tid] = expf(d1) - expf(d2) + lam_init;
      float mq = 0.f, mk = 0.f;
      for (int i = 0; i < 64; ++i) { mq = fmaxf(mq, fabsf(((const float*)p.fox_qg)[tid * 64 + i])); mk = fmaxf(mk, fabsf(((const float*)p.fox_kg)[tid * 64 + i])); }
      const float B = 0.125f * LOG2E * 64.f * mq * mk * 1.02f;
      misc[1032 + tid] = 2.f * B + 8.f;
    }
  }
}

constexpr int LROW = 144;
constexpr int G_XB = 256 * LROW, G_WB = 256 * LROW, G_STAGE = G_XB + G_WB;
constexpr int DIFF_STASH_OFF = 2 * (64 * LROW + 128 * LROW + 256);
constexpr int LDS_BYTES = 2 * G_STAGE;
static_assert(LDS_BYTES >= DIFF_STASH_OFF + 512 * 32 * 4, "lds");

template <class Epi>
DI void gemm_phase(const bf16_t* __restrict__ X, const int ldx, const bf16_t* __restrict__ Wt, const int N, const int K, const Epi& epi, char* lds) {
  const int tid = tid_l(), lane = tid & 63, wave = tid >> 6;
  const int r = lane & 31, hh = lane >> 5;
  const int tw = wave & 3, fw = wave >> 2;
  const int nNt = N >> 8;
  const int ntiles = nNt * (NTOK / 256);
  const int nk = K >> 6;
  const int lrow = tid >> 3, lch = tid & 7;
  const int xcd = blockIdx.x & 7, slot = blockIdx.x >> 3, nchunks = 4 * nNt;
  (void)ntiles;
  u32x4 xr0[4], wr0[4];
  for (int chunk = xcd; chunk < nchunks; chunk += 8) {
    const int L = chunk * 32 + slot, band = L / (4 * nNt), rem = L % (4 * nNt);
    const int mt_ = band * 4 + (rem & 3), nt_ = rem >> 2;
    const char* Xt = (const char*)(X + (size_t)(mt_ * 256) * ldx);
    const char* Wtb = (const char*)(Wt + (size_t)(nt_ * 256) * K);
    const unsigned xoff = (unsigned)(lrow * ldx + lch * 8) * 2u, woff = (unsigned)(lrow * K + lch * 8) * 2u;
    const bool has_next = (chunk + 8 < nchunks);
    const int Ln = (has_next ? chunk + 8 : chunk) * 32 + slot, band_n = Ln / (4 * nNt), rem_n = Ln % (4 * nNt);
    const char* Xt_n = (const char*)(X + (size_t)((band_n * 4 + (rem_n & 3)) * 256) * ldx);
    const char* Wtb_n = (const char*)(Wt + (size_t)((rem_n >> 2) * 256) * K);
    f32x16 acc[2][2][2];
#define G_GLOAD(XR, WR, KT) { _Pragma("unroll") for (int i_ = 0; i_ < 4; ++i_) XR[i_] = *(const u32x4*)(Xt + ((size_t)(64 * i_) * ldx + (KT) * 64) * 2 + xoff); \
    _Pragma("unroll") for (int i_ = 0; i_ < 4; ++i_) WR[i_] = *(const u32x4*)(Wtb + ((size_t)(64 * i_) * K + (KT) * 64) * 2 + woff); }
#define G_LSTORE(XR, WR, STG) { char* xs_ = lds + (STG) * G_STAGE; char* ws_ = xs_ + G_XB; \
    _Pragma("unroll") for (int i_ = 0; i_ < 4; ++i_) *(u32x4*)(xs_ + (lrow + 64 * i_) * LROW + lch * 16) = XR[i_]; \
    _Pragma("unroll") for (int i_ = 0; i_ < 4; ++i_) *(u32x4*)(ws_ + (lrow + 64 * i_) * LROW + lch * 16) = WR[i_]; }
#define G_PART(Q, STG, KT, DOLOAD) { char* xs_ = lds + (STG) * G_STAGE; char* ws_ = xs_ + G_XB; \
    if ((Q) < 2) { _Pragma("unroll") for (int i_ = 2 * (Q); i_ < 2 * (Q) + 2; ++i_) { *(u32x4*)(xs_ + (lrow + 64 * i_) * LROW + lch * 16) = xr0[i_]; \
        if (DOLOAD) xr0[i_] = *(const u32x4*)(xb_ + ((size_t)(64 * i_) * ldx + (KT) * 64) * 2 + xoff); } } \
    else { _Pragma("unroll") for (int i_ = 2 * ((Q) - 2); i_ < 2 * ((Q) - 2) + 2; ++i_) { *(u32x4*)(ws_ + (lrow + 64 * i_) * LROW + lch * 16) = wr0[i_]; \
        if (DOLOAD) wr0[i_] = *(const u32x4*)(wb_ + ((size_t)(64 * i_) * K + (KT) * 64) * 2 + woff); } } \
    __builtin_amdgcn_sched_barrier(0); }
#define G_LDX(XF, KS) { _Pragma("unroll") for (int m = 0; m < 2; ++m) XF[m] = *(const bf16x8*)(xs + (tw * 64 + m * 32 + r) * LROW + (KS) * 32 + hh * 16); }
#define G_LDW(WF, N0, KS) { _Pragma("unroll") for (int n = 0; n < 2; ++n) WF[n] = *(const bf16x8*)(wsm + (fw * 128 + ((N0) + n) * 32 + r) * LROW + (KS) * 32 + hh * 16); }
#define G_MFMA4S(XF, WF, H) { _Pragma("unroll") for (int n = 0; n < 2; ++n) _Pragma("unroll") for (int m = 0; m < 2; ++m) acc[H][n][m] = MFMA32(XF[m], WF[n], acc[H][n][m]); }
#define G_MFMA4(XF, WF, H) { _Pragma("unroll") for (int n = 0; n < 2; ++n) _Pragma("unroll") for (int m = 0; m < 2; ++m) acc[H][n][m] = MFMA32(WF[n], XF[m], acc[H][n][m]); }
#define G_STEP(MM, KS, XC, XN) { G_LDW(wc, 2, KS); if ((KS) < 3) { G_LDX(XN, (KS) + 1); } __builtin_amdgcn_sched_barrier(0); \
    MM(XC, w01, 0); __builtin_amdgcn_sched_barrier(0); if ((KS) < 3) { G_LDW(w01, 0, (KS) + 1); } MM(XC, wc, 1); __builtin_amdgcn_sched_barrier(0); }
#define G_COMPUTE_ST(MM, STG, DOSTORE, NSTG, KTL, DOLOAD) { const char* xs = lds + (STG) * G_STAGE; const char* wsm = xs + G_XB; \
    bf16x8 xfa[2], xfb[2], w01[2], wc[2]; \
    G_LDX(xfa, 0); G_LDW(w01, 0, 0); \
    if (DOSTORE) G_PART(0, NSTG, KTL, DOLOAD); \
    G_STEP(MM, 0, xfa, xfb); if (DOSTORE) G_PART(1, NSTG, KTL, DOLOAD); \
    G_STEP(MM, 1, xfb, xfa); if (DOSTORE) G_PART(2, NSTG, KTL, DOLOAD); \
    G_STEP(MM, 2, xfa, xfb); if (DOSTORE) G_PART(3, NSTG, KTL, DOLOAD); \
    G_STEP(MM, 3, xfb, xfa); }
#define G_COMPUTE(MM, STG) { const char* xs = lds + (STG) * G_STAGE; const char* wsm = xs + G_XB; \
    bf16x8 xfa[2], xfb[2], w01[2], wc[2]; \
    G_LDX(xfa, 0); G_LDW(w01, 0, 0); \
    G_STEP(MM, 0, xfa, xfb); G_STEP(MM, 1, xfb, xfa); G_STEP(MM, 2, xfa, xfb); G_STEP(MM, 3, xfb, xfa); }
    asm volatile("" ::: "memory");
    if (chunk == xcd) {
      G_GLOAD(xr0, wr0, 0);
      G_LSTORE(xr0, wr0, 0);
      __syncthreads();
      G_GLOAD(xr0, wr0, 1);
    }
#pragma unroll
    for (int c = 0; c < 2; ++c)
#pragma unroll
      for (int a = 0; a < 2; ++a)
#pragma unroll
        for (int b = 0; b < 2; ++b)
#pragma unroll
          for (int i = 0; i < 16; ++i) acc[c][a][b][i] = 0.f;
#define G_KLOOP(MM) for (int kt = 0; kt < nk; kt += 2) { \
        \
        \
      { const bool in_ = (kt + 2 < nk); const char* xb_ = in_ ? Xt : Xt_n; const char* wb_ = in_ ? Wtb : Wtb_n; \
        const int k2_ = in_ ? kt + 2 : (has_next ? 0 : nk - 1); G_COMPUTE_ST(MM, 0, true, 1, k2_, true); } \
      __syncthreads(); \
      { const bool in_ = (kt + 3 < nk); const char* xb_ = in_ ? Xt : Xt_n; const char* wb_ = in_ ? Wtb : Wtb_n; \
        const int k3_ = in_ ? kt + 3 : (has_next ? 1 : nk - 1); G_COMPUTE_ST(MM, 1, true, 0, k3_, true); } \
      __syncthreads(); \
    }
    const bool sw = Epi::kSwap && epi.swap_tile(nt_);
#define G_EPI_IDS const int t2 = tid_l(); const int r2 = t2 & 31, hh2 = (t2 >> 5) & 1, tw2 = (t2 >> 6) & 3, fw2 = t2 >> 8;
    if (sw) {
      G_KLOOP(G_MFMA4S)
      if constexpr (Epi::kSwap) {
        G_EPI_IDS
        epi.swapped(mt_ * 256 + tw2 * 64, nt_ * 256 + fw2 * 128, acc[0], r2, hh2);
        __builtin_amdgcn_sched_barrier(0);
        epi.swapped(mt_ * 256 + tw2 * 64, nt_ * 256 + fw2 * 128 + 64, acc[1], r2, hh2);
      }
    } else {
      G_KLOOP(G_MFMA4)
      G_EPI_IDS
      if constexpr (Epi::kFull) {
        epi.full(mt_, nt_, acc, tw2, fw2, r2, hh2, lds, t2);
      } else {
        epi(mt_ * 256 + tw2 * 64, nt_ * 256 + fw2 * 128, acc[0], r2, hh2);
        __builtin_amdgcn_sched_barrier(0);
        epi(mt_ * 256 + tw2 * 64, nt_ * 256 + fw2 * 128 + 64, acc[1], r2, hh2);
      }
    }
#undef G_EPI_IDS
#undef G_KLOOP
#undef G_GLOAD
#undef G_LSTORE
#undef G_COMPUTE
#undef G_PART
#undef G_COMPUTE_ST
#undef G_LDX
#undef G_LDW
#undef G_MFMA4
#undef G_MFMA4S
#undef G_STEP
    __builtin_amdgcn_sched_barrier(0);
  }
}

struct EpiEvenIn {
  static constexpr bool kFull = false, kSwap = false;
  DI bool swap_tile(int nt_) const { const int seg = nt_ >> 1; return seg == 2 || seg == 6; }
  char* r1; const float* lb;
#define aq  ((bf16_t*)(r1))
#define alf ((float*)(r1 + 32 * MiB))
#define aiT ((bf16_t*)(r1 + 96 * MiB))
#define ag  ((bf16_t*)(r1 + 128 * MiB))
#define bq  ((bf16_t*)(r1 + 160 * MiB))
#define bk  ((bf16_t*)(r1 + 192 * MiB))
#define bvT ((bf16_t*)(r1 + 224 * MiB))
  DI void operator()(int tok0, int feat0, f32x16 (&acc)[2][2], int r, int hh) const {
    const int seg = feat0 >> 9, c0 = feat0 & 511;
#pragma unroll
    for (int mt = 0; mt < 2; ++mt) {
      const int tok = tok0 + mt * 32 + r, b = tok >> 14, s = tok & (SEQ - 1);
#pragma unroll
      for (int nt = 0; nt < 2; ++nt)
#pragma unroll
        for (int g = 0; g < 4; ++g) {
          const int c = c0 + nt * 32 + 8 * g + 4 * hh;
          const float v0 = acc[nt][mt][4 * g], v1 = acc[nt][mt][4 * g + 1], v2 = acc[nt][mt][4 * g + 2], v3 = acc[nt][mt][4 * g + 3];
          if (seg == 0) { u32x2 o = {pk2(siluf_(v0), siluf_(v1)), pk2(siluf_(v2), siluf_(v3))}; *(u32x2*)(aq + (size_t)tok * 512 + c) = o; }
          else if (seg == 1) {
            f32x4 lbv = *(const f32x4*)(lb + c);
            f32x4 o;
            o[0] = __logf(lbv[0] + (1.f - lbv[0]) * sigmoidf_(v0)); o[1] = __logf(lbv[1] + (1.f - lbv[1]) * sigmoidf_(v1));
            o[2] = __logf(lbv[2] + (1.f - lbv[2]) * sigmoidf_(v2)); o[3] = __logf(lbv[3] + (1.f - lbv[3]) * sigmoidf_(v3));
            *(f32x4*)(alf + (size_t)tok * 512 + c) = o;
          }
          else if (seg == 3) { u32x2 o = {pk2(siluf_(v0), siluf_(v1)), pk2(siluf_(v2), siluf_(v3))}; *(u32x2*)(ag + (size_t)tok * 512 + c) = o; }
          else if (seg == 4) { const float sc = 0.125f * LOG2E; u32x2 o = {pk2(v0 * sc, v1 * sc), pk2(v2 * sc, v3 * sc)}; *(u32x2*)(bq + (size_t)tok * 512 + c) = o; }
          else if (seg == 5) { u32x2 o = {pk2(v0, v1), pk2(v2, v3)}; *(u32x2*)(bk + (size_t)tok * 512 + c) = o; }
          else if (seg == 2) {
            bf16_t* dst = aiT + ((size_t)((b * 4 + (c >> 7)) * 128 + (c & 127))) * SEQ + s;
            dst[0] = f2bf(v0); dst[SEQ] = f2bf(v1); dst[2 * SEQ] = f2bf(v2); dst[3 * SEQ] = f2bf(v3);
          }
          else if (seg == 6) {
            bf16_t* dst = bvT + ((size_t)((b * 4 + (c >> 7)) * 128 + (c & 127))) * SEQ + swz32(s);
            dst[0] = f2bf(v0); dst[SEQ] = f2bf(v1); dst[2 * SEQ] = f2bf(v2); dst[3 * SEQ] = f2bf(v3);
          }
          __builtin_amdgcn_sched_barrier(0);
        }
    }
  }
  DI void swapped(int tok0, int feat0, f32x16 (&acc)[2][2], int r, int hh) const {
    const int seg = feat0 >> 9, c0 = feat0 & 511;
#pragma unroll
    for (int nt = 0; nt < 2; ++nt) {
      const int c = c0 + nt * 32 + r;
#pragma unroll
      for (int mt = 0; mt < 2; ++mt)
#pragma unroll
        for (int g = 0; g < 4; ++g) {
          const int tok = tok0 + mt * 32 + 8 * g + 4 * hh, b = tok >> 14, s = tok & (SEQ - 1);
          u32x2 o = {pk2(acc[nt][mt][4 * g], acc[nt][mt][4 * g + 1]), pk2(acc[nt][mt][4 * g + 2], acc[nt][mt][4 * g + 3])};
          bf16_t* base = (seg == 2 ? aiT : bvT) + ((size_t)((b * 4 + (c >> 7)) * 128 + (c & 127))) * SEQ;
          *(u32x2*)(base + (seg == 2 ? s : swz32(s))) = o;
        }
    }
  }
};

#undef aq
#undef alf
#undef aiT
#undef ag
#undef bq
#undef bk
#undef bvT
struct EpiOddIn {
  static constexpr bool kFull = false, kSwap = false;
  DI bool swap_tile(int nt_) const { return (nt_ >> 2) == 2; }
  char* r1; float* lf; const float *qg, *kg, *bf;
#define fq  ((bf16_t*)(r1))
#define fk  ((bf16_t*)(r1 + 64 * MiB))
#define fvT ((bf16_t*)(r1 + 128 * MiB))
#define fg  ((bf16_t*)(r1 + 192 * MiB))
  DI void operator()(int tok0, int feat0, f32x16 (&acc)[2][2], int r, int hh) const {
    const int seg = feat0 >> 10, c0 = feat0 & 1023;
#pragma unroll
    for (int mt = 0; mt < 2; ++mt) {
      const int tok = tok0 + mt * 32 + r, b = tok >> 14, s = tok & (SEQ - 1);
      if (seg < 2) {
        float ssq = 0.f;
#pragma unroll
        for (int nt = 0; nt < 2; ++nt)
#pragma unroll
          for (int i = 0; i < 16; ++i) ssq += acc[nt][mt][i] * acc[nt][mt][i];
        ssq += xor32(ssq);
        float rs = rsqrtf(ssq * (1.f / 64.f) + 1e-6f);
        if (seg == 0) rs *= 0.125f * LOG2E;
        const float* gg = seg == 0 ? qg : kg;
        bf16_t* dstb = (seg == 0 ? fq : fk) + (size_t)tok * 1024 + c0;
#pragma unroll
        for (int nt = 0; nt < 2; ++nt)
#pragma unroll
          for (int g = 0; g < 4; ++g) {
            const int d = nt * 32 + 8 * g + 4 * hh;
            f32x4 gv = *(const f32x4*)(gg + d);
            u32x2 o = {pk2(acc[nt][mt][4 * g] * rs * gv[0], acc[nt][mt][4 * g + 1] * rs * gv[1]), pk2(acc[nt][mt][4 * g + 2] * rs * gv[2], acc[nt][mt][4 * g + 3] * rs * gv[3])};
            *(u32x2*)(dstb + d) = o;
            __builtin_amdgcn_sched_barrier(0);
          }
      } else if (seg == 2) {
        const int head = c0 >> 6;
#pragma unroll
        for (int nt = 0; nt < 2; ++nt)
#pragma unroll
          for (int g = 0; g < 4; ++g) {
            const int d = nt * 32 + 8 * g + 4 * hh;
            bf16_t* dst = fvT + ((size_t)((b * 16 + head) * 64 + d)) * SEQ + swz32(s);
            dst[0] = f2bf(acc[nt][mt][4 * g]); dst[SEQ] = f2bf(acc[nt][mt][4 * g + 1]); dst[2 * SEQ] = f2bf(acc[nt][mt][4 * g + 2]); dst[3 * SEQ] = f2bf(acc[nt][mt][4 * g + 3]);
          }
      } else if (seg == 3) {
#pragma unroll
        for (int nt = 0; nt < 2; ++nt)
#pragma unroll
          for (int g = 0; g < 4; ++g) {
            const int c = c0 + nt * 32 + 8 * g + 4 * hh;
            u32x2 o = {pk2(sigmoidf_(acc[nt][mt][4 * g]), sigmoidf_(acc[nt][mt][4 * g + 1])), pk2(sigmoidf_(acc[nt][mt][4 * g + 2]), sigmoidf_(acc[nt][mt][4 * g + 3]))};
            *(u32x2*)(fg + (size_t)tok * 1024 + c) = o;
            __builtin_amdgcn_sched_barrier(0);
          }
      } else if (feat0 == 4096) {
#pragma unroll
        for (int g = 0; g < 2; ++g)
#pragma unroll
          for (int j = 0; j < 4; ++j) {
            const int hd = 8 * g + 4 * hh + j;
            const float xv = acc[0][mt][4 * g + j] + bf[hd];
            const float ls = fminf(xv, 0.f) - log1pf(expf(-fabsf(xv)));
            lf[((size_t)(b * 16 + hd)) * SEQ + s] = ls;
          }
      }
    }
  }
  DI void swapped(int tok0, int feat0, f32x16 (&acc)[2][2], int r, int hh) const {
    const int head = (feat0 & 1023) >> 6;
#pragma unroll
    for (int nt = 0; nt < 2; ++nt) {
      const int d = nt * 32 + r;
#pragma unroll
      for (int mt = 0; mt < 2; ++mt)
#pragma unroll
        for (int g = 0; g < 4; ++g) {
          const int tok = tok0 + mt * 32 + 8 * g + 4 * hh, b = tok >> 14, s = tok & (SEQ - 1);
          u32x2 o = {pk2(acc[nt][mt][4 * g], acc[nt][mt][4 * g + 1]), pk2(acc[nt][mt][4 * g + 2], acc[nt][mt][4 * g + 3])};
          *(u32x2*)(fvT + ((size_t)((b * 16 + head) * 64 + d)) * SEQ + swz32(s)) = o;
        }
    }
  }
};

#undef fq
#undef fk
#undef fvT
#undef fg
struct EpiRes {
  static constexpr bool kFull = false;
  const float* xin; float* y;
  DI void operator()(int tok0, int feat0, f32x16 (&acc)[2][2], int r, int hh) const {
#pragma unroll
    for (int mt = 0; mt < 2; ++mt) {
      const size_t rowo = (size_t)(tok0 + mt * 32 + r) * 1024;
#pragma unroll
      for (int nt = 0; nt < 2; ++nt)
#pragma unroll
        for (int g = 0; g < 4; ++g) {
          const int c = feat0 + nt * 32 + 8 * g + 4 * hh;
          f32x4 xv = *(const f32x4*)(xin + rowo + c);
          f32x4 o = {ALPHA * xv[0] + acc[nt][mt][4 * g], ALPHA * xv[1] + acc[nt][mt][4 * g + 1], ALPHA * xv[2] + acc[nt][mt][4 * g + 2], ALPHA * xv[3] + acc[nt][mt][4 * g + 3]};
          *(f32x4*)(y + rowo + c) = o;
          if (g & 1) __builtin_amdgcn_sched_barrier(0);
        }
    }
  }
};

struct EpiResLN {
  static constexpr bool kFull = true, kSwap = false;
  DI bool swap_tile(int) const { return false; }
  const float* xin; float* xout; bf16_t* xb; const float *g, *b; float* xchg; unsigned* cnt; unsigned target;
  DI void full(const int mt_, const int nt_, f32x16 (&acc)[2][2][2], const int tw, const int fw, const int r, const int hh, char* lds, const int tid) const {
    float* part = (float*)(lds + G_STAGE);
#pragma unroll
    for (int mt = 0; mt < 2; ++mt) {
      const size_t rowo = (size_t)(mt_ * 256 + tw * 64 + mt * 32 + r) * 1024 + nt_ * 256 + fw * 128 + 4 * hh;
      float sm = 0.f, sq = 0.f;
#pragma unroll
      for (int half = 0; half < 2; ++half)
#pragma unroll
        for (int nt = 0; nt < 2; ++nt) {
#pragma unroll
          for (int gq = 0; gq < 4; ++gq) {
            f32x4 xv = *(const f32x4*)(xin + rowo + half * 64 + nt * 32 + 8 * gq);
#pragma unroll
            for (int jj = 0; jj < 4; ++jj) { const float y = ALPHA * xv[jj] + acc[half][nt][mt][4 * gq + jj]; acc[half][nt][mt][4 * gq + jj] = y; sm += y; sq += y * y; }
          }
          __builtin_amdgcn_sched_barrier(0);
        }
      sm += xor32(sm); sq += xor32(sq);
      if (hh == 0) { float* pp = part + ((fw * 256) + tw * 64 + mt * 32 + r) * 2; pp[0] = sm; pp[1] = sq; }
    }
    __syncthreads();
    if (tid < 256) {
      f32x2 a = *(const f32x2*)(part + tid * 2), c = *(const f32x2*)(part + (256 + tid) * 2);
      const unsigned long long pk = ((unsigned long long)__float_as_uint(a[1] + c[1]) << 32) | (unsigned long long)__float_as_uint(a[0] + c[0]);
      __hip_atomic_store((GAS unsigned long long*)(xchg + ((size_t)(mt_ * 4 + nt_) * 256 + tid) * 2), pk, __ATOMIC_RELAXED, __HIP_MEMORY_SCOPE_AGENT);
    }
    asm volatile("s_waitcnt vmcnt(0)" ::: "memory");
    __syncthreads();
    if (tid == 0) {
      __hip_atomic_fetch_add((GAS unsigned*)(cnt + mt_), 1u, __ATOMIC_RELAXED, __HIP_MEMORY_SCOPE_AGENT);
      while (__hip_atomic_load((GAS unsigned*)(cnt + mt_), __ATOMIC_RELAXED, __HIP_MEMORY_SCOPE_AGENT) < target) __builtin_amdgcn_s_sleep(1);
    }
    __syncthreads();
#pragma unroll
    for (int mt = 0; mt < 2; ++mt) {
      const int tl = tw * 64 + mt * 32 + r;
      float S = 0.f, Q = 0.f;
#pragma unroll
      for (int k = 0; k < 4; ++k) {
        const unsigned long long pk = __hip_atomic_load((GAS unsigned long long*)(xchg + ((size_t)(mt_ * 4 + k) * 256 + tl) * 2), __ATOMIC_RELAXED, __HIP_MEMORY_SCOPE_AGENT);
        S += __uint_as_float((unsigned)pk);
        Q += __uint_as_float((unsigned)(pk >> 32));
      }
      const float mean = S * (1.f / 1024.f);
      const float rstd = rsqrtf(fmaxf(Q * (1.f / 1024.f) - mean * mean, 0.f) + 1e-5f);
      const int c0 = nt_ * 256 + fw * 128 + 4 * hh;
      const size_t rowo = (size_t)(mt_ * 256 + tl) * 1024 + c0;
#pragma unroll
      for (int half = 0; half < 2; ++half)
#pragma unroll
        for (int nt = 0; nt < 2; ++nt) {
#pragma unroll
          for (int gq = 0; gq < 4; ++gq) {
            const int co = half * 64 + nt * 32 + 8 * gq;
            f32x4 gv = *(const f32x4*)(g + c0 + co), bv = *(const f32x4*)(b + c0 + co), o;
#pragma unroll
            for (int jj = 0; jj < 4; ++jj) o[jj] = (acc[half][nt][mt][4 * gq + jj] - mean) * rstd * gv[jj] + bv[jj];
            *(f32x4*)(xout + rowo + co) = o;
            u32x2 ob = {pk2(o[0], o[1]), pk2(o[2], o[3])};
            *(u32x2*)(xb + rowo + co) = ob;
          }
          __builtin_amdgcn_sched_barrier(0);
        }
    }
    __syncthreads();
  }
};

struct EpiW1 {
  static constexpr bool kFull = false, kSwap = false;
  DI bool swap_tile(int) const { return false; }
  DI void swapped(int, int, f32x16 (&)[2][2], int, int) const {}
  bf16_t* act;
  DI void operator()(int tok0, int feat0, f32x16 (&acc)[2][2], int r, int hh) const {
    const int u0 = (feat0 >> 6) * 32;
#pragma unroll
    for (int mt = 0; mt < 2; ++mt) {
      bf16_t* dst = act + (size_t)(tok0 + mt * 32 + r) * DFF + u0 + 4 * hh;
#pragma unroll
      for (int g = 0; g < 4; ++g) {
        u32x2 o = {pk2(siluf_(acc[0][mt][4 * g]) * acc[1][mt][4 * g], siluf_(acc[0][mt][4 * g + 1]) * acc[1][mt][4 * g + 1]),
                   pk2(siluf_(acc[0][mt][4 * g + 2]) * acc[1][mt][4 * g + 2], siluf_(acc[0][mt][4 * g + 3]) * acc[1][mt][4 * g + 3])};
        *(u32x2*)(dst + 8 * g) = o;
      }
    }
  }
};

DI float wave_sum(float v) {
#pragma unroll
  for (int o = 32; o >= 1; o >>= 1) v += __shfl_xor(v, o, 64);
  return v;
}
DI void ln_phase(float* x, bf16_t* xb, const float* __restrict__ g, const float* __restrict__ bta) {
  const int tid = tid_l(); const int lane = tid & 63, wave = tid >> 6;
  for (int row = blockIdx.x * 8 + wave; row < NTOK; row += gridDim.x * 8) {
    float* xr = x + (size_t)row * 1024;
    f32x4 v[4];
    float s = 0.f;
#pragma unroll
    for (int i = 0; i < 4; ++i) { v[i] = *(const f32x4*)(xr + (i * 64 + lane) * 4); s += v[i][0] + v[i][1] + v[i][2] + v[i][3]; }
    const float mean = wave_sum(s) * (1.f / 1024.f);
    float q = 0.f;
#pragma unroll
    for (int i = 0; i < 4; ++i)
#pragma unroll
      for (int j = 0; j < 4; ++j) { const float d = v[i][j] - mean; q += d * d; }
    const float rstd = rsqrtf(wave_sum(q) * (1.f / 1024.f) + 1e-5f);
#pragma unroll
    for (int i = 0; i < 4; ++i) {
      const int c = (i * 64 + lane) * 4;
      f32x4 gv = *(const f32x4*)(g + c), bv = *(const f32x4*)(bta + c), o;
#pragma unroll
      for (int j = 0; j < 4; ++j) o[j] = (v[i][j] - mean) * rstd * gv[j] + bv[j];
      *(f32x4*)(xr + c) = o;
      u32x2 ob = {pk2(o[0], o[1]), pk2(o[2], o[3])};
      *(u32x2*)(xb + (size_t)row * 1024 + c) = ob;
    }
  }
}

DI void cumsum_phase(const float* __restrict__ lf, float* __restrict__ c2, char* lds) {
  float* wt = (float*)lds;
  const int tid = tid_l(), lane = tid & 63, wave = tid >> 6;
  for (int row = blockIdx.x; row < 32; row += gridDim.x) {
    const float* src = lf + (size_t)row * SEQ + tid * 32;
    float v[32];
#pragma unroll
    for (int i = 0; i < 8; ++i) { f32x4 t = *(const f32x4*)(src + 4 * i); v[4 * i] = t[0]; v[4 * i + 1] = t[1]; v[4 * i + 2] = t[2]; v[4 * i + 3] = t[3]; }
    float run = 0.f;
#pragma unroll
    for (int i = 0; i < 32; ++i) { run += v[i]; v[i] = run; }
    float inc = run;
#pragma unroll
    for (int o = 1; o < 64; o <<= 1) { const float t = __shfl_up(inc, o, 64); if (lane >= o) inc += t; }
    if (lane == 63) wt[wave] = inc;
    __syncthreads();
    float pre = inc - run;
    for (int w = 0; w < wave; ++w) pre += wt[w];
    float* dst = c2 + (size_t)row * SEQ + tid * 32;
#pragma unroll
    for (int i = 0; i < 8; ++i) { f32x4 o = {(pre + v[4 * i]) * LOG2E, (pre + v[4 * i + 1]) * LOG2E, (pre + v[4 * i + 2]) * LOG2E, (pre + v[4 * i + 3]) * LOG2E}; *(f32x4*)(dst + 4 * i) = o; }
    __syncthreads();
  }
}

template <int DVT, bool FOX>
DI void attn_step(const char* kb, const bf16x8 (&qf)[4], f32x16 (&o)[DVT], float& m, float& l, const bool diag, const int j, const int tq, const int r, const int hh) {
  constexpr int VB = DVT * 32 * LROW;
  const char* vb = kb + 64 * LROW; const char* cb = vb + VB;
  f32x16 st[2];
  bf16x8 kf[8];
#pragma unroll
  for (int ks = 0; ks < 4; ++ks)
#pragma unroll
    for (int kt = 0; kt < 2; ++kt) kf[ks * 2 + kt] = *(const bf16x8*)(kb + (kt * 32 + r) * LROW + ks * 32 + hh * 16);
  if (FOX) {
#pragma unroll
    for (int kt = 0; kt < 2; ++kt)
#pragma unroll
      for (int g = 0; g < 4; ++g) {
        f32x4 cs = *(const f32x4*)(cb + (kt * 32 + 8 * g + 4 * hh) * 4);
        st[kt][4 * g] = cs[0]; st[kt][4 * g + 1] = cs[1]; st[kt][4 * g + 2] = cs[2]; st[kt][4 * g + 3] = cs[3];
      }
  } else {
#pragma unroll
    for (int kt = 0; kt < 2; ++kt)
#pragma unroll
      for (int i = 0; i < 16; ++i) st[kt][i] = 0.f;
  }
  __builtin_amdgcn_sched_barrier(0);
#pragma unroll
  for (int ks = 0; ks < 4; ++ks)
#pragma unroll
    for (int kt = 0; kt < 2; ++kt) st[kt] = MFMA32(kf[ks * 2 + kt], qf[ks], st[kt]);
  bf16x8 va[DVT], vn[DVT];
#pragma unroll
  for (int d = 0; d < DVT; ++d) va[d] = *(const bf16x8*)(vb + (d * 32 + r) * LROW + (8 * hh) * 2);
  __builtin_amdgcn_sched_barrier(0);
  {
    const f32x2 mm = {m, m};
#pragma unroll
    for (int kt = 0; kt < 2; ++kt)
#pragma unroll
      for (int i = 0; i < 8; ++i) { f32x2 z = {st[kt][2 * i], st[kt][2 * i + 1]}; z = z - mm; st[kt][2 * i] = z[0]; st[kt][2 * i + 1] = z[1]; }
  }
  if (FOX) {
    if (diag) {
#pragma unroll
      for (int kt = 0; kt < 2; ++kt)
#pragma unroll
        for (int i = 0; i < 16; ++i) {
          const int key = j * 64 + kt * 32 + (i & 3) + 8 * (i >> 2) + 4 * hh;
          if (key > tq) st[kt][i] = -INFINITY;
        }
    }
  }
  float mx;
  {
    float a0 = fmaxf(fmaxf(st[0][0], st[0][1]), st[0][2]), a1 = fmaxf(fmaxf(st[1][0], st[1][1]), st[1][2]);
#pragma unroll
    for (int i = 3; i < 15; i += 2) { a0 = fmaxf(fmaxf(a0, st[0][i]), st[0][i + 1]); a1 = fmaxf(fmaxf(a1, st[1][i]), st[1][i + 1]); }
    mx = fmaxf(fmaxf(a0, a1), fmaxf(st[0][15], st[1][15]));
  }
  mx = fmaxf(mx, xor32(mx));
  if (__any(diag || mx > 8.f)) {
    const float d = (diag || mx > 0.f) ? mx : 0.f;
    const float alpha = diag ? 0.f : __builtin_amdgcn_exp2f(-d);
    m += d;
    l *= alpha;
#pragma unroll
    for (int dd = 0; dd < DVT; ++dd)
#pragma unroll
      for (int i = 0; i < 16; ++i) o[dd][i] *= alpha;
    const f32x2 d2 = {d, d};
#pragma unroll
    for (int kt = 0; kt < 2; ++kt)
#pragma unroll
      for (int i = 0; i < 8; ++i) { f32x2 z = {st[kt][2 * i], st[kt][2 * i + 1]}; z = z - d2; st[kt][2 * i] = z[0]; st[kt][2 * i + 1] = z[1]; }
  }
  f32x2 ls2 = {0.f, 0.f};
#pragma unroll
  for (int kt = 0; kt < 2; ++kt)
#pragma unroll
    for (int i = 0; i < 8; ++i) {
      f32x2 pv = {__builtin_amdgcn_exp2f(st[kt][2 * i]), __builtin_amdgcn_exp2f(st[kt][2 * i + 1])};
      st[kt][2 * i] = pv[0]; st[kt][2 * i + 1] = pv[1];
      ls2 = ls2 + pv;
    }
  l += ls2[0] + ls2[1];
  __builtin_amdgcn_sched_barrier(0);
#define A_PVGROUP(GK, VC, VN) { constexpr int kt_ = (GK) >> 1, s2_ = (GK) & 1; \
    if ((GK) < 3) { constexpr int kt1_ = ((GK) + 1) >> 1, s21_ = ((GK) + 1) & 1; \
      _Pragma("unroll") for (int d = 0; d < DVT; ++d) VN[d] = *(const bf16x8*)(vb + (d * 32 + r) * LROW + (kt1_ * 32 + 16 * s21_ + 8 * hh) * 2); } \
    u32x4 pw_ = {pk2(st[kt_][8 * s2_], st[kt_][8 * s2_ + 1]), pk2(st[kt_][8 * s2_ + 2], st[kt_][8 * s2_ + 3]), pk2(st[kt_][8 * s2_ + 4], st[kt_][8 * s2_ + 5]), pk2(st[kt_][8 * s2_ + 6], st[kt_][8 * s2_ + 7])}; \
    const bf16x8 pf_ = __builtin_bit_cast(bf16x8, pw_); \
    __builtin_amdgcn_sched_barrier(0); \
    _Pragma("unroll") for (int d = 0; d < DVT; ++d) o[d] = MFMA32(VC[d], pf_, o[d]); \
    __builtin_amdgcn_sched_barrier(0); }
  A_PVGROUP(0, va, vn); A_PVGROUP(1, vn, va); A_PVGROUP(2, va, vn); A_PVGROUP(3, vn, va);
#undef A_PVGROUP
}

template <int DVT, bool FOX>
DI void attn_pass(const bf16_t* __restrict__ qrow, const bf16_t* __restrict__ kbase, const int ldk, const bf16_t* __restrict__ vtbase,
                  const float* __restrict__ cbase, const int j_hi, const int my_last, const int j_lo_diag, const int tq, const float prune_c,
                  f32x16 (&o)[DVT], float& l_out, char* lds) {
  constexpr int VB = DVT * 32 * LROW;
  constexpr int STAGE = 64 * LROW + VB + 256;
  const int tid = tid_l(), lane = tid & 63;
  const int r = lane & 31, hh = lane >> 5;
  const int lrow = tid >> 3, lch = tid & 7;
  bf16x8 qf[4];
#pragma unroll
  for (int ks = 0; ks < 4; ++ks) qf[ks] = *(const bf16x8*)(qrow + ks * 16 + hh * 8);
#pragma unroll
  for (int d = 0; d < DVT; ++d)
#pragma unroll
    for (int i = 0; i < 16; ++i) o[d][i] = 0.f;
  float m = 0.f, l = 0.f;
  u32x4 kr0, kr1, vr0[DVT / 2], vr1[DVT / 2]; f32x4 cr0 = {0.f, 0.f, 0.f, 0.f}, cr1 = {0.f, 0.f, 0.f, 0.f};
  const bf16_t* kp = kbase + (size_t)lrow * ldk + lch * 8;
  const bf16_t* vp = vtbase + (size_t)lrow * SEQ + lch * 8;
#define A_GLOAD(KR, VR, CR, JT) { const int s1_ = (JT) * 64; KR = *(const u32x4*)(kp + (size_t)s1_ * ldk); \
    _Pragma("unroll") for (int i_ = 0; i_ < DVT / 2; ++i_) VR[i_] = *(const u32x4*)(vp + (size_t)(64 * i_) * SEQ + s1_); \
    if (FOX) { if (tid < 16) { f32x4 t_ = *(const f32x4*)(cbase + s1_ + tid * 4); CR[0] = -t_[0]; CR[1] = -t_[1]; CR[2] = -t_[2]; CR[3] = -t_[3]; } } }
#define A_LSTORE(KR, VR, CR, STG) { char* kb_ = lds + (STG) * STAGE; char* vb_ = kb_ + 64 * LROW; char* cb_ = vb_ + VB; \
    *(u32x4*)(kb_ + lrow * LROW + lch * 16) = KR; \
    _Pragma("unroll") for (int i_ = 0; i_ < DVT / 2; ++i_) *(u32x4*)(vb_ + (lrow + 64 * i_) * LROW + lch * 16) = VR[i_]; \
    if (FOX) { if (tid < 16) *(f32x4*)(cb_ + tid * 16) = CR; } }
#define A_PRUNE(STG) (FOX && j < j_lo_diag && (prune_c + *(const float*)(lds + (STG) * STAGE + 64 * LROW + VB + 63 * 4) < -160.f))
  int j = j_hi;
  A_GLOAD(kr0, vr0, cr0, j);
  if (j >= 1) A_GLOAD(kr1, vr1, cr1, j - 1);
  A_LSTORE(kr0, vr0, cr0, 0);
  __syncthreads();
  for (;;) {
    if (A_PRUNE(0)) break;
    if (j >= 2) A_GLOAD(kr0, vr0, cr0, j - 2);
    if (j <= my_last) attn_step<DVT, FOX>(lds, qf, o, m, l, j == my_last, j, tq, r, hh);
    if (j == 0) break;
    A_LSTORE(kr1, vr1, cr1, 1);
    __syncthreads();
    --j;
    if (A_PRUNE(1)) break;
    if (j >= 2) A_GLOAD(kr1, vr1, cr1, j - 2);
    if (j <= my_last) attn_step<DVT, FOX>(lds + STAGE, qf, o, m, l, j == my_last, j, tq, r, hh);
    if (j == 0) break;
    A_LSTORE(kr0, vr0, cr0, 0);
    __syncthreads();
    --j;
  }
  __syncthreads();
#undef A_GLOAD
#undef A_LSTORE
#undef A_PRUNE
  l_out = l + xor32(l);
}

DI void fox_phase(const Params& p, const int j_odd, char* lds) {
  char* ws = (char*)launder(p.ws);
  const bf16_t* fq = (const bf16_t*)(ws + OFF_R1);
  const bf16_t* fk = (const bf16_t*)(ws + OFF_R1 + 64 * MiB);
  const bf16_t* fvT = (const bf16_t*)(ws + OFF_R1 + 128 * MiB);
  const bf16_t* fg = (const bf16_t*)(ws + OFF_R1 + 192 * MiB);
  const float* c2 = (const float*)(ws + OFF_C2);
  bf16_t* ab = (bf16_t*)(ws + OFF_AB);
  const float b2 = ((const float*)(ws + OFF_MISC))[1032 + j_odd];
  const int tid = tid_l(); const int lane = tid & 63, wave = __builtin_amdgcn_readfirstlane(tid >> 6), r = lane & 31, hh = lane >> 5;
  for (int rnd = 0; rnd < 4; ++rnd) {
    const int bh = rnd * 8 + (blockIdx.x & 7), pp = blockIdx.x >> 3, b = bh >> 4, h = bh & 15;
    for (int half = 0; half < 2; ++half) {
      const int qb = half == 0 ? 63 - pp : pp;
      const int t0 = qb * 256, tq0 = t0 + wave * 32, tq = tq0 + r;
      const int nkv = (t0 + 256) >> 6, my_last = (tq0 + 31) >> 6;
      const float prune_c = b2 + c2[(size_t)bh * SEQ + t0];
      f32x16 o[2]; float l;
      attn_pass<2, true>(fq + (size_t)(b * SEQ + tq) * 1024 + h * 64, fk + (size_t)(b * SEQ) * 1024 + h * 64, 1024,
                         fvT + (size_t)(bh * 64) * SEQ, c2 + (size_t)bh * SEQ, nkv - 1, my_last, t0 >> 6, tq, prune_c, o, l, lds);
      const float inv = 1.f / l;
      const size_t rowo = (size_t)(b * SEQ + tq) * 1024 + h * 64;
#pragma unroll
      for (int d = 0; d < 2; ++d)
#pragma unroll
        for (int g = 0; g < 4; ++g) {
          const int c = d * 32 + 8 * g + 4 * hh;
          u32x2 gv = *(const u32x2*)(fg + rowo + c);
          const float g0 = __uint_as_float(gv[0] << 16), g1 = __uint_as_float(gv[0] & 0xffff0000u), g2 = __uint_as_float(gv[1] << 16), g3 = __uint_as_float(gv[1] & 0xffff0000u);
          u32x2 ov = {pk2(o[d][4 * g] * inv * g0, o[d][4 * g + 1] * inv * g1), pk2(o[d][4 * g + 2] * inv * g2, o[d][4 * g + 3] * inv * g3)};
          *(u32x2*)(ab + rowo + c) = ov;
        }
    }
  }
}

DI void diff_phase(const Params& p, const int j_even, char* lds) {
  char* ws = (char*)launder(p.ws);
  const bf16_t* bq = (const bf16_t*)(ws + OFF_R1 + 160 * MiB);
  const bf16_t* bk = (const bf16_t*)(ws + OFF_R1 + 192 * MiB);
  const bf16_t* bvT = (const bf16_t*)(ws + OFF_R1 + 224 * MiB);
  bf16_t* ab = (bf16_t*)(ws + OFF_AB);
  const float* misc = (const float*)(ws + OFF_MISC);
  const float lam = misc[1024 + j_even];
  const float lam_init = 0.8f - 0.6f * expf(-0.3f * (float)(2 * j_even));
  const float* dg = ((const float*)p.diff_g) + j_even * 128;
  const int tid = tid_l(); const int lane = tid & 63, wave = __builtin_amdgcn_readfirstlane(tid >> 6), r = lane & 31, hh = lane >> 5;
  {
    const int bh = blockIdx.x & 7, pp = blockIdx.x >> 3, b = bh >> 2, h = bh & 3;
    for (int half = 0; half < 2; ++half) {
      const int qb = half == 0 ? 63 - pp : pp;
      const int t0 = qb * 256, tq0 = t0 + wave * 32, tq = tq0 + r;
      const int nkv = (t0 + 256) >> 6, my_last = tq0 >> 6;
      f32x16 o1[4], o2[4]; float l1, l2;
      attn_pass<4, false>(bq + (size_t)(b * SEQ + tq) * 512 + h * 128, bk + (size_t)(b * SEQ) * 512 + h * 128, 512,
                          bvT + (size_t)(bh * 128) * SEQ, nullptr, nkv - 1, my_last, 0, tq, 0.f, o1, l1, lds);
      const float i1 = 1.f / l1;
      unsigned* o1s = (unsigned*)(lds + DIFF_STASH_OFF) + tid;
#pragma unroll
      for (int d = 0; d < 4; ++d)
#pragma unroll
        for (int i = 0; i < 8; ++i) o1s[(d * 8 + i) * 512] = pk2(o1[d][2 * i] * i1, o1[d][2 * i + 1] * i1);
      attn_pass<4, false>(bq + (size_t)(b * SEQ + tq) * 512 + h * 128 + 64, bk + (size_t)(b * SEQ) * 512 + h * 128 + 64, 512,
                          bvT + (size_t)(bh * 128) * SEQ, nullptr, nkv - 1, my_last, 0, tq, 0.f, o2, l2, lds);
      const float i2 = lam / l2;
      float ssq = 0.f;
#pragma unroll
      for (int d = 0; d < 4; ++d)
#pragma unroll
        for (int i = 0; i < 8; ++i) {
          const unsigned pw = o1s[(d * 8 + i) * 512];
          const float va = __uint_as_float(pw << 16) - i2 * o2[d][2 * i], vb = __uint_as_float(pw & 0xffff0000u) - i2 * o2[d][2 * i + 1];
          o2[d][2 * i] = va; o2[d][2 * i + 1] = vb; ssq += va * va + vb * vb; }
      ssq += xor32(ssq);
      const float rs = rsqrtf(ssq * (1.f / 128.f) + 1e-6f) * (1.f - lam_init);
      const size_t rowo = (size_t)(b * SEQ + tq) * 1024 + 512 + h * 128;
#pragma unroll
      for (int d = 0; d < 4; ++d)
#pragma unroll
        for (int g = 0; g < 4; ++g) {
          const int c = d * 32 + 8 * g + 4 * hh;
          f32x4 gv = *(const f32x4*)(dg + c);
          u32x2 ov = {pk2(o2[d][4 * g] * rs * gv[0], o2[d][4 * g + 1] * rs * gv[1]), pk2(o2[d][4 * g + 2] * rs * gv[2], o2[d][4 * g + 3] * rs * gv[3])};
          *(u32x2*)(ab + rowo + c) = ov;
        }
    }
  }
}

DI void hgrn_stageA(const Params& p, char* lds) {
  char* ws = (char*)launder(p.ws);
  const float* alf = (const float*)(ws + OFF_R1 + 32 * MiB);
  const bf16_t* aiT = (const bf16_t*)(ws + OFF_R1 + 96 * MiB);
  bf16_t* UT = (bf16_t*)(ws + OFF_UT);
  float* dbuf = (float*)(ws + OFF_DB);
  float* lfT = (float*)lds;
  float* part = (float*)(lds + 32768);
  char* KT = lds + 34816;
  char* IT = KT + 18432;
  const int tid = tid_l(), lane = tid & 63, wave = tid >> 6, r = lane & 31, hh = lane >> 5;
  for (int task = blockIdx.x; task < 2048; task += gridDim.x) {
    const int bh = task >> 8, c = task & 255, b = bh >> 2, h = bh & 3;
    const int tok0 = b * SEQ + c * 64;
#pragma unroll
    for (int i = 0; i < 4; ++i) {
      const int idx = tid + 512 * i, row = idx >> 5, c4 = idx & 31;
      *(f32x4*)(lfT + row * 128 + c4 * 4) = *(const f32x4*)(alf + (size_t)(tok0 + row) * 512 + h * 128 + c4 * 4);
    }
#pragma unroll
    for (int i = 0; i < 2; ++i) {
      const int idx = tid + 512 * i, row = idx >> 3, ch = idx & 7;
      *(u32x4*)(IT + row * LROW + ch * 16) = *(const u32x4*)(aiT + (size_t)(bh * 128 + row) * SEQ + c * 64 + ch * 8);
    }
    __syncthreads();
    const int k = tid & 127, seg = tid >> 7;
    float lv[16], bv[16];
    float run = 0.f;
#pragma unroll
    for (int i = 0; i < 16; ++i) { lv[i] = lfT[(seg * 16 + i) * 128 + k]; run += lv[i]; bv[i] = run; }
    part[seg * 128 + k] = run;
    __syncthreads();
    float pre = 0.f, tot = 0.f;
#pragma unroll
    for (int s2 = 0; s2 < 4; ++s2) { const float pv = part[s2 * 128 + k]; if (s2 < seg) pre += pv; tot += pv; }
    {
      float kv[16];
#pragma unroll
      for (int i = 0; i < 16; ++i) kv[i] = (1.f - __expf(lv[i])) * __expf(tot - (pre + bv[i]));
      u32x4 w0 = {pk2(kv[0], kv[1]), pk2(kv[2], kv[3]), pk2(kv[4], kv[5]), pk2(kv[6], kv[7])};
      u32x4 w1 = {pk2(kv[8], kv[9]), pk2(kv[10], kv[11]), pk2(kv[12], kv[13]), pk2(kv[14], kv[15])};
      *(u32x4*)(KT + k * LROW + seg * 32) = w0;
      *(u32x4*)(KT + k * LROW + seg * 32 + 16) = w1;
    }
    if (seg == 0) dbuf[(size_t)task * 128 + k] = __expf(tot);
    __syncthreads();
    {
      const int ktile = wave & 3, vhalf = wave >> 2;
      f32x16 acc[2];
#pragma unroll
      for (int vt = 0; vt < 2; ++vt)
#pragma unroll
        for (int i = 0; i < 16; ++i) acc[vt][i] = 0.f;
#pragma unroll
      for (int ks = 0; ks < 4; ++ks) {
        bf16x8 a = *(const bf16x8*)(KT + (ktile * 32 + r) * LROW + ks * 32 + hh * 16);
#pragma unroll
        for (int vt = 0; vt < 2; ++vt) {
          bf16x8 bb = *(const bf16x8*)(IT + (vhalf * 64 + vt * 32 + r) * LROW + ks * 32 + hh * 16);
          acc[vt] = MFMA32(a, bb, acc[vt]);
        }
      }
#pragma unroll
      for (int vt = 0; vt < 2; ++vt) {
        bf16_t* dst = UT + ((size_t)task * 128 + vhalf * 64 + vt * 32 + r) * 128 + ktile * 32 + 4 * hh;
#pragma unroll
        for (int g = 0; g < 4; ++g) { u32x2 ov = {pk2(acc[vt][4 * g], acc[vt][4 * g + 1]), pk2(acc[vt][4 * g + 2], acc[vt][4 * g + 3])}; *(u32x2*)(dst + 8 * g) = ov; }
      }
    }
    __syncthreads();
  }
}

DI void hgrn_scan(const Params& p) {
  char* ws = (char*)launder(p.ws);
  bf16_t* UT = (bf16_t*)(ws + OFF_UT);
  const float* dbuf = (const float*)(ws + OFF_DB);
  const int gid = blockIdx.x * 512 + tid_l();
  if (gid >= 8 * 16384) return;
  const int bh = gid >> 14, e = gid & 16383;
  bf16_t* up = UT + (size_t)bh * 256 * 16384 + e;
  const float* dp = dbuf + (size_t)bh * 256 * 128 + (e & 127);
  float st = 0.f;
  for (int c0 = 0; c0 < 256; c0 += 32) {
    bf16_t u[32]; float dv[32];
#pragma unroll
    for (int i = 0; i < 32; ++i) { u[i] = up[(size_t)(c0 + i) * 16384]; dv[i] = dp[(size_t)(c0 + i) * 128]; }
#pragma unroll
    for (int i = 0; i < 32; ++i) {
      up[(size_t)(c0 + i) * 16384] = f2bf(st);
      st = dv[i] * st + bf2f(u[i]);
    }
  }
}

constexpr int QROW = 272;
DI void hgrn_stageC(const Params& p, const int j_even, char* lds) {
  char* ws = (char*)launder(p.ws);
  const bf16_t* aq = (const bf16_t*)(ws + OFF_R1);
  const float* alf = (const float*)(ws + OFF_R1 + 32 * MiB);
  const bf16_t* aiT = (const bf16_t*)(ws + OFF_R1 + 96 * MiB);
  const bf16_t* ag = (const bf16_t*)(ws + OFF_R1 + 128 * MiB);
  const bf16_t* UT = (const bf16_t*)(ws + OFF_UT);
  bf16_t* ab = (bf16_t*)(ws + OFF_AB);
  const float* hg = ((const float*)p.hgrn_g) + j_even * 128;
  float* lfT = (float*)lds;
  char* ST = lds;
  char* Q1 = lds + 34816;
  char* Q2 = Q1 + 64 * QROW;
  char* K2 = Q2 + 64 * QROW;
  char* IT = K2 + 64 * QROW;
  float* part = (float*)(IT + 128 * LROW);
  const int tid = tid_l(), lane = tid & 63, wave = tid >> 6, r = lane & 31, hh = lane >> 5;
  for (int task = blockIdx.x; task < 2048; task += gridDim.x) {
    const int bh = task >> 8, c = task & 255, b = bh >> 2, h = bh & 3;
    const int tok0 = b * SEQ + c * 64;
#pragma unroll
    for (int i = 0; i < 4; ++i) {
      const int idx = tid + 512 * i, row = idx >> 5, c4 = idx & 31;
      *(f32x4*)(lfT + row * 128 + c4 * 4) = *(const f32x4*)(alf + (size_t)(tok0 + row) * 512 + h * 128 + c4 * 4);
    }
#pragma unroll
    for (int i = 0; i < 2; ++i) {
      const int idx = tid + 512 * i, row = idx >> 3, ch = idx & 7;
      *(u32x4*)(IT + row * LROW + ch * 16) = *(const u32x4*)(aiT + (size_t)(bh * 128 + row) * SEQ + c * 64 + ch * 8);
    }
    u32x4 sreg[4];
#pragma unroll
    for (int i = 0; i < 4; ++i) sreg[i] = *(const u32x4*)(UT + (size_t)task * 16384 + (size_t)(tid + 512 * i) * 8);
    __syncthreads();
    const int k = tid & 127, seg = tid >> 7;
    float lv[16], bv[16];
    float run = 0.f;
#pragma unroll
    for (int i = 0; i < 16; ++i) { lv[i] = lfT[(seg * 16 + i) * 128 + k]; run += lv[i]; bv[i] = run; }
    part[seg * 128 + k] = run;
    __syncthreads();
    {
      const float p0 = part[k], p1 = part[128 + k], p2 = part[256 + k];
      const float pre = (seg > 0 ? p0 : 0.f) + (seg > 1 ? p1 : 0.f) + (seg > 2 ? p2 : 0.f);
      const float bmid = p0 + p1;
#pragma unroll
      for (int i = 0; i < 16; ++i) {
        const int t = seg * 16 + i;
        const float bt = pre + bv[i];
        const float qv = bf2f(aq[(size_t)(tok0 + t) * 512 + h * 128 + k]);
        const float kk = 1.f - __expf(lv[i]);
        *(bf16_t*)(Q1 + t * QROW + k * 2) = f2bf(qv * __expf(bt));
        *(bf16_t*)(Q2 + t * QROW + k * 2) = f2bf(qv * __expf(fminf(bt - bmid, 80.f)));
        *(bf16_t*)(K2 + t * QROW + k * 2) = f2bf(kk * __expf(fminf(bmid - bt, 80.f)));
      }
    }
#pragma unroll
    for (int i = 0; i < 4; ++i) { const int idx = tid + 512 * i, row = idx >> 4, ch = idx & 15; *(u32x4*)(ST + row * QROW + ch * 16) = sreg[i]; }
    __syncthreads();
    {
      const int vt = wave & 3, tt = wave >> 2;
      const int t = tt * 32 + r;
      f32x16 sc[2];
#pragma unroll
      for (int st = 0; st < 2; ++st)
#pragma unroll
        for (int i = 0; i < 16; ++i) sc[st][i] = 0.f;
#pragma unroll
      for (int ks = 0; ks < 8; ++ks) {
        bf16x8 qb = *(const bf16x8*)(Q2 + t * QROW + ks * 32 + hh * 16);
#pragma unroll
        for (int st = 0; st < 2; ++st) {
          if (st <= tt) {
            bf16x8 a = *(const bf16x8*)(K2 + (st * 32 + r) * QROW + ks * 32 + hh * 16);
            sc[st] = MFMA32(a, qb, sc[st]);
          }
        }
      }
      f32x16 acc;
#pragma unroll
      for (int i = 0; i < 16; ++i) acc[i] = 0.f;
#pragma unroll
      for (int st = 0; st < 2; ++st) {
        if (st <= tt) {
#pragma unroll
          for (int i = 0; i < 16; ++i) { const int s = st * 32 + (i & 3) + 8 * (i >> 2) + 4 * hh; if (s > t) sc[st][i] = 0.f; }
#pragma unroll
          for (int s2 = 0; s2 < 2; ++s2) {
            u32x4 pw = {pk2(sc[st][8 * s2], sc[st][8 * s2 + 1]), pk2(sc[st][8 * s2 + 2], sc[st][8 * s2 + 3]), pk2(sc[st][8 * s2 + 4], sc[st][8 * s2 + 5]), pk2(sc[st][8 * s2 + 6], sc[st][8 * s2 + 7])};
            const bf16x8 pf = __builtin_bit_cast(bf16x8, pw);
            const char* ip = IT + (vt * 32 + r) * LROW + (st * 32 + 16 * s2 + 4 * hh) * 2;
            u32x2 lo = *(const u32x2*)ip, hi = *(const u32x2*)(ip + 16);
            u32x4 aw = {lo[0], lo[1], hi[0], hi[1]};
            acc = MFMA32(__builtin_bit_cast(bf16x8, aw), pf, acc);
          }
        }
      }
#pragma unroll
      for (int ks = 0; ks < 8; ++ks) {
        bf16x8 a = *(const bf16x8*)(ST + (vt * 32 + r) * QROW + ks * 32 + hh * 16);
        bf16x8 qb = *(const bf16x8*)(Q1 + t * QROW + ks * 32 + hh * 16);
        acc = MFMA32(a, qb, acc);
      }
      float ssq = 0.f;
#pragma unroll
      for (int i = 0; i < 16; ++i) ssq += acc[i] * acc[i];
      ssq += xor32(ssq);
      if (hh == 0) part[vt * 64 + t] = ssq;
      __syncthreads();
      const float tot = part[t] + part[64 + t] + part[128 + t] + part[192 + t];
      const float rs = rsqrtf(tot * (1.f / 128.f) + 1e-6f);
      const size_t go = (size_t)(tok0 + t) * 512 + h * 128 + vt * 32 + 4 * hh;
      const size_t oo = (size_t)(tok0 + t) * 1024 + h * 128 + vt * 32 + 4 * hh;
#pragma unroll
      for (int g = 0; g < 4; ++g) {
        f32x4 gn = *(const f32x4*)(hg + vt * 32 + 4 * hh + 8 * g);
        u32x2 gv = *(const u32x2*)(ag + go + 8 * g);
        const float g0 = __uint_as_float(gv[0] << 16), g1 = __uint_as_float(gv[0] & 0xffff0000u), g2 = __uint_as_float(gv[1] << 16), g3 = __uint_as_float(gv[1] & 0xffff0000u);
        u32x2 ov = {pk2(acc[4 * g] * rs * gn[0] * g0, acc[4 * g + 1] * rs * gn[1] * g1), pk2(acc[4 * g + 2] * rs * gn[2] * g2, acc[4 * g + 3] * rs * gn[3] * g3)};
        *(u32x2*)(ab + oo + 8 * g) = ov;
      }
    }
    __syncthreads();
  }
}

DI void grid_barrier(unsigned* ctr, const unsigned target) {
  asm volatile("s_waitcnt vmcnt(0)" ::: "memory");
  __syncthreads();
  if (threadIdx.x == 0) {
    __builtin_amdgcn_fence(__ATOMIC_RELEASE, "agent");
    asm volatile("s_waitcnt vmcnt(0)" ::: "memory");
    __hip_atomic_fetch_add((GAS unsigned*)ctr, 1u, __ATOMIC_RELAXED, __HIP_MEMORY_SCOPE_AGENT);
    while (__hip_atomic_load((GAS unsigned*)ctr, __ATOMIC_RELAXED, __HIP_MEMORY_SCOPE_AGENT) < target) __builtin_amdgcn_s_sleep(1);
    __builtin_amdgcn_fence(__ATOMIC_ACQUIRE, "agent");
    asm volatile("s_waitcnt vmcnt(0)" ::: "memory");
  }
  __syncthreads();
}
typedef const __attribute__((address_space(4))) Params* kparams_t;
#if defined(__HIP_DEVICE_COMPILE__)
DI kparams_t launder_k(kparams_t q) { asm volatile("" : "+s"(q)); return q; }
#endif
#if defined(__HIP_DEVICE_COMPILE__)
#define KPARAMS (*launder_k((kparams_t)__builtin_amdgcn_kernarg_segment_ptr()))
#else
#define KPARAMS p_arg
#endif
__global__ void __launch_bounds__(512) fwd_mega(Params p_arg) {
  extern __shared__ __attribute__((aligned(16))) char lds[];
  int ph = 0;
  const int p_lo = p_arg.lo, p_hi = p_arg.hi;
#define PHASE(id, ...) { if (ph >= p_lo && ph < p_hi) { const Params p = KPARAMS; char* ws = (char*)launder(p.ws); float* outp = (float*)launder((GAS char*)p.out); bf16_t* ab = (bf16_t*)(ws + OFF_AB); (void)outp; (void)ab; \
    if (ONLY < 0 || ONLY == id) { __VA_ARGS__; } if ((DUPMASK >> id) & 1) { __syncthreads(); __VA_ARGS__; } if (ph + 1 < p_hi) { if (ph == p_lo) cg::this_grid().sync(); else grid_barrier((unsigned*)(ws + OFF_CNT) + 256, (unsigned)(ph - p_lo) * gridDim.x); } } ++ph; }
  PHASE(0, phase0(p, lds));
  for (int l = 0; l < 4; ++l) {
    const int j = l >> 1;
    if ((l & 1) == 0) {
      PHASE(1,
        EpiEvenIn e;
        e.r1 = ws + OFF_R1; e.lb = (const float*)(ws + OFF_MISC) + j * 512;
        gemm_phase(ab, 1024, (const bf16_t*)(ws + OFF_WEI) + (size_t)j * EVEN_IN * D, EVEN_IN, D, e, lds));
      PHASE(2, hgrn_stageA(p, lds));
      PHASE(3, hgrn_scan(p));
      PHASE(4, hgrn_stageC(p, j, lds); diff_phase(p, j, lds));
      PHASE(6,
        EpiResLN er; er.xin = (l == 0) ? (const float*)launder((GAS char*)p.x_in) : outp; er.xout = outp; er.xb = ab;
        er.g = ((const float*)p.ln1g) + l * D; er.b = ((const float*)p.ln1b) + l * D;
        er.xchg = (float*)(ws + OFF_XCHG); er.cnt = (unsigned*)(ws + OFF_CNT); er.target = 4u * (unsigned)(2 * l + 1);
        gemm_phase(ab, 1024, (const bf16_t*)(ws + OFF_WEO) + (size_t)j * D * D, D, D, er, lds));
    } else {
      PHASE(7,
        EpiOddIn e;
        e.r1 = ws + OFF_R1;
        e.lf = (float*)(ws + OFF_LF); e.qg = ((const float*)p.fox_qg) + j * 64; e.kg = ((const float*)p.fox_kg) + j * 64; e.bf = ((const float*)p.fox_bf) + j * 16;
        gemm_phase(ab, 1024, (const bf16_t*)(ws + OFF_WFI) + (size_t)j * ODD_PAD * D, ODD_PAD, D, e, lds));
      PHASE(8, cumsum_phase((const float*)(ws + OFF_LF), (float*)(ws + OFF_C2), lds));
      PHASE(9, fox_phase(p, j, lds));
      PHASE(6,
        EpiResLN er; er.xin = outp; er.xout = outp; er.xb = ab;
        er.g = ((const float*)p.ln1g) + l * D; er.b = ((const float*)p.ln1b) + l * D;
        er.xchg = (float*)(ws + OFF_XCHG); er.cnt = (unsigned*)(ws + OFF_CNT); er.target = 4u * (unsigned)(2 * l + 1);
        gemm_phase(ab, 1024, (const bf16_t*)(ws + OFF_WFO) + (size_t)j * D * D, D, D, er, lds));
    }
    PHASE(11,
      EpiW1 e1; e1.act = (bf16_t*)(ws + OFF_R1);
      gemm_phase(ab, 1024, (const bf16_t*)(ws + OFF_W1) + (size_t)l * 2 * DFF * D, 2 * DFF, D, e1, lds));
    PHASE(6,
      EpiResLN e2; e2.xin = outp; e2.xout = outp; e2.xb = ab;
      e2.g = ((const float*)p.ln2g) + l * D; e2.b = ((const float*)p.ln2b) + l * D;
      e2.xchg = (float*)(ws + OFF_XCHG); e2.cnt = (unsigned*)(ws + OFF_CNT); e2.target = 4u * (unsigned)(2 * l + 2);
      gemm_phase((const bf16_t*)(ws + OFF_R1), DFF, (const bf16_t*)(ws + OFF_W2) + (size_t)l * D * DFF, D, DFF, e2, lds));
  }
#undef PHASE
}
constexpr int N_PHASES = 1 + 2 * 7 + 2 * 6;

extern "C" void kernel_launch(void* const* d_in, const int* in_sizes, int n_in, void* d_out, int out_size, void* d_ws, size_t ws_size, hipStream_t stream) {
  static bool attr = false;
  if (!attr) { hipFuncSetAttribute((const void*)fwd_mega, hipFuncAttributeMaxDynamicSharedMemorySize, LDS_BYTES); attr = true; }
  Params p{};
  p.x_in = (const GAS float*)d_in[0];
  p.even_w_in = (const GAS float*)d_in[1]; p.even_w_out = (const GAS float*)d_in[2]; p.lb_logits = (const GAS float*)d_in[3];
  p.lq1 = (const GAS float*)d_in[4]; p.lk1 = (const GAS float*)d_in[5]; p.lq2 = (const GAS float*)d_in[6]; p.lk2 = (const GAS float*)d_in[7];
  p.hgrn_g = (const GAS float*)d_in[8]; p.diff_g = (const GAS float*)d_in[9];
  p.fox_w_in = (const GAS float*)d_in[10]; p.fox_w_out = (const GAS float*)d_in[11]; p.fox_bf = (const GAS float*)d_in[12];
  p.fox_qg = (const GAS float*)d_in[13]; p.fox_kg = (const GAS float*)d_in[14];
  p.w1 = (const GAS float*)d_in[15]; p.w2 = (const GAS float*)d_in[16];
  p.ln1g = (const GAS float*)d_in[17]; p.ln1b = (const GAS float*)d_in[18]; p.ln2g = (const GAS float*)d_in[19]; p.ln2b = (const GAS float*)d_in[20];
  p.out = (GAS float*)d_out; p.ws = (GAS char*)d_ws;
#if COOP
  p.lo = 0; p.hi = N_PHASES;
  void* args[] = {&p};
  hipError_t e = hipLaunchCooperativeKernel((const void*)fwd_mega, dim3(256), dim3(512), args, LDS_BYTES, stream);
  if (e != hipSuccess) fprintf(stderr, "cooperative launch failed: %s\n", hipGetErrorString(e));
#else
  for (int ph = 0; ph < N_PHASES; ++ph) {
    p.lo = ph; p.hi = ph + 1;
    hipLaunchKernelGGL(fwd_mega, dim3(256), dim3(512), LDS_BYTES, stream, p);
  }
#endif
}
```

```cpp
#include <hip/hip_runtime.h>
#include <hip/hip_cooperative_groups.h>
#include <cstdio>
#include <cstdint>
namespace cg = cooperative_groups;

#ifndef COOP
#define COOP 1
#endif
#ifndef ONLY
#define ONLY -1
#endif
#ifndef DUPMASK
#define DUPMASK 0
#endif

typedef unsigned short bf16_t;
typedef short bf16x8 __attribute__((ext_vector_type(8)));
typedef float f32x16 __attribute__((ext_vector_type(16)));
typedef float f32x4 __attribute__((ext_vector_type(4)));
typedef float f32x2 __attribute__((ext_vector_type(2)));
typedef unsigned u32x4 __attribute__((ext_vector_type(4)));
typedef unsigned u32x2 __attribute__((ext_vector_type(2)));
typedef __bf16 bf16x2v __attribute__((ext_vector_type(2)));

#define DI __device__ __forceinline__
#define MFMA32(a, b, c) __builtin_amdgcn_mfma_f32_32x32x16_bf16((a), (b), (c), 0, 0, 0)

constexpr int D = 1024, SEQ = 16384, NTOK = 32768, DFF = 2816;
constexpr int EVEN_IN = 3584, ODD_IN = 4112, ODD_PAD = 4352;
constexpr float ALPHA = 1.6817928305074290f;
constexpr float LOG2E = 1.4426950408889634f;
constexpr size_t MiB = 1u << 20;

constexpr size_t OFF_WEI = 0;
constexpr size_t OFF_WEO = OFF_WEI + (size_t)2 * EVEN_IN * D * 2;
constexpr size_t OFF_WFI = OFF_WEO + (size_t)2 * D * D * 2;
constexpr size_t OFF_WFO = OFF_WFI + (size_t)2 * ODD_PAD * D * 2;
constexpr size_t OFF_W1  = OFF_WFO + (size_t)2 * D * D * 2;
constexpr size_t OFF_W2  = OFF_W1 + (size_t)4 * 2 * DFF * D * 2;
constexpr size_t W_END   = OFF_W2 + (size_t)4 * D * DFF * 2;
static_assert(W_END <= 105 * MiB, "weights region");
constexpr size_t OFF_R1 = 105 * MiB;
constexpr size_t OFF_AB = 361 * MiB;
constexpr size_t OFF_UT = 425 * MiB;
constexpr size_t OFF_DB = 489 * MiB;
constexpr size_t OFF_LF = 490 * MiB;
constexpr size_t OFF_C2 = 492 * MiB;
constexpr size_t OFF_MISC = 494 * MiB;
constexpr size_t OFF_CNT = OFF_MISC + 80 * 1024;
constexpr size_t OFF_XCHG = OFF_MISC + 128 * 1024;

#define GAS __attribute__((address_space(1)))
struct Params {
  const GAS float* x_in;
  const GAS float *even_w_in, *even_w_out, *lb_logits, *lq1, *lk1, *lq2, *lk2, *hgrn_g, *diff_g;
  const GAS float *fox_w_in, *fox_w_out, *fox_bf, *fox_qg, *fox_kg;
  const GAS float *w1, *w2, *ln1g, *ln1b, *ln2g, *ln2b;
  GAS float* out;
  GAS char* ws;
  int lo, hi;
};

DI unsigned pk2(float lo, float hi) { f32x2 v = {lo, hi}; bf16x2v b = __builtin_convertvector(v, bf16x2v); return __builtin_bit_cast(unsigned, b); }
DI bf16_t f2bf(float x) { return (bf16_t)(pk2(x, 0.f) & 0xffffu); }
DI float bf2f(bf16_t v) { return __uint_as_float(((unsigned)v) << 16); }
DI float sigmoidf_(float x) { return __builtin_amdgcn_rcpf(1.f + __builtin_amdgcn_exp2f(-LOG2E * x)); }
DI float siluf_(float x) { return x * __builtin_amdgcn_rcpf(1.f + __builtin_amdgcn_exp2f(-LOG2E * x)); }
DI GAS char* launder(GAS char* q) { asm volatile("" : "+s"(q)); return q; }
DI int tid_l() { int t = threadIdx.x; asm volatile("" : "+v"(t)); return t; }
DI int swz32(int s) { return (s & ~12) | ((s & 4) << 1) | ((s & 8) >> 1); }
DI float xor32(float v) { return __shfl_xor(v, 32, 64); }

DI void convert_w(const float* __restrict__ w, bf16_t* __restrict__ wt, int K, int N, int Npad, int mode, float* tl) {
  const int tid = tid_l();
  const int nkt = K >> 6, nnt = Npad >> 6;
  for (int tile = blockIdx.x; tile < nkt * nnt; tile += gridDim.x) {
    const int k0 = (tile / nnt) << 6, n0 = (tile % nnt) << 6;
#pragma unroll
    for (int i = 0; i < 2; ++i) {
      const int kk = (tid >> 4) + 32 * i, n4 = (tid & 15) << 2;
      const int np = n0 + n4;
      int src = np;
      if (mode == 1) { const int grp = np >> 6, j = np & 63; src = (j < 32) ? grp * 32 + j : DFF + grp * 32 + (j - 32); }
      f32x4 v = {0.f, 0.f, 0.f, 0.f};
      if (src < N) v = *(const f32x4*)(w + (size_t)(k0 + kk) * N + src);
      tl[kk * 65 + n4 + 0] = v[0]; tl[kk * 65 + n4 + 1] = v[1]; tl[kk * 65 + n4 + 2] = v[2]; tl[kk * 65 + n4 + 3] = v[3];
    }
    __syncthreads();
    {
      const int n = tid >> 3, kc = (tid & 7) << 3;
      float f[8];
#pragma unroll
      for (int j = 0; j < 8; ++j) f[j] = tl[(kc + j) * 65 + n];
      u32x4 o = {pk2(f[0], f[1]), pk2(f[2], f[3]), pk2(f[4], f[5]), pk2(f[6], f[7])};
      *(u32x4*)(wt + (size_t)(n0 + n) * K + k0 + kc) = o;
    }
    __syncthreads();
  }
}

DI void phase0(const Params& p, char* lds) {
  float* tl = (float*)lds;
  char* ws = (char*)launder(p.ws);
  for (int j = 0; j < 2; ++j) {
    convert_w(((const float*)p.even_w_in) + (size_t)j * D * EVEN_IN, (bf16_t*)(ws + OFF_WEI) + (size_t)j * EVEN_IN * D, D, EVEN_IN, EVEN_IN, 0, tl);
    convert_w(((const float*)p.even_w_out) + (size_t)j * D * D, (bf16_t*)(ws + OFF_WEO) + (size_t)j * D * D, D, D, D, 0, tl);
    convert_w(((const float*)p.fox_w_in) + (size_t)j * D * ODD_IN, (bf16_t*)(ws + OFF_WFI) + (size_t)j * ODD_PAD * D, D, ODD_IN, ODD_PAD, 0, tl);
    convert_w(((const float*)p.fox_w_out) + (size_t)j * D * D, (bf16_t*)(ws + OFF_WFO) + (size_t)j * D * D, D, D, D, 0, tl);
  }
  for (int l = 0; l < 4; ++l) {
    convert_w(((const float*)p.w1) + (size_t)l * D * 2 * DFF, (bf16_t*)(ws + OFF_W1) + (size_t)l * 2 * DFF * D, D, 2 * DFF, 2 * DFF, 1, tl);
    convert_w(((const float*)p.w2) + (size_t)l * DFF * D, (bf16_t*)(ws + OFF_W2) + (size_t)l * D * DFF, DFF, D, D, 0, tl);
  }
  {
    bf16_t* ab = (bf16_t*)(ws + OFF_AB);
    const size_t n8 = (size_t)NTOK * D / 8;
    for (size_t i = (size_t)blockIdx.x * 512 + tid_l(); i < n8; i += (size_t)gridDim.x * 512) {
      f32x4 a = *(const f32x4*)(((const float*)p.x_in) + i * 8), b = *(const f32x4*)(((const float*)p.x_in) + i * 8 + 4);
      u32x4 o = {pk2(a[0], a[1]), pk2(a[2], a[3]), pk2(b[0], b[1]), pk2(b[2], b[3])};
      *(u32x4*)(ab + i * 8) = o;
    }
  }
  if (blockIdx.x == 0) { const int t_ = tid_l(); if (t_ < 128) ((unsigned*)(ws + OFF_CNT))[t_] = 0u; if (t_ == 128) ((unsigned*)(ws + OFF_CNT))[256] = 0u; }
  if (blockIdx.x == 0) {
    float* misc = (float*)(ws + OFF_MISC);
    const int tid = tid_l();
    {
      const float l0 = ((const float*)p.lb_logits)[tid], l1 = ((const float*)p.lb_logits)[512 + tid];
      const float mx = fmaxf(l0, l1);
      const float e0 = expf(l0 - mx), e1 = expf(l1 - mx);
      const float s0 = e0 / (e0 + e1), s1 = e1 / (e0 + e1);
      misc[tid] = s0 - s0;
      misc[512 + tid] = (s0 + s1) - s0;
    }
    if (tid < 2) {
      float d1 = 0.f, d2 = 0.f;
      for (int i = 0; i < 64; ++i) { d1 += ((const float*)p.lq1)[tid * 64 + i] * ((const float*)p.lk1)[tid * 64 + i]; d2 += ((const float*)p.lq2)[tid * 64 + i] * ((const float*)p.lk2)[tid * 64 + i]; }
      const float lam_init = 0.8f - 0.6f * expf(-0.3f * (float)(2 * tid));
      misc[1024 + tid] = expf(d1) - expf(d2) + lam_init;
      float mq = 0.f, mk = 0.f;
      for (int i = 0; i < 64; ++i) { mq = fmaxf(mq, fabsf(((const float*)p.fox_qg)[tid * 64 + i])); mk = fmaxf(mk, fabsf(((const float*)p.fox_kg)[tid * 64 + i])); }
      const float B = 0.125f * LOG2E * 64.f * mq * mk * 1.02f;
      misc[1032 + tid] = 2.f * B + 8.f;
    }
  }
}

constexpr int LROW = 144;
constexpr int G_XB = 256 * LROW, G_WB = 256 * LROW, G_STAGE = G_XB + G_WB;
constexpr int DIFF_STASH_OFF = 2 * (64 * LROW + 128 * LROW + 256);
constexpr int LDS_BYTES = 2 * G_STAGE;
static_assert(LDS_BYTES >= DIFF_STASH_OFF + 512 * 32 * 4, "lds");

template <class Epi>
DI void gemm_phase(const bf16_t* __restrict__ X, const int ldx, const bf16_t* __restrict__ Wt, const int N, const int K, const Epi& epi, char* lds) {
  const int tid = tid_l(), lane = tid & 63, wave = tid >> 6;
  const int r = lane & 31, hh = lane >> 5;
  const int tw = wave & 3, fw = wave >> 2;
  const int nNt = N >> 8;
  const int ntiles = nNt * (NTOK / 256);
  const int nk = K >> 6;
  const int lrow = tid >> 3, lch = tid & 7;
  const int xcd = blockIdx.x & 7, slot = blockIdx.x >> 3, nchunks = 4 * nNt;
  (void)ntiles;
  u32x4 xr0[4], wr0[4];
  for (int chunk = xcd; chunk < nchunks; chunk += 8) {
    const int L = chunk * 32 + slot, band = L / (4 * nNt), rem = L % (4 * nNt);
    const int mt_ = band * 4 + (rem & 3), nt_ = rem >> 2;
    const char* Xt = (const char*)(X + (size_t)(mt_ * 256) * ldx);
    const char* Wtb = (const char*)(Wt + (size_t)(nt_ * 256) * K);
    const unsigned xoff = (unsigned)(lrow * ldx + lch * 8) * 2u, woff = (unsigned)(lrow * K + lch * 8) * 2u;
    const bool has_next = (chunk + 8 < nchunks);
    const int Ln = (has_next ? chunk + 8 : chunk) * 32 + slot, band_n = Ln / (4 * nNt), rem_n = Ln % (4 * nNt);
    const char* Xt_n = (const char*)(X + (size_t)((band_n * 4 + (rem_n & 3)) * 256) * ldx);
    const char* Wtb_n = (const char*)(Wt + (size_t)((rem_n >> 2) * 256) * K);
    f32x16 acc[2][2][2];
#define G_GLOAD(XR, WR, KT) { _Pragma("unroll") for (int i_ = 0; i_ < 4; ++i_) XR[i_] = *(const u32x4*)(Xt + ((size_t)(64 * i_) * ldx + (KT) * 64) * 2 + xoff); \
    _Pragma("unroll") for (int i_ = 0; i_ < 4; ++i_) WR[i_] = *(const u32x4*)(Wtb + ((size_t)(64 * i_) * K + (KT) * 64) * 2 + woff); }
#define G_LSTORE(XR, WR, STG) { char* xs_ = lds + (STG) * G_STAGE; char* ws_ = xs_ + G_XB; \
    _Pragma("unroll") for (int i_ = 0; i_ < 4; ++i_) *(u32x4*)(xs_ + (lrow + 64 * i_) * LROW + lch * 16) = XR[i_]; \
    _Pragma("unroll") for (int i_ = 0; i_ < 4; ++i_) *(u32x4*)(ws_ + (lrow + 64 * i_) * LROW + lch * 16) = WR[i_]; }
#define G_PART(Q, STG, KT, DOLOAD) { char* xs_ = lds + (STG) * G_STAGE; char* ws_ = xs_ + G_XB; \
    if ((Q) < 2) { _Pragma("unroll") for (int i_ = 2 * (Q); i_ < 2 * (Q) + 2; ++i_) { *(u32x4*)(xs_ + (lrow + 64 * i_) * LROW + lch * 16) = xr0[i_]; \
        if (DOLOAD) xr0[i_] = *(const u32x4*)(xb_ + ((size_t)(64 * i_) * ldx + (KT) * 64) * 2 + xoff); } } \
    else { _Pragma("unroll") for (int i_ = 2 * ((Q) - 2); i_ < 2 * ((Q) - 2) + 2; ++i_) { *(u32x4*)(ws_ + (lrow + 64 * i_) * LROW + lch * 16) = wr0[i_]; \
        if (DOLOAD) wr0[i_] = *(const u32x4*)(wb_ + ((size_t)(64 * i_) * K + (KT) * 64) * 2 + woff); } } \
    __builtin_amdgcn_sched_barrier(0); }
#define G_LDX(XF, KS) { _Pragma("unroll") for (int m = 0; m < 2; ++m) XF[m] = *(const bf16x8*)(xs + (tw * 64 + m * 32 + r) * LROW + (KS) * 32 + hh * 16); }
#define G_LDW(WF, N0, KS) { _Pragma("unroll") for (int n = 0; n < 2; ++n) WF[n] = *(const bf16x8*)(wsm + (fw * 128 + ((N0) + n) * 32 + r) * LROW + (KS) * 32 + hh * 16); }
#define G_MFMA4S(XF, WF, H) { _Pragma("unroll") for (int n = 0; n < 2; ++n) _Pragma("unroll") for (int m = 0; m < 2; ++m) acc[H][n][m] = MFMA32(XF[m], WF[n], acc[H][n][m]); }
#define G_MFMA4(XF, WF, H) { _Pragma("unroll") for (int n = 0; n < 2; ++n) _Pragma("unroll") for (int m = 0; m < 2; ++m) acc[H][n][m] = MFMA32(WF[n], XF[m], acc[H][n][m]); }
#define G_STEP(MM, KS, XC, XN) { G_LDW(wc, 2, KS); if ((KS) < 3) { G_LDX(XN, (KS) + 1); } __builtin_amdgcn_sched_barrier(0); \
    MM(XC, w01, 0); __builtin_amdgcn_sched_barrier(0); if ((KS) < 3) { G_LDW(w01, 0, (KS) + 1); } MM(XC, wc, 1); __builtin_amdgcn_sched_barrier(0); }
#define G_COMPUTE_ST(MM, STG, DOSTORE, NSTG, KTL, DOLOAD) { const char* xs = lds + (STG) * G_STAGE; const char* wsm = xs + G_XB; \
    bf16x8 xfa[2], xfb[2], w01[2], wc[2]; \
    G_LDX(xfa, 0); G_LDW(w01, 0, 0); \
    G_STEP(MM, 0, xfa, xfb); if (DOSTORE) { G_PART(0, NSTG, KTL, DOLOAD); G_PART(1, NSTG, KTL, DOLOAD); } \
    G_STEP(MM, 1, xfb, xfa); if (DOSTORE) G_PART(2, NSTG, KTL, DOLOAD); \
    G_STEP(MM, 2, xfa, xfb); if (DOSTORE) G_PART(3, NSTG, KTL, DOLOAD); \
    G_STEP(MM, 3, xfb, xfa); }
#define G_COMPUTE(MM, STG) { const char* xs = lds + (STG) * G_STAGE; const char* wsm = xs + G_XB; \
    bf16x8 xfa[2], xfb[2], w01[2], wc[2]; \
    G_LDX(xfa, 0); G_LDW(w01, 0, 0); \
    G_STEP(MM, 0, xfa, xfb); G_STEP(MM, 1, xfb, xfa); G_STEP(MM, 2, xfa, xfb); G_STEP(MM, 3, xfb, xfa); }
    asm volatile("" ::: "memory");
    if (chunk == xcd) {
      G_GLOAD(xr0, wr0, 0);
      G_LSTORE(xr0, wr0, 0);
      __syncthreads();
      G_GLOAD(xr0, wr0, 1);
    }
#pragma unroll
    for (int c = 0; c < 2; ++c)
#pragma unroll
      for (int a = 0; a < 2; ++a)
#pragma unroll
        for (int b = 0; b < 2; ++b)
#pragma unroll
          for (int i = 0; i < 16; ++i) acc[c][a][b][i] = 0.f;
#define G_KLOOP(MM) for (int kt = 0; kt < nk; kt += 2) { \
        \
        \
      { const bool in_ = (kt + 2 < nk); const char* xb_ = in_ ? Xt : Xt_n; const char* wb_ = in_ ? Wtb : Wtb_n; \
        const int k2_ = in_ ? kt + 2 : (has_next ? 0 : nk - 1); G_COMPUTE_ST(MM, 0, true, 1, k2_, true); } \
      __syncthreads(); \
      { const bool in_ = (kt + 3 < nk); const char* xb_ = in_ ? Xt : Xt_n; const char* wb_ = in_ ? Wtb : Wtb_n; \
        const int k3_ = in_ ? kt + 3 : (has_next ? 1 : nk - 1); G_COMPUTE_ST(MM, 1, true, 0, k3_, true); } \
      __syncthreads(); \
    }
    const bool sw = Epi::kSwap && epi.swap_tile(nt_);
#define G_EPI_IDS const int t2 = tid_l(); const int r2 = t2 & 31, hh2 = (t2 >> 5) & 1, tw2 = (t2 >> 6) & 3, fw2 = t2 >> 8;
    if (sw) {
      G_KLOOP(G_MFMA4S)
      if constexpr (Epi::kSwap) {
        G_EPI_IDS
        epi.swapped(mt_ * 256 + tw2 * 64, nt_ * 256 + fw2 * 128, acc[0], r2, hh2);
        __builtin_amdgcn_sched_barrier(0);
        epi.swapped(mt_ * 256 + tw2 * 64, nt_ * 256 + fw2 * 128 + 64, acc[1], r2, hh2);
      }
    } else {
      G_KLOOP(G_MFMA4)
      G_EPI_IDS
      if constexpr (Epi::kFull) {
        epi.full(mt_, nt_, acc, tw2, fw2, r2, hh2, lds, t2);
      } else {
        epi(mt_ * 256 + tw2 * 64, nt_ * 256 + fw2 * 128, acc[0], r2, hh2);
        __builtin_amdgcn_sched_barrier(0);
        epi(mt_ * 256 + tw2 * 64, nt_ * 256 + fw2 * 128 + 64, acc[1], r2, hh2);
      }
    }
#undef G_EPI_IDS
#undef G_KLOOP
#undef G_GLOAD
#undef G_LSTORE
#undef G_COMPUTE
#undef G_PART
#undef G_COMPUTE_ST
#undef G_LDX
#undef G_LDW
#undef G_MFMA4
#undef G_MFMA4S
#undef G_STEP
    __builtin_amdgcn_sched_barrier(0);
  }
}

struct EpiEvenIn {
  static constexpr bool kFull = false, kSwap = false;
  DI bool swap_tile(int nt_) const { const int seg = nt_ >> 1; return seg == 2 || seg == 6; }
  char* r1; const float* lb;
#define aq  ((bf16_t*)(r1))
#define alf ((float*)(r1 + 32 * MiB))
#define aiT ((bf16_t*)(r1 + 96 * MiB))
#define ag  ((bf16_t*)(r1 + 128 * MiB))
#define bq  ((bf16_t*)(r1 + 160 * MiB))
#define bk  ((bf16_t*)(r1 + 192 * MiB))
#define bvT ((bf16_t*)(r1 + 224 * MiB))
  DI void operator()(int tok0, int feat0, f32x16 (&acc)[2][2], int r, int hh) const {
    const int seg = feat0 >> 9, c0 = feat0 & 511;
#pragma unroll
    for (int mt = 0; mt < 2; ++mt) {
      const int tok = tok0 + mt * 32 + r, b = tok >> 14, s = tok & (SEQ - 1);
#pragma unroll
      for (int nt = 0; nt < 2; ++nt)
#pragma unroll
        for (int g = 0; g < 4; ++g) {
          const int c = c0 + nt * 32 + 8 * g + 4 * hh;
          const float v0 = acc[nt][mt][4 * g], v1 = acc[nt][mt][4 * g + 1], v2 = acc[nt][mt][4 * g + 2], v3 = acc[nt][mt][4 * g + 3];
          if (seg == 0) { u32x2 o = {pk2(siluf_(v0), siluf_(v1)), pk2(siluf_(v2), siluf_(v3))}; *(u32x2*)(aq + (size_t)tok * 512 + c) = o; }
          else if (seg == 1) {
            f32x4 lbv = *(const f32x4*)(lb + c);
            f32x4 o;
            o[0] = __logf(lbv[0] + (1.f - lbv[0]) * sigmoidf_(v0)); o[1] = __logf(lbv[1] + (1.f - lbv[1]) * sigmoidf_(v1));
            o[2] = __logf(lbv[2] + (1.f - lbv[2]) * sigmoidf_(v2)); o[3] = __logf(lbv[3] + (1.f - lbv[3]) * sigmoidf_(v3));
            *(f32x4*)(alf + (size_t)tok * 512 + c) = o;
          }
          else if (seg == 3) { u32x2 o = {pk2(siluf_(v0), siluf_(v1)), pk2(siluf_(v2), siluf_(v3))}; *(u32x2*)(ag + (size_t)tok * 512 + c) = o; }
          else if (seg == 4) { const float sc = 0.125f * LOG2E; u32x2 o = {pk2(v0 * sc, v1 * sc), pk2(v2 * sc, v3 * sc)}; *(u32x2*)(bq + (size_t)tok * 512 + c) = o; }
          else if (seg == 5) { u32x2 o = {pk2(v0, v1), pk2(v2, v3)}; *(u32x2*)(bk + (size_t)tok * 512 + c) = o; }
          else if (seg == 2) {
            bf16_t* dst = aiT + ((size_t)((b * 4 + (c >> 7)) * 128 + (c & 127))) * SEQ + s;
            dst[0] = f2bf(v0); dst[SEQ] = f2bf(v1); dst[2 * SEQ] = f2bf(v2); dst[3 * SEQ] = f2bf(v3);
          }
          else if (seg == 6) {
            bf16_t* dst = bvT + ((size_t)((b * 4 + (c >> 7)) * 128 + (c & 127))) * SEQ + swz32(s);
            dst[0] = f2bf(v0); dst[SEQ] = f2bf(v1); dst[2 * SEQ] = f2bf(v2); dst[3 * SEQ] = f2bf(v3);
          }
          __builtin_amdgcn_sched_barrier(0);
        }
    }
  }
  DI void swapped(int tok0, int feat0, f32x16 (&acc)[2][2], int r, int hh) const {
    const int seg = feat0 >> 9, c0 = feat0 & 511;
#pragma unroll
    for (int nt = 0; nt < 2; ++nt) {
      const int c = c0 + nt * 32 + r;
#pragma unroll
      for (int mt = 0; mt < 2; ++mt)
#pragma unroll
        for (int g = 0; g < 4; ++g) {
          const int tok = tok0 + mt * 32 + 8 * g + 4 * hh, b = tok >> 14, s = tok & (SEQ - 1);
          u32x2 o = {pk2(acc[nt][mt][4 * g], acc[nt][mt][4 * g + 1]), pk2(acc[nt][mt][4 * g + 2], acc[nt][mt][4 * g + 3])};
          bf16_t* base = (seg == 2 ? aiT : bvT) + ((size_t)((b * 4 + (c >> 7)) * 128 + (c & 127))) * SEQ;
          *(u32x2*)(base + (seg == 2 ? s : swz32(s))) = o;
        }
    }
  }
};

#undef aq
#undef alf
#undef aiT
#undef ag
#undef bq
#undef bk
#undef bvT
struct EpiOddIn {
  static constexpr bool kFull = false, kSwap = false;
  DI bool swap_tile(int nt_) const { return (nt_ >> 2) == 2; }
  char* r1; float* lf; const float *qg, *kg, *bf;
#define fq  ((bf16_t*)(r1))
#define fk  ((bf16_t*)(r1 + 64 * MiB))
#define fvT ((bf16_t*)(r1 + 128 * MiB))
#define fg  ((bf16_t*)(r1 + 192 * MiB))
  DI void operator()(int tok0, int feat0, f32x16 (&acc)[2][2], int r, int hh) const {
    const int seg = feat0 >> 10, c0 = feat0 & 1023;
#pragma unroll
    for (int mt = 0; mt < 2; ++mt) {
      const int tok = tok0 + mt * 32 + r, b = tok >> 14, s = tok & (SEQ - 1);
      if (seg < 2) {
        float ssq = 0.f;
#pragma unroll
        for (int nt = 0; nt < 2; ++nt)
#pragma unroll
          for (int i = 0; i < 16; ++i) ssq += acc[nt][mt][i] * acc[nt][mt][i];
        ssq += xor32(ssq);
        float rs = rsqrtf(ssq * (1.f / 64.f) + 1e-6f);
        if (seg == 0) rs *= 0.125f * LOG2E;
        const float* gg = seg == 0 ? qg : kg;
        bf16_t* dstb = (seg == 0 ? fq : fk) + (size_t)tok * 1024 + c0;
#pragma unroll
        for (int nt = 0; nt < 2; ++nt)
#pragma unroll
          for (int g = 0; g < 4; ++g) {
            const int d = nt * 32 + 8 * g + 4 * hh;
            f32x4 gv = *(const f32x4*)(gg + d);
            u32x2 o = {pk2(acc[nt][mt][4 * g] * rs * gv[0], acc[nt][mt][4 * g + 1] * rs * gv[1]), pk2(acc[nt][mt][4 * g + 2] * rs * gv[2], acc[nt][mt][4 * g + 3] * rs * gv[3])};
            *(u32x2*)(dstb + d) = o;
            __builtin_amdgcn_sched_barrier(0);
          }
      } else if (seg == 2) {
        const int head = c0 >> 6;
#pragma unroll
        for (int nt = 0; nt < 2; ++nt)
#pragma unroll
          for (int g = 0; g < 4; ++g) {
            const int d = nt * 32 + 8 * g + 4 * hh;
            bf16_t* dst = fvT + ((size_t)((b * 16 + head) * 64 + d)) * SEQ + swz32(s);
            dst[0] = f2bf(acc[nt][mt][4 * g]); dst[SEQ] = f2bf(acc[nt][mt][4 * g + 1]); dst[2 * SEQ] = f2bf(acc[nt][mt][4 * g + 2]); dst[3 * SEQ] = f2bf(acc[nt][mt][4 * g + 3]);
          }
      } else if (seg == 3) {
#pragma unroll
        for (int nt = 0; nt < 2; ++nt)
#pragma unroll
          for (int g = 0; g < 4; ++g) {
            const int c = c0 + nt * 32 + 8 * g + 4 * hh;
            u32x2 o = {pk2(sigmoidf_(acc[nt][mt][4 * g]), sigmoidf_(acc[nt][mt][4 * g + 1])), pk2(sigmoidf_(acc[nt][mt][4 * g + 2]), sigmoidf_(acc[nt][mt][4 * g + 3]))};
            *(u32x2*)(fg + (size_t)tok * 1024 + c) = o;
            __builtin_amdgcn_sched_barrier(0);
          }
      } else if (feat0 == 4096) {
#pragma unroll
        for (int g = 0; g < 2; ++g)
#pragma unroll
          for (int j = 0; j < 4; ++j) {
            const int hd = 8 * g + 4 * hh + j;
            const float xv = acc[0][mt][4 * g + j] + bf[hd];
            const float ls = fminf(xv, 0.f) - log1pf(expf(-fabsf(xv)));
            lf[((size_t)(b * 16 + hd)) * SEQ + s] = ls;
          }
      }
    }
  }
  DI void swapped(int tok0, int feat0, f32x16 (&acc)[2][2], int r, int hh) const {
    const int head = (feat0 & 1023) >> 6;
#pragma unroll
    for (int nt = 0; nt < 2; ++nt) {
      const int d = nt * 32 + r;
#pragma unroll
      for (int mt = 0; mt < 2; ++mt)
#pragma unroll
        for (int g = 0; g < 4; ++g) {
          const int tok = tok0 + mt * 32 + 8 * g + 4 * hh, b = tok >> 14, s = tok & (SEQ - 1);
          u32x2 o = {pk2(acc[nt][mt][4 * g], acc[nt][mt][4 * g + 1]), pk2(acc[nt][mt][4 * g + 2], acc[nt][mt][4 * g + 3])};
          *(u32x2*)(fvT + ((size_t)((b * 16 + head) * 64 + d)) * SEQ + swz32(s)) = o;
        }
    }
  }
};

#undef fq
#undef fk
#undef fvT
#undef fg
struct EpiRes {
  static constexpr bool kFull = false;
  const float* xin; float* y;
  DI void operator()(int tok0, int feat0, f32x16 (&acc)[2][2], int r, int hh) const {
#pragma unroll
    for (int mt = 0; mt < 2; ++mt) {
      const size_t rowo = (size_t)(tok0 + mt * 32 + r) * 1024;
#pragma unroll
      for (int nt = 0; nt < 2; ++nt)
#pragma unroll
        for (int g = 0; g < 4; ++g) {
          const int c = feat0 + nt * 32 + 8 * g + 4 * hh;
          f32x4 xv = *(const f32x4*)(xin + rowo + c);
          f32x4 o = {ALPHA * xv[0] + acc[nt][mt][4 * g], ALPHA * xv[1] + acc[nt][mt][4 * g + 1], ALPHA * xv[2] + acc[nt][mt][4 * g + 2], ALPHA * xv[3] + acc[nt][mt][4 * g + 3]};
          *(f32x4*)(y + rowo + c) = o;
          if (g & 1) __builtin_amdgcn_sched_barrier(0);
        }
    }
  }
};

struct EpiResLN {
  static constexpr bool kFull = true, kSwap = false;
  DI bool swap_tile(int) const { return false; }
  const float* xin; float* xout; bf16_t* xb; const float *g, *b; float* xchg; unsigned* cnt; unsigned target;
  DI void full(const int mt_, const int nt_, f32x16 (&acc)[2][2][2], const int tw, const int fw, const int r, const int hh, char* lds, const int tid) const {
    float* part = (float*)(lds + G_STAGE);
#pragma unroll
    for (int mt = 0; mt < 2; ++mt) {
      const size_t rowo = (size_t)(mt_ * 256 + tw * 64 + mt * 32 + r) * 1024 + nt_ * 256 + fw * 128 + 4 * hh;
      float sm = 0.f, sq = 0.f;
#pragma unroll
      for (int half = 0; half < 2; ++half)
#pragma unroll
        for (int nt = 0; nt < 2; ++nt) {
#pragma unroll
          for (int gq = 0; gq < 4; ++gq) {
            f32x4 xv = *(const f32x4*)(xin + rowo + half * 64 + nt * 32 + 8 * gq);
#pragma unroll
            for (int jj = 0; jj < 4; ++jj) { const float y = ALPHA * xv[jj] + acc[half][nt][mt][4 * gq + jj]; acc[half][nt][mt][4 * gq + jj] = y; sm += y; sq += y * y; }
          }
          __builtin_amdgcn_sched_barrier(0);
        }
      sm += xor32(sm); sq += xor32(sq);
      if (hh == 0) { float* pp = part + ((fw * 256) + tw * 64 + mt * 32 + r) * 2; pp[0] = sm; pp[1] = sq; }
    }
    __syncthreads();
    if (tid < 256) {
      f32x2 a = *(const f32x2*)(part + tid * 2), c = *(const f32x2*)(part + (256 + tid) * 2);
      const unsigned long long pk = ((unsigned long long)__float_as_uint(a[1] + c[1]) << 32) | (unsigned long long)__float_as_uint(a[0] + c[0]);
      __hip_atomic_store((GAS unsigned long long*)(xchg + ((size_t)(mt_ * 4 + nt_) * 256 + tid) * 2), pk, __ATOMIC_RELAXED, __HIP_MEMORY_SCOPE_AGENT);
    }
    asm volatile("s_waitcnt vmcnt(0)" ::: "memory");
    __syncthreads();
    if (tid == 0) {
      __hip_atomic_fetch_add((GAS unsigned*)(cnt + mt_), 1u, __ATOMIC_RELAXED, __HIP_MEMORY_SCOPE_AGENT);
      while (__hip_atomic_load((GAS unsigned*)(cnt + mt_), __ATOMIC_RELAXED, __HIP_MEMORY_SCOPE_AGENT) < target) __builtin_amdgcn_s_sleep(1);
    }
    __syncthreads();
#pragma unroll
    for (int mt = 0; mt < 2; ++mt) {
      const int tl = tw * 64 + mt * 32 + r;
      float S = 0.f, Q = 0.f;
#pragma unroll
      for (int k = 0; k < 4; ++k) {
        const unsigned long long pk = __hip_atomic_load((GAS unsigned long long*)(xchg + ((size_t)(mt_ * 4 + k) * 256 + tl) * 2), __ATOMIC_RELAXED, __HIP_MEMORY_SCOPE_AGENT);
        S += __uint_as_float((unsigned)pk);
        Q += __uint_as_float((unsigned)(pk >> 32));
      }
      const float mean = S * (1.f / 1024.f);
      const float rstd = rsqrtf(fmaxf(Q * (1.f / 1024.f) - mean * mean, 0.f) + 1e-5f);
      const int c0 = nt_ * 256 + fw * 128 + 4 * hh;
      const size_t rowo = (size_t)(mt_ * 256 + tl) * 1024 + c0;
#pragma unroll
      for (int half = 0; half < 2; ++half)
#pragma unroll
        for (int nt = 0; nt < 2; ++nt) {
#pragma unroll
          for (int gq = 0; gq < 4; ++gq) {
            const int co = half * 64 + nt * 32 + 8 * gq;
            f32x4 gv = *(const f32x4*)(g + c0 + co), bv = *(const f32x4*)(b + c0 + co), o;
#pragma unroll
            for (int jj = 0; jj < 4; ++jj) o[jj] = (acc[half][nt][mt][4 * gq + jj] - mean) * rstd * gv[jj] + bv[jj];
            *(f32x4*)(xout + rowo + co) = o;
            u32x2 ob = {pk2(o[0], o[1]), pk2(o[2], o[3])};
            *(u32x2*)(xb + rowo + co) = ob;
          }
          __builtin_amdgcn_sched_barrier(0);
        }
    }
    __syncthreads();
  }
};

struct EpiW1 {
  static constexpr bool kFull = false, kSwap = false;
  DI bool swap_tile(int) const { return false; }
  DI void swapped(int, int, f32x16 (&)[2][2], int, int) const {}
  bf16_t* act;
  DI void operator()(int tok0, int feat0, f32x16 (&acc)[2][2], int r, int hh) const {
    const int u0 = (feat0 >> 6) * 32;
#pragma unroll
    for (int mt = 0; mt < 2; ++mt) {
      bf16_t* dst = act + (size_t)(tok0 + mt * 32 + r) * DFF + u0 + 4 * hh;
#pragma unroll
      for (int g = 0; g < 4; ++g) {
        u32x2 o = {pk2(siluf_(acc[0][mt][4 * g]) * acc[1][mt][4 * g], siluf_(acc[0][mt][4 * g + 1]) * acc[1][mt][4 * g + 1]),
                   pk2(siluf_(acc[0][mt][4 * g + 2]) * acc[1][mt][4 * g + 2], siluf_(acc[0][mt][4 * g + 3]) * acc[1][mt][4 * g + 3])};
        *(u32x2*)(dst + 8 * g) = o;
      }
    }
  }
};

DI float wave_sum(float v) {
#pragma unroll
  for (int o = 32; o >= 1; o >>= 1) v += __shfl_xor(v, o, 64);
  return v;
}
DI void ln_phase(float* x, bf16_t* xb, const float* __restrict__ g, const float* __restrict__ bta) {
  const int tid = tid_l(); const int lane = tid & 63, wave = tid >> 6;
  for (int row = blockIdx.x * 8 + wave; row < NTOK; row += gridDim.x * 8) {
    float* xr = x + (size_t)row * 1024;
    f32x4 v[4];
    float s = 0.f;
#pragma unroll
    for (int i = 0; i < 4; ++i) { v[i] = *(const f32x4*)(xr + (i * 64 + lane) * 4); s += v[i][0] + v[i][1] + v[i][2] + v[i][3]; }
    const float mean = wave_sum(s) * (1.f / 1024.f);
    float q = 0.f;
#pragma unroll
    for (int i = 0; i < 4; ++i)
#pragma unroll
      for (int j = 0; j < 4; ++j) { const float d = v[i][j] - mean; q += d * d; }
    const float rstd = rsqrtf(wave_sum(q) * (1.f / 1024.f) + 1e-5f);
#pragma unroll
    for (int i = 0; i < 4; ++i) {
      const int c = (i * 64 + lane) * 4;
      f32x4 gv = *(const f32x4*)(g + c), bv = *(const f32x4*)(bta + c), o;
#pragma unroll
      for (int j = 0; j < 4; ++j) o[j] = (v[i][j] - mean) * rstd * gv[j] + bv[j];
      *(f32x4*)(xr + c) = o;
      u32x2 ob = {pk2(o[0], o[1]), pk2(o[2], o[3])};
      *(u32x2*)(xb + (size_t)row * 1024 + c) = ob;
    }
  }
}

DI void cumsum_phase(const float* __restrict__ lf, float* __restrict__ c2, char* lds) {
  float* wt = (float*)lds;
  const int tid = tid_l(), lane = tid & 63, wave = tid >> 6;
  for (int row = blockIdx.x; row < 32; row += gridDim.x) {
    const float* src = lf + (size_t)row * SEQ + tid * 32;
    float v[32];
#pragma unroll
    for (int i = 0; i < 8; ++i) { f32x4 t = *(const f32x4*)(src + 4 * i); v[4 * i] = t[0]; v[4 * i + 1] = t[1]; v[4 * i + 2] = t[2]; v[4 * i + 3] = t[3]; }
    float run = 0.f;
#pragma unroll
    for (int i = 0; i < 32; ++i) { run += v[i]; v[i] = run; }
    float inc = run;
#pragma unroll
    for (int o = 1; o < 64; o <<= 1) { const float t = __shfl_up(inc, o, 64); if (lane >= o) inc += t; }
    if (lane == 63) wt[wave] = inc;
    __syncthreads();
    float pre = inc - run;
    for (int w = 0; w < wave; ++w) pre += wt[w];
    float* dst = c2 + (size_t)row * SEQ + tid * 32;
#pragma unroll
    for (int i = 0; i < 8; ++i) { f32x4 o = {(pre + v[4 * i]) * LOG2E, (pre + v[4 * i + 1]) * LOG2E, (pre + v[4 * i + 2]) * LOG2E, (pre + v[4 * i + 3]) * LOG2E}; *(f32x4*)(dst + 4 * i) = o; }
    __syncthreads();
  }
}

template <int DVT, bool FOX>
DI void attn_step(const char* kb, const bf16x8 (&qf)[4], f32x16 (&o)[DVT], float& m, float& l, const bool diag, const int j, const int tq, const int r, const int hh) {
  constexpr int VB = DVT * 32 * LROW;
  const char* vb = kb + 64 * LROW; const char* cb = vb + VB;
  f32x16 st[2];
  bf16x8 kf[8];
#pragma unroll
  for (int ks = 0; ks < 4; ++ks)
#pragma unroll
    for (int kt = 0; kt < 2; ++kt) kf[ks * 2 + kt] = *(const bf16x8*)(kb + (kt * 32 + r) * LROW + ks * 32 + hh * 16);
  if (FOX) {
#pragma unroll
    for (int kt = 0; kt < 2; ++kt)
#pragma unroll
      for (int g = 0; g < 4; ++g) {
        f32x4 cs = *(const f32x4*)(cb + (kt * 32 + 8 * g + 4 * hh) * 4);
        st[kt][4 * g] = cs[0]; st[kt][4 * g + 1] = cs[1]; st[kt][4 * g + 2] = cs[2]; st[kt][4 * g + 3] = cs[3];
      }
  } else {
#pragma unroll
    for (int kt = 0; kt < 2; ++kt)
#pragma unroll
      for (int i = 0; i < 16; ++i) st[kt][i] = 0.f;
  }
  __builtin_amdgcn_sched_barrier(0);
#pragma unroll
  for (int ks = 0; ks < 4; ++ks)
#pragma unroll
    for (int kt = 0; kt < 2; ++kt) st[kt] = MFMA32(kf[ks * 2 + kt], qf[ks], st[kt]);
  bf16x8 va[DVT], vn[DVT];
#pragma unroll
  for (int d = 0; d < DVT; ++d) va[d] = *(const bf16x8*)(vb + (d * 32 + r) * LROW + (8 * hh) * 2);
  __builtin_amdgcn_sched_barrier(0);
  {
    const f32x2 mm = {m, m};
#pragma unroll
    for (int kt = 0; kt < 2; ++kt)
#pragma unroll
      for (int i = 0; i < 8; ++i) { f32x2 z = {st[kt][2 * i], st[kt][2 * i + 1]}; z = z - mm; st[kt][2 * i] = z[0]; st[kt][2 * i + 1] = z[1]; }
  }
  if (FOX) {
    if (diag) {
#pragma unroll
      for (int kt = 0; kt < 2; ++kt)
#pragma unroll
        for (int i = 0; i < 16; ++i) {
          const int key = j * 64 + kt * 32 + (i & 3) + 8 * (i >> 2) + 4 * hh;
          if (key > tq) st[kt][i] = -INFINITY;
        }
    }
  }
  float mx;
  {
    float a0 = fmaxf(fmaxf(st[0][0], st[0][1]), st[0][2]), a1 = fmaxf(fmaxf(st[1][0], st[1][1]), st[1][2]);
#pragma unroll
    for (int i = 3; i < 15; i += 2) { a0 = fmaxf(fmaxf(a0, st[0][i]), st[0][i + 1]); a1 = fmaxf(fmaxf(a1, st[1][i]), st[1][i + 1]); }
    mx = fmaxf(fmaxf(a0, a1), fmaxf(st[0][15], st[1][15]));
  }
  mx = fmaxf(mx, xor32(mx));
  if (__any(diag || mx > 8.f)) {
    const float d = (diag || mx > 0.f) ? mx : 0.f;
    const float alpha = diag ? 0.f : __builtin_amdgcn_exp2f(-d);
    m += d;
    l *= alpha;
#pragma unroll
    for (int dd = 0; dd < DVT; ++dd)
#pragma unroll
      for (int i = 0; i < 16; ++i) o[dd][i] *= alpha;
    const f32x2 d2 = {d, d};
#pragma unroll
    for (int kt = 0; kt < 2; ++kt)
#pragma unroll
      for (int i = 0; i < 8; ++i) { f32x2 z = {st[kt][2 * i], st[kt][2 * i + 1]}; z = z - d2; st[kt][2 * i] = z[0]; st[kt][2 * i + 1] = z[1]; }
  }
  f32x2 ls2 = {0.f, 0.f};
#pragma unroll
  for (int kt = 0; kt < 2; ++kt)
#pragma unroll
    for (int i = 0; i < 8; ++i) {
      f32x2 pv = {__builtin_amdgcn_exp2f(st[kt][2 * i]), __builtin_amdgcn_exp2f(st[kt][2 * i + 1])};
      st[kt][2 * i] = pv[0]; st[kt][2 * i + 1] = pv[1];
      ls2 = ls2 + pv;
    }
  l += ls2[0] + ls2[1];
  __builtin_amdgcn_sched_barrier(0);
#define A_PVGROUP(GK, VC, VN) { constexpr int kt_ = (GK) >> 1, s2_ = (GK) & 1; \
    if ((GK) < 3) { constexpr int kt1_ = ((GK) + 1) >> 1, s21_ = ((GK) + 1) & 1; \
      _Pragma("unroll") for (int d = 0; d < DVT; ++d) VN[d] = *(const bf16x8*)(vb + (d * 32 + r) * LROW + (kt1_ * 32 + 16 * s21_ + 8 * hh) * 2); } \
    u32x4 pw_ = {pk2(st[kt_][8 * s2_], st[kt_][8 * s2_ + 1]), pk2(st[kt_][8 * s2_ + 2], st[kt_][8 * s2_ + 3]), pk2(st[kt_][8 * s2_ + 4], st[kt_][8 * s2_ + 5]), pk2(st[kt_][8 * s2_ + 6], st[kt_][8 * s2_ + 7])}; \
    const bf16x8 pf_ = __builtin_bit_cast(bf16x8, pw_); \
    __builtin_amdgcn_sched_barrier(0); \
    _Pragma("unroll") for (int d = 0; d < DVT; ++d) o[d] = MFMA32(VC[d], pf_, o[d]); \
    __builtin_amdgcn_sched_barrier(0); }
  A_PVGROUP(0, va, vn); A_PVGROUP(1, vn, va); A_PVGROUP(2, va, vn); A_PVGROUP(3, vn, va);
#undef A_PVGROUP
}

template <int DVT, bool FOX>
DI void attn_pass(const bf16_t* __restrict__ qrow, const bf16_t* __restrict__ kbase, const int ldk, const bf16_t* __restrict__ vtbase,
                  const float* __restrict__ cbase, const int j_hi, const int my_last, const int j_lo_diag, const int tq, const float prune_c,
                  f32x16 (&o)[DVT], float& l_out, char* lds) {
  constexpr int VB = DVT * 32 * LROW;
  constexpr int STAGE = 64 * LROW + VB + 256;
  const int tid = tid_l(), lane = tid & 63;
  const int r = lane & 31, hh = lane >> 5;
  const int lrow = tid >> 3, lch = tid & 7;
  bf16x8 qf[4];
#pragma unroll
  for (int ks = 0; ks < 4; ++ks) qf[ks] = *(const bf16x8*)(qrow + ks * 16 + hh * 8);
#pragma unroll
  for (int d = 0; d < DVT; ++d)
#pragma unroll
    for (int i = 0; i < 16; ++i) o[d][i] = 0.f;
  float m = 0.f, l = 0.f;
  u32x4 kr0, kr1, vr0[DVT / 2], vr1[DVT / 2]; f32x4 cr0 = {0.f, 0.f, 0.f, 0.f}, cr1 = {0.f, 0.f, 0.f, 0.f};
  const bf16_t* kp = kbase + (size_t)lrow * ldk + lch * 8;
  const bf16_t* vp = vtbase + (size_t)lrow * SEQ + lch * 8;
#define A_GLOAD(KR, VR, CR, JT) { const int s1_ = (JT) * 64; KR = *(const u32x4*)(kp + (size_t)s1_ * ldk); \
    _Pragma("unroll") for (int i_ = 0; i_ < DVT / 2; ++i_) VR[i_] = *(const u32x4*)(vp + (size_t)(64 * i_) * SEQ + s1_); \
    if (FOX) { if (tid < 16) { f32x4 t_ = *(const f32x4*)(cbase + s1_ + tid * 4); CR[0] = -t_[0]; CR[1] = -t_[1]; CR[2] = -t_[2]; CR[3] = -t_[3]; } } }
#define A_LSTORE(KR, VR, CR, STG) { char* kb_ = lds + (STG) * STAGE; char* vb_ = kb_ + 64 * LROW; char* cb_ = vb_ + VB; \
    *(u32x4*)(kb_ + lrow * LROW + lch * 16) = KR; \
    _Pragma("unroll") for (int i_ = 0; i_ < DVT / 2; ++i_) *(u32x4*)(vb_ + (lrow + 64 * i_) * LROW + lch * 16) = VR[i_]; \
    if (FOX) { if (tid < 16) *(f32x4*)(cb_ + tid * 16) = CR; } }
#define A_PRUNE(STG) (FOX && j < j_lo_diag && (prune_c + *(const float*)(lds + (STG) * STAGE + 64 * LROW + VB + 63 * 4) < -160.f))
  int j = j_hi;
  A_GLOAD(kr0, vr0, cr0, j);
  if (j >= 1) A_GLOAD(kr1, vr1, cr1, j - 1);
  A_LSTORE(kr0, vr0, cr0, 0);
  __syncthreads();
  for (;;) {
    if (A_PRUNE(0)) break;
    if (j >= 2) A_GLOAD(kr0, vr0, cr0, j - 2);
    if (j <= my_last) attn_step<DVT, FOX>(lds, qf, o, m, l, j == my_last, j, tq, r, hh);
    if (j == 0) break;
    A_LSTORE(kr1, vr1, cr1, 1);
    __syncthreads();
    --j;
    if (A_PRUNE(1)) break;
    if (j >= 2) A_GLOAD(kr1, vr1, cr1, j - 2);
    if (j <= my_last) attn_step<DVT, FOX>(lds + STAGE, qf, o, m, l, j == my_last, j, tq, r, hh);
    if (j == 0) break;
    A_LSTORE(kr0, vr0, cr0, 0);
    __syncthreads();
    --j;
  }
  __syncthreads();
#undef A_GLOAD
#undef A_LSTORE
#undef A_PRUNE
  l_out = l + xor32(l);
}

DI void fox_phase(const Params& p, const int j_odd, char* lds) {
  char* ws = (char*)launder(p.ws);
  const bf16_t* fq = (const bf16_t*)(ws + OFF_R1);
  const bf16_t* fk = (const bf16_t*)(ws + OFF_R1 + 64 * MiB);
  const bf16_t* fvT = (const bf16_t*)(ws + OFF_R1 + 128 * MiB);
  const bf16_t* fg = (const bf16_t*)(ws + OFF_R1 + 192 * MiB);
  const float* c2 = (const float*)(ws + OFF_C2);
  bf16_t* ab = (bf16_t*)(ws + OFF_AB);
  const float b2 = ((const float*)(ws + OFF_MISC))[1032 + j_odd];
  const int tid = tid_l(); const int lane = tid & 63, wave = __builtin_amdgcn_readfirstlane(tid >> 6), r = lane & 31, hh = lane >> 5;
  for (int rnd = 0; rnd < 4; ++rnd) {
    const int bh = rnd * 8 + (blockIdx.x & 7), pp = blockIdx.x >> 3, b = bh >> 4, h = bh & 15;
    for (int half = 0; half < 2; ++half) {
      const int qb = half == 0 ? 63 - pp : pp;
      const int t0 = qb * 256, tq0 = t0 + wave * 32, tq = tq0 + r;
      const int nkv = (t0 + 256) >> 6, my_last = (tq0 + 31) >> 6;
      const float prune_c = b2 + c2[(size_t)bh * SEQ + t0];
      f32x16 o[2]; float l;
      attn_pass<2, true>(fq + (size_t)(b * SEQ + tq) * 1024 + h * 64, fk + (size_t)(b * SEQ) * 1024 + h * 64, 1024,
                         fvT + (size_t)(bh * 64) * SEQ, c2 + (size_t)bh * SEQ, nkv - 1, my_last, t0 >> 6, tq, prune_c, o, l, lds);
      const float inv = 1.f / l;
      const size_t rowo = (size_t)(b * SEQ + tq) * 1024 + h * 64;
#pragma unroll
      for (int d = 0; d < 2; ++d)
#pragma unroll
        for (int g = 0; g < 4; ++g) {
          const int c = d * 32 + 8 * g + 4 * hh;
          u32x2 gv = *(const u32x2*)(fg + rowo + c);
          const float g0 = __uint_as_float(gv[0] << 16), g1 = __uint_as_float(gv[0] & 0xffff0000u), g2 = __uint_as_float(gv[1] << 16), g3 = __uint_as_float(gv[1] & 0xffff0000u);
          u32x2 ov = {pk2(o[d][4 * g] * inv * g0, o[d][4 * g + 1] * inv * g1), pk2(o[d][4 * g + 2] * inv * g2, o[d][4 * g + 3] * inv * g3)};
          *(u32x2*)(ab + rowo + c) = ov;
        }
    }
  }
}

DI void diff_phase(const Params& p, const int j_even, char* lds) {
  char* ws = (char*)launder(p.ws);
  const bf16_t* bq = (const bf16_t*)(ws + OFF_R1 + 160 * MiB);
  const bf16_t* bk = (const bf16_t*)(ws + OFF_R1 + 192 * MiB);
  const bf16_t* bvT = (const bf16_t*)(ws + OFF_R1 + 224 * MiB);
  bf16_t* ab = (bf16_t*)(ws + OFF_AB);
  const float* misc = (const float*)(ws + OFF_MISC);
  const float lam = misc[1024 + j_even];
  const float lam_init = 0.8f - 0.6f * expf(-0.3f * (float)(2 * j_even));
  const float* dg = ((const float*)p.diff_g) + j_even * 128;
  const int tid = tid_l(); const int lane = tid & 63, wave = __builtin_amdgcn_readfirstlane(tid >> 6), r = lane & 31, hh = lane >> 5;
  {
    const int bh = blockIdx.x & 7, pp = blockIdx.x >> 3, b = bh >> 2, h = bh & 3;
    for (int half = 0; half < 2; ++half) {
      const int qb = half == 0 ? 63 - pp : pp;
      const int t0 = qb * 256, tq0 = t0 + wave * 32, tq = tq0 + r;
      const int nkv = (t0 + 256) >> 6, my_last = tq0 >> 6;
      f32x16 o1[4], o2[4]; float l1, l2;
      attn_pass<4, false>(bq + (size_t)(b * SEQ + tq) * 512 + h * 128, bk + (size_t)(b * SEQ) * 512 + h * 128, 512,
                          bvT + (size_t)(bh * 128) * SEQ, nullptr, nkv - 1, my_last, 0, tq, 0.f, o1, l1, lds);
      const float i1 = 1.f / l1;
      unsigned* o1s = (unsigned*)(lds + DIFF_STASH_OFF) + tid;
#pragma unroll
      for (int d = 0; d < 4; ++d)
#pragma unroll
        for (int i = 0; i < 8; ++i) o1s[(d * 8 + i) * 512] = pk2(o1[d][2 * i] * i1, o1[d][2 * i + 1] * i1);
      attn_pass<4, false>(bq + (size_t)(b * SEQ + tq) * 512 + h * 128 + 64, bk + (size_t)(b * SEQ) * 512 + h * 128 + 64, 512,
                          bvT + (size_t)(bh * 128) * SEQ, nullptr, nkv - 1, my_last, 0, tq, 0.f, o2, l2, lds);
      const float i2 = lam / l2;
      float ssq = 0.f;
#pragma unroll
      for (int d = 0; d < 4; ++d)
#pragma unroll
        for (int i = 0; i < 8; ++i) {
          const unsigned pw = o1s[(d * 8 + i) * 512];
          const float va = __uint_as_float(pw << 16) - i2 * o2[d][2 * i], vb = __uint_as_float(pw & 0xffff0000u) - i2 * o2[d][2 * i + 1];
          o2[d][2 * i] = va; o2[d][2 * i + 1] = vb; ssq += va * va + vb * vb; }
      ssq += xor32(ssq);
      const float rs = rsqrtf(ssq * (1.f / 128.f) + 1e-6f) * (1.f - lam_init);
      const size_t rowo = (size_t)(b * SEQ + tq) * 1024 + 512 + h * 128;
#pragma unroll
      for (int d = 0; d < 4; ++d)
#pragma unroll
        for (int g = 0; g < 4; ++g) {
          const int c = d * 32 + 8 * g + 4 * hh;
          f32x4 gv = *(const f32x4*)(dg + c);
          u32x2 ov = {pk2(o2[d][4 * g] * rs * gv[0], o2[d][4 * g + 1] * rs * gv[1]), pk2(o2[d][4 * g + 2] * rs * gv[2], o2[d][4 * g + 3] * rs * gv[3])};
          *(u32x2*)(ab + rowo + c) = ov;
        }
    }
  }
}

DI void hgrn_stageA(const Params& p, char* lds) {
  char* ws = (char*)launder(p.ws);
  const float* alf = (const float*)(ws + OFF_R1 + 32 * MiB);
  const bf16_t* aiT = (const bf16_t*)(ws + OFF_R1 + 96 * MiB);
  bf16_t* UT = (bf16_t*)(ws + OFF_UT);
  float* dbuf = (float*)(ws + OFF_DB);
  float* lfT = (float*)lds;
  float* part = (float*)(lds + 32768);
  char* KT = lds + 34816;
  char* IT = KT + 18432;
  const int tid = tid_l(), lane = tid & 63, wave = tid >> 6, r = lane & 31, hh = lane >> 5;
  for (int task = blockIdx.x; task < 2048; task += gridDim.x) {
    const int bh = task >> 8, c = task & 255, b = bh >> 2, h = bh & 3;
    const int tok0 = b * SEQ + c * 64;
#pragma unroll
    for (int i = 0; i < 4; ++i) {
      const int idx = tid + 512 * i, row = idx >> 5, c4 = idx & 31;
      *(f32x4*)(lfT + row * 128 + c4 * 4) = *(const f32x4*)(alf + (size_t)(tok0 + row) * 512 + h * 128 + c4 * 4);
    }
#pragma unroll
    for (int i = 0; i < 2; ++i) {
      const int idx = tid + 512 * i, row = idx >> 3, ch = idx & 7;
      *(u32x4*)(IT + row * LROW + ch * 16) = *(const u32x4*)(aiT + (size_t)(bh * 128 + row) * SEQ + c * 64 + ch * 8);
    }
    __syncthreads();
    const int k = tid & 127, seg = tid >> 7;
    float lv[16], bv[16];
    float run = 0.f;
#pragma unroll
    for (int i = 0; i < 16; ++i) { lv[i] = lfT[(seg * 16 + i) * 128 + k]; run += lv[i]; bv[i] = run; }
    part[seg * 128 + k] = run;
    __syncthreads();
    float pre = 0.f, tot = 0.f;
#pragma unroll
    for (int s2 = 0; s2 < 4; ++s2) { const float pv = part[s2 * 128 + k]; if (s2 < seg) pre += pv; tot += pv; }
    {
      float kv[16];
#pragma unroll
      for (int i = 0; i < 16; ++i) kv[i] = (1.f - __expf(lv[i])) * __expf(tot - (pre + bv[i]));
      u32x4 w0 = {pk2(kv[0], kv[1]), pk2(kv[2], kv[3]), pk2(kv[4], kv[5]), pk2(kv[6], kv[7])};
      u32x4 w1 = {pk2(kv[8], kv[9]), pk2(kv[10], kv[11]), pk2(kv[12], kv[13]), pk2(kv[14], kv[15])};
      *(u32x4*)(KT + k * LROW + seg * 32) = w0;
      *(u32x4*)(KT + k * LROW + seg * 32 + 16) = w1;
    }
    if (seg == 0) dbuf[(size_t)task * 128 + k] = __expf(tot);
    __syncthreads();
    {
      const int ktile = wave & 3, vhalf = wave >> 2;
      f32x16 acc[2];
#pragma unroll
      for (int vt = 0; vt < 2; ++vt)
#pragma unroll
        for (int i = 0; i < 16; ++i) acc[vt][i] = 0.f;
#pragma unroll
      for (int ks = 0; ks < 4; ++ks) {
        bf16x8 a = *(const bf16x8*)(KT + (ktile * 32 + r) * LROW + ks * 32 + hh * 16);
#pragma unroll
        for (int vt = 0; vt < 2; ++vt) {
          bf16x8 bb = *(const bf16x8*)(IT + (vhalf * 64 + vt * 32 + r) * LROW + ks * 32 + hh * 16);
          acc[vt] = MFMA32(a, bb, acc[vt]);
        }
      }
#pragma unroll
      for (int vt = 0; vt < 2; ++vt) {
        bf16_t* dst = UT + ((size_t)task * 128 + vhalf * 64 + vt * 32 + r) * 128 + ktile * 32 + 4 * hh;
#pragma unroll
        for (int g = 0; g < 4; ++g) { u32x2 ov = {pk2(acc[vt][4 * g], acc[vt][4 * g + 1]), pk2(acc[vt][4 * g + 2], acc[vt][4 * g + 3])}; *(u32x2*)(dst + 8 * g) = ov; }
      }
    }
    __syncthreads();
  }
}

DI void hgrn_scan(const Params& p) {
  char* ws = (char*)launder(p.ws);
  bf16_t* UT = (bf16_t*)(ws + OFF_UT);
  const float* dbuf = (const float*)(ws + OFF_DB);
  const int gid = blockIdx.x * 512 + tid_l();
  if (gid >= 8 * 16384) return;
  const int bh = gid >> 14, e = gid & 16383;
  bf16_t* up = UT + (size_t)bh * 256 * 16384 + e;
  const float* dp = dbuf + (size_t)bh * 256 * 128 + (e & 127);
  float st = 0.f;
  for (int c0 = 0; c0 < 256; c0 += 32) {
    bf16_t u[32]; float dv[32];
#pragma unroll
    for (int i = 0; i < 32; ++i) { u[i] = up[(size_t)(c0 + i) * 16384]; dv[i] = dp[(size_t)(c0 + i) * 128]; }
#pragma unroll
    for (int i = 0; i < 32; ++i) {
      up[(size_t)(c0 + i) * 16384] = f2bf(st);
      st = dv[i] * st + bf2f(u[i]);
    }
  }
}

constexpr int QROW = 272;
DI void hgrn_stageC(const Params& p, const int j_even, char* lds) {
  char* ws = (char*)launder(p.ws);
  const bf16_t* aq = (const bf16_t*)(ws + OFF_R1);
  const float* alf = (const float*)(ws + OFF_R1 + 32 * MiB);
  const bf16_t* aiT = (const bf16_t*)(ws + OFF_R1 + 96 * MiB);
  const bf16_t* ag = (const bf16_t*)(ws + OFF_R1 + 128 * MiB);
  const bf16_t* UT = (const bf16_t*)(ws + OFF_UT);
  bf16_t* ab = (bf16_t*)(ws + OFF_AB);
  const float* hg = ((const float*)p.hgrn_g) + j_even * 128;
  float* lfT = (float*)lds;
  char* ST = lds;
  char* Q1 = lds + 34816;
  char* Q2 = Q1 + 64 * QROW;
  char* K2 = Q2 + 64 * QROW;
  char* IT = K2 + 64 * QROW;
  float* part = (float*)(IT + 128 * LROW);
  const int tid = tid_l(), lane = tid & 63, wave = tid >> 6, r = lane & 31, hh = lane >> 5;
  for (int task = blockIdx.x; task < 2048; task += gridDim.x) {
    const int bh = task >> 8, c = task & 255, b = bh >> 2, h = bh & 3;
    const int tok0 = b * SEQ + c * 64;
#pragma unroll
    for (int i = 0; i < 4; ++i) {
      const int idx = tid + 512 * i, row = idx >> 5, c4 = idx & 31;
      *(f32x4*)(lfT + row * 128 + c4 * 4) = *(const f32x4*)(alf + (size_t)(tok0 + row) * 512 + h * 128 + c4 * 4);
    }
#pragma unroll
    for (int i = 0; i < 2; ++i) {
      const int idx = tid + 512 * i, row = idx >> 3, ch = idx & 7;
      *(u32x4*)(IT + row * LROW + ch * 16) = *(const u32x4*)(aiT + (size_t)(bh * 128 + row) * SEQ + c * 64 + ch * 8);
    }
    u32x4 sreg[4];
#pragma unroll
    for (int i = 0; i < 4; ++i) sreg[i] = *(const u32x4*)(UT + (size_t)task * 16384 + (size_t)(tid + 512 * i) * 8);
    __syncthreads();
    const int k = tid & 127, seg = tid >> 7;
    float lv[16], bv[16];
    float run = 0.f;
#pragma unroll
    for (int i = 0; i < 16; ++i) { lv[i] = lfT[(seg * 16 + i) * 128 + k]; run += lv[i]; bv[i] = run; }
    part[seg * 128 + k] = run;
    __syncthreads();
    {
      const float p0 = part[k], p1 = part[128 + k], p2 = part[256 + k];
      const float pre = (seg > 0 ? p0 : 0.f) + (seg > 1 ? p1 : 0.f) + (seg > 2 ? p2 : 0.f);
      const float bmid = p0 + p1;
#pragma unroll
      for (int i = 0; i < 16; ++i) {
        const int t = seg * 16 + i;
        const float bt = pre + bv[i];
        const float qv = bf2f(aq[(size_t)(tok0 + t) * 512 + h * 128 + k]);
        const float kk = 1.f - __expf(lv[i]);
        *(bf16_t*)(Q1 + t * QROW + k * 2) = f2bf(qv * __expf(bt));
        *(bf16_t*)(Q2 + t * QROW + k * 2) = f2bf(qv * __expf(fminf(bt - bmid, 80.f)));
        *(bf16_t*)(K2 + t * QROW + k * 2) = f2bf(kk * __expf(fminf(bmid - bt, 80.f)));
      }
    }
#pragma unroll
    for (int i = 0; i < 4; ++i) { const int idx = tid + 512 * i, row = idx >> 4, ch = idx & 15; *(u32x4*)(ST + row * QROW + ch * 16) = sreg[i]; }
    __syncthreads();
    {
      const int vt = wave & 3, tt = wave >> 2;
      const int t = tt * 32 + r;
      f32x16 sc[2];
#pragma unroll
      for (int st = 0; st < 2; ++st)
#pragma unroll
        for (int i = 0; i < 16; ++i) sc[st][i] = 0.f;
#pragma unroll
      for (int ks = 0; ks < 8; ++ks) {
        bf16x8 qb = *(const bf16x8*)(Q2 + t * QROW + ks * 32 + hh * 16);
#pragma unroll
        for (int st = 0; st < 2; ++st) {
          if (st <= tt) {
            bf16x8 a = *(const bf16x8*)(K2 + (st * 32 + r) * QROW + ks * 32 + hh * 16);
            sc[st] = MFMA32(a, qb, sc[st]);
          }
        }
      }
      f32x16 acc;
#pragma unroll
      for (int i = 0; i < 16; ++i) acc[i] = 0.f;
#pragma unroll
      for (int st = 0; st < 2; ++st) {
        if (st <= tt) {
#pragma unroll
          for (int i = 0; i < 16; ++i) { const int s = st * 32 + (i & 3) + 8 * (i >> 2) + 4 * hh; if (s > t) sc[st][i] = 0.f; }
#pragma unroll
          for (int s2 = 0; s2 < 2; ++s2) {
            u32x4 pw = {pk2(sc[st][8 * s2], sc[st][8 * s2 + 1]), pk2(sc[st][8 * s2 + 2], sc[st][8 * s2 + 3]), pk2(sc[st][8 * s2 + 4], sc[st][8 * s2 + 5]), pk2(sc[st][8 * s2 + 6], sc[st][8 * s2 + 7])};
            const bf16x8 pf = __builtin_bit_cast(bf16x8, pw);
            const char* ip = IT + (vt * 32 + r) * LROW + (st * 32 + 16 * s2 + 4 * hh) * 2;
            u32x2 lo = *(const u32x2*)ip, hi = *(const u32x2*)(ip + 16);
            u32x4 aw = {lo[0], lo[1], hi[0], hi[1]};
            acc = MFMA32(__builtin_bit_cast(bf16x8, aw), pf, acc);
          }
        }
      }
#pragma unroll
      for (int ks = 0; ks < 8; ++ks) {
        bf16x8 a = *(const bf16x8*)(ST + (vt * 32 + r) * QROW + ks * 32 + hh * 16);
        bf16x8 qb = *(const bf16x8*)(Q1 + t * QROW + ks * 32 + hh * 16);
        acc = MFMA32(a, qb, acc);
      }
      float ssq = 0.f;
#pragma unroll
      for (int i = 0; i < 16; ++i) ssq += acc[i] * acc[i];
      ssq += xor32(ssq);
      if (hh == 0) part[vt * 64 + t] = ssq;
      __syncthreads();
      const float tot = part[t] + part[64 + t] + part[128 + t] + part[192 + t];
      const float rs = rsqrtf(tot * (1.f / 128.f) + 1e-6f);
      const size_t go = (size_t)(tok0 + t) * 512 + h * 128 + vt * 32 + 4 * hh;
      const size_t oo = (size_t)(tok0 + t) * 1024 + h * 128 + vt * 32 + 4 * hh;
#pragma unroll
      for (int g = 0; g < 4; ++g) {
        f32x4 gn = *(const f32x4*)(hg + vt * 32 + 4 * hh + 8 * g);
        u32x2 gv = *(const u32x2*)(ag + go + 8 * g);
        const float g0 = __uint_as_float(gv[0] << 16), g1 = __uint_as_float(gv[0] & 0xffff0000u), g2 = __uint_as_float(gv[1] << 16), g3 = __uint_as_float(gv[1] & 0xffff0000u);
        u32x2 ov = {pk2(acc[4 * g] * rs * gn[0] * g0, acc[4 * g + 1] * rs * gn[1] * g1), pk2(acc[4 * g + 2] * rs * gn[2] * g2, acc[4 * g + 3] * rs * gn[3] * g3)};
        *(u32x2*)(ab + oo + 8 * g) = ov;
      }
    }
    __syncthreads();
  }
}

DI void grid_barrier(unsigned* ctr, const unsigned target) {
  asm volatile("s_waitcnt vmcnt(0)" ::: "memory");
  __syncthreads();
  if (threadIdx.x == 0) {
    __builtin_amdgcn_fence(__ATOMIC_RELEASE, "agent");
    asm volatile("s_waitcnt vmcnt(0)" ::: "memory");
    __hip_atomic_fetch_add((GAS unsigned*)ctr, 1u, __ATOMIC_RELAXED, __HIP_MEMORY_SCOPE_AGENT);
    while (__hip_atomic_load((GAS unsigned*)ctr, __ATOMIC_RELAXED, __HIP_MEMORY_SCOPE_AGENT) < target) __builtin_amdgcn_s_sleep(1);
    __builtin_amdgcn_fence(__ATOMIC_ACQUIRE, "agent");
    asm volatile("s_waitcnt vmcnt(0)" ::: "memory");
  }
  __syncthreads();
}
typedef const __attribute__((address_space(4))) Params* kparams_t;
#if defined(__HIP_DEVICE_COMPILE__)
DI kparams_t launder_k(kparams_t q) { asm volatile("" : "+s"(q)); return q; }
#endif
#if defined(__HIP_DEVICE_COMPILE__)
#define KPARAMS (*launder_k((kparams_t)__builtin_amdgcn_kernarg_segment_ptr()))
#else
#define KPARAMS p_arg
#endif
__global__ void __launch_bounds__(512) fwd_mega(Params p_arg) {
  extern __shared__ __attribute__((aligned(16))) char lds[];
  int ph = 0;
  const int p_lo = p_arg.lo, p_hi = p_arg.hi;
#define PHASE(id, ...) { if (ph >= p_lo && ph < p_hi) { const Params p = KPARAMS; char* ws = (char*)launder(p.ws); float* outp = (float*)launder((GAS char*)p.out); bf16_t* ab = (bf16_t*)(ws + OFF_AB); (void)outp; (void)ab; \
    if (ONLY < 0 || ONLY == id) { __VA_ARGS__; } if ((DUPMASK >> id) & 1) { __syncthreads(); __VA_ARGS__; } if (ph + 1 < p_hi) { if (ph == p_lo) cg::this_grid().sync(); else grid_barrier((unsigned*)(ws + OFF_CNT) + 256, (unsigned)(ph - p_lo) * gridDim.x); } } ++ph; }
  PHASE(0, phase0(p, lds));
  for (int l = 0; l < 4; ++l) {
    const int j = l >> 1;
    if ((l & 1) == 0) {
      PHASE(1,
        EpiEvenIn e;
        e.r1 = ws + OFF_R1; e.lb = (const float*)(ws + OFF_MISC) + j * 512;
        gemm_phase(ab, 1024, (const bf16_t*)(ws + OFF_WEI) + (size_t)j * EVEN_IN * D, EVEN_IN, D, e, lds));
      PHASE(2, hgrn_stageA(p, lds));
      PHASE(3, hgrn_scan(p));
      PHASE(4, hgrn_stageC(p, j, lds); diff_phase(p, j, lds));
      PHASE(6,
        EpiResLN er; er.xin = (l == 0) ? (const float*)launder((GAS char*)p.x_in) : outp; er.xout = outp; er.xb = ab;
        er.g = ((const float*)p.ln1g) + l * D; er.b = ((const float*)p.ln1b) + l * D;
        er.xchg = (float*)(ws + OFF_XCHG); er.cnt = (unsigned*)(ws + OFF_CNT); er.target = 4u * (unsigned)(2 * l + 1);
        gemm_phase(ab, 1024, (const bf16_t*)(ws + OFF_WEO) + (size_t)j * D * D, D, D, er, lds));
    } else {
      PHASE(7,
        EpiOddIn e;
        e.r1 = ws + OFF_R1;
        e.lf = (float*)(ws + OFF_LF); e.qg = ((const float*)p.fox_qg) + j * 64; e.kg = ((const float*)p.fox_kg) + j * 64; e.bf = ((const float*)p.fox_bf) + j * 16;
        gemm_phase(ab, 1024, (const bf16_t*)(ws + OFF_WFI) + (size_t)j * ODD_PAD * D, ODD_PAD, D, e, lds));
      PHASE(8, cumsum_phase((const float*)(ws + OFF_LF), (float*)(ws + OFF_C2), lds));
      PHASE(9, fox_phase(p, j, lds));
      PHASE(6,
        EpiResLN er; er.xin = outp; er.xout = outp; er.xb = ab;
        er.g = ((const float*)p.ln1g) + l * D; er.b = ((const float*)p.ln1b) + l * D;
        er.xchg = (float*)(ws + OFF_XCHG); er.cnt = (unsigned*)(ws + OFF_CNT); er.target = 4u * (unsigned)(2 * l + 1);
        gemm_phase(ab, 1024, (const bf16_t*)(ws + OFF_WFO) + (size_t)j * D * D, D, D, er, lds));
    }
    PHASE(11,
      EpiW1 e1; e1.act = (bf16_t*)(ws + OFF_R1);
      gemm_phase(ab, 1024, (const bf16_t*)(ws + OFF_W1) + (size_t)l * 2 * DFF * D, 2 * DFF, D, e1, lds));
    PHASE(6,
      EpiResLN e2; e2.xin = outp; e2.xout = outp; e2.xb = ab;
      e2.g = ((const float*)p.ln2g) + l * D; e2.b = ((const float*)p.ln2b) + l * D;
      e2.xchg = (float*)(ws + OFF_XCHG); e2.cnt = (unsigned*)(ws + OFF_CNT); e2.target = 4u * (unsigned)(2 * l + 2);
      gemm_phase((const bf16_t*)(ws + OFF_R1), DFF, (const bf16_t*)(ws + OFF_W2) + (size_t)l * D * DFF, D, DFF, e2, lds));
  }
#undef PHASE
}
constexpr int N_PHASES = 1 + 2 * 7 + 2 * 6;

extern "C" void kernel_launch(void* const* d_in, const int* in_sizes, int n_in, void* d_out, int out_size, void* d_ws, size_t ws_size, hipStream_t stream) {
  static bool attr = false;
  if (!attr) { hipFuncSetAttribute((const void*)fwd_mega, hipFuncAttributeMaxDynamicSharedMemorySize, LDS_BYTES); attr = true; }
  Params p{};
  p.x_in = (const GAS float*)d_in[0];
  p.even_w_in = (const GAS float*)d_in[1]; p.even_w_out = (const GAS float*)d_in[2]; p.lb_logits = (const GAS float*)d_in[3];
  p.lq1 = (const GAS float*)d_in[4]; p.lk1 = (const GAS float*)d_in[5]; p.lq2 = (const GAS float*)d_in[6]; p.lk2 = (const GAS float*)d_in[7];
  p.hgrn_g = (const GAS float*)d_in[8]; p.diff_g = (const GAS float*)d_in[9];
  p.fox_w_in = (const GAS float*)d_in[10]; p.fox_w_out = (const GAS float*)d_in[11]; p.fox_bf = (const GAS float*)d_in[12];
  p.fox_qg = (const GAS float*)d_in[13]; p.fox_kg = (const GAS float*)d_in[14];
  p.w1 = (const GAS float*)d_in[15]; p.w2 = (const GAS float*)d_in[16];
  p.ln1g = (const GAS float*)d_in[17]; p.ln1b = (const GAS float*)d_in[18]; p.ln2g = (const GAS float*)d_in[19]; p.ln2b = (const GAS float*)d_in[20];
  p.out = (GAS float*)d_out; p.ws = (GAS char*)d_ws;
#if COOP
  p.lo = 0; p.hi = N_PHASES;
  void* args[] = {&p};
  hipError_t e = hipLaunchCooperativeKernel((const void*)fwd_mega, dim3(256), dim3(512), args, LDS_BYTES, stream);
  if (e != hipSuccess) fprintf(stderr, "cooperative launch failed: %s\n", hipGetErrorString(e));
#else
  for (int ph = 0; ph < N_PHASES; ++ph) {
    p.lo = ph; p.hi = ph + 1;
    hipLaunchKernelGGL(fwd_mega, dim3(256), dim3(512), LDS_BYTES, stream, p);
  }
#endif
}
```

```cpp
#include <hip/hip_runtime.h>
#include <hip/hip_cooperative_groups.h>
#include <cstdio>
#include <cstdint>
namespace cg = cooperative_groups;

#ifndef COOP
#define COOP 1
#endif
#ifndef ONLY
#define ONLY -1
#endif
#ifndef DUPMASK
#define DUPMASK 0
#endif

typedef unsigned short bf16_t;
typedef short bf16x8 __attribute__((ext_vector_type(8)));
typedef float f32x16 __attribute__((ext_vector_type(16)));
typedef float f32x4 __attribute__((ext_vector_type(4)));
typedef float f32x2 __attribute__((ext_vector_type(2)));
typedef unsigned u32x4 __attribute__((ext_vector_type(4)));
typedef unsigned u32x2 __attribute__((ext_vector_type(2)));
typedef __bf16 bf16x2v __attribute__((ext_vector_type(2)));

#define DI __device__ __forceinline__
#define MFMA32(a, b, c) __builtin_amdgcn_mfma_f32_32x32x16_bf16((a), (b), (c), 0, 0, 0)

constexpr int D = 1024, SEQ = 16384, NTOK = 32768, DFF = 2816;
constexpr int EVEN_IN = 3584, ODD_IN = 4112, ODD_PAD = 4352;
constexpr float ALPHA = 1.6817928305074290f;
constexpr float LOG2E = 1.4426950408889634f;
constexpr size_t MiB = 1u << 20;

constexpr size_t OFF_WEI = 0;
constexpr size_t OFF_WEO = OFF_WEI + (size_t)2 * EVEN_IN * D * 2;
constexpr size_t OFF_WFI = OFF_WEO + (size_t)2 * D * D * 2;
constexpr size_t OFF_WFO = OFF_WFI + (size_t)2 * ODD_PAD * D * 2;
constexpr size_t OFF_W1  = OFF_WFO + (size_t)2 * D * D * 2;
constexpr size_t OFF_W2  = OFF_W1 + (size_t)4 * 2 * DFF * D * 2;
constexpr size_t W_END   = OFF_W2 + (size_t)4 * D * DFF * 2;
static_assert(W_END <= 105 * MiB, "weights region");
constexpr size_t OFF_R1 = 105 * MiB;
constexpr size_t OFF_AB = 361 * MiB;
constexpr size_t OFF_UT = 425 * MiB;
constexpr size_t OFF_DB = 489 * MiB;
constexpr size_t OFF_LF = 490 * MiB;
constexpr size_t OFF_C2 = 492 * MiB;
constexpr size_t OFF_MISC = 494 * MiB;
constexpr size_t OFF_CNT = OFF_MISC + 80 * 1024;
constexpr size_t OFF_XCHG = OFF_MISC + 128 * 1024;

#define GAS __attribute__((address_space(1)))
struct Params {
  const GAS float* x_in;
  const GAS float *even_w_in, *even_w_out, *lb_logits, *lq1, *lk1, *lq2, *lk2, *hgrn_g, *diff_g;
  const GAS float *fox_w_in, *fox_w_out, *fox_bf, *fox_qg, *fox_kg;
  const GAS float *w1, *w2, *ln1g, *ln1b, *ln2g, *ln2b;
  GAS float* out;
  GAS char* ws;
  int lo, hi;
};

DI unsigned pk2(float lo, float hi) { f32x2 v = {lo, hi}; bf16x2v b = __builtin_convertvector(v, bf16x2v); return __builtin_bit_cast(unsigned, b); }
DI bf16_t f2bf(float x) { return (bf16_t)(pk2(x, 0.f) & 0xffffu); }
DI float bf2f(bf16_t v) { return __uint_as_float(((unsigned)v) << 16); }
DI float sigmoidf_(float x) { return __builtin_amdgcn_rcpf(1.f + __builtin_amdgcn_exp2f(-LOG2E * x)); }
DI float siluf_(float x) { return x * __builtin_amdgcn_rcpf(1.f + __builtin_amdgcn_exp2f(-LOG2E * x)); }
DI GAS char* launder(GAS char* q) { asm volatile("" : "+s"(q)); return q; }
DI int tid_l() { int t = threadIdx.x; asm volatile("" : "+v"(t)); return t; }
DI int swz32(int s) { return (s & ~12) | ((s & 4) << 1) | ((s & 8) >> 1); }
DI float xor32(float v) { return __shfl_xor(v, 32, 64); }

DI void convert_w(const float* __restrict__ w, bf16_t* __restrict__ wt, int K, int N, int Npad, int mode, float* tl) {
  const int tid = tid_l();
  const int nkt = K >> 6, nnt = Npad >> 6;
  for (int tile = blockIdx.x; tile < nkt * nnt; tile += gridDim.x) {
    const int k0 = (tile / nnt) << 6, n0 = (tile % nnt) << 6;
#pragma unroll
    for (int i = 0; i < 2; ++i) {
      const int kk = (tid >> 4) + 32 * i, n4 = (tid & 15) << 2;
      const int np = n0 + n4;
      int src = np;
      if (mode == 1) { const int grp = np >> 6, j = np & 63; src = (j < 32) ? grp * 32 + j : DFF + grp * 32 + (j - 32); }
      f32x4 v = {0.f, 0.f, 0.f, 0.f};
      if (src < N) v = *(const f32x4*)(w + (size_t)(k0 + kk) * N + src);
      tl[kk * 65 + n4 + 0] = v[0]; tl[kk * 65 + n4 + 1] = v[1]; tl[kk * 65 + n4 + 2] = v[2]; tl[kk * 65 + n4 + 3] = v[3];
    }
    __syncthreads();
    {
      const int n = tid >> 3, kc = (tid & 7) << 3;
      float f[8];
#pragma unroll
      for (int j = 0; j < 8; ++j) f[j] = tl[(kc + j) * 65 + n];
      u32x4 o = {pk2(f[0], f[1]), pk2(f[2], f[3]), pk2(f[4], f[5]), pk2(f[6], f[7])};
      *(u32x4*)(wt + (size_t)(n0 + n) * K + k0 + kc) = o;
    }
    __syncthreads();
  }
}

DI void phase0(const Params& p, char* lds) {
  float* tl = (float*)lds;
  char* ws = (char*)launder(p.ws);
  for (int j = 0; j < 2; ++j) {
    convert_w(((const float*)p.even_w_in) + (size_t)j * D * EVEN_IN, (bf16_t*)(ws + OFF_WEI) + (size_t)j * EVEN_IN * D, D, EVEN_IN, EVEN_IN, 0, tl);
    convert_w(((const float*)p.even_w_out) + (size_t)j * D * D, (bf16_t*)(ws + OFF_WEO) + (size_t)j * D * D, D, D, D, 0, tl);
    convert_w(((const float*)p.fox_w_in) + (size_t)j * D * ODD_IN, (bf16_t*)(ws + OFF_WFI) + (size_t)j * ODD_PAD * D, D, ODD_IN, ODD_PAD, 0, tl);
    convert_w(((const float*)p.fox_w_out) + (size_t)j * D * D, (bf16_t*)(ws + OFF_WFO) + (size_t)j * D * D, D, D, D, 0, tl);
  }
  for (int l = 0; l < 4; ++l) {
    convert_w(((const float*)p.w1) + (size_t)l * D * 2 * DFF, (bf16_t*)(ws + OFF_W1) + (size_t)l * 2 * DFF * D, D, 2 * DFF, 2 * DFF, 1, tl);
    convert_w(((const float*)p.w2) + (size_t)l * DFF * D, (bf16_t*)(ws + OFF_W2) + (size_t)l * D * DFF, DFF, D, D, 0, tl);
  }
  {
    bf16_t* ab = (bf16_t*)(ws + OFF_AB);
    const size_t n8 = (size_t)NTOK * D / 8;
    for (size_t i = (size_t)blockIdx.x * 512 + tid_l(); i < n8; i += (size_t)gridDim.x * 512) {
      f32x4 a = *(const f32x4*)(((const float*)p.x_in) + i * 8), b = *(const f32x4*)(((const float*)p.x_in) + i * 8 + 4);
      u32x4 o = {pk2(a[0], a[1]), pk2(a[2], a[3]), pk2(b[0], b[1]), pk2(b[2], b[3])};
      *(u32x4*)(ab + i * 8) = o;
    }
  }
  if (blockIdx.x == 0) { const int t_ = tid_l(); if (t_ < 128) ((unsigned*)(ws + OFF_CNT))[t_] = 0u; if (t_ == 128) ((unsigned*)(ws + OFF_CNT))[256] = 0u; }
  if (blockIdx.x == 0) {
    float* misc = (float*)(ws + OFF_MISC);
    const int tid = tid_l();
    {
      const float l0 = ((const float*)p.lb_logits)[tid], l1 = ((const float*)p.lb_logits)[512 + tid];
      const float mx = fmaxf(l0, l1);
      const float e0 = expf(l0 - mx), e1 = expf(l1 - mx);
      const float s0 = e0 / (e0 + e1), s1 = e1 / (e0 + e1);
      misc[tid] = s0 - s0;
      misc[512 + tid] = (s0 + s1) - s0;
    }
    if (tid < 2) {
      float d1 = 0.f, d2 = 0.f;
      for (int i = 0; i < 64; ++i) { d1 += ((const float*)p.lq1)[tid * 64 + i] * ((const float*)p.lk1)[tid * 64 + i]; d2 += ((const float*)p.lq2)[tid * 64 + i] * ((const float*)p.lk2)[tid * 64 + i]; }
      const float lam_init = 0.8f - 0.6f * expf(-0.3f * (float)(2 * tid));
      misc[1024 + tid] = expf(d1) - expf(d2) + lam_init;
      float mq = 0.f, mk = 0.f;
      for (int i = 0; i < 64; ++i) { mq = fmaxf(mq, fabsf(((const float*)p.fox_qg)[tid * 64 + i])); mk = fmaxf(mk, fabsf(((const float*)p.fox_kg)[tid * 64 + i])); }
      const float B = 0.125f * LOG2E * 64.f * mq * mk * 1.02f;
      misc[1032 + tid] = 2.f * B + 8.f;
    }
  }
}

constexpr int LROW = 144;
constexpr int G_XB = 256 * LROW, G_WB = 256 * LROW, G_STAGE = G_XB + G_WB;
constexpr int DIFF_STASH_OFF = 2 * (64 * LROW + 128 * LROW + 256);
constexpr int LDS_BYTES = 2 * G_STAGE;
static_assert(LDS_BYTES >= DIFF_STASH_OFF + 512 * 32 * 4, "lds");

template <class Epi>
DI void gemm_phase(const bf16_t* __restrict__ X, const int ldx, const bf16_t* __restrict__ Wt, const int N, const int K, const Epi& epi, char* lds) {
  const int tid = tid_l(), lane = tid & 63, wave = tid >> 6;
  const int r = lane & 31, hh = lane >> 5;
  const int tw = wave & 3, fw = wave >> 2;
  const int nNt = N >> 8;
  const int ntiles = nNt * (NTOK / 256);
  const int nk = K >> 6;
  const int lrow = tid >> 3, lch = tid & 7;
  const int xcd = blockIdx.x & 7, slot = blockIdx.x >> 3, nchunks = 4 * nNt;
  (void)ntiles;
  u32x4 xr0[4], wr0[4];
  for (int chunk = xcd; chunk < nchunks; chunk += 8) {
    const int L = chunk * 32 + slot, band = L / (4 * nNt), rem = L % (4 * nNt);
    const int mt_ = band * 4 + (rem & 3), nt_ = rem >> 2;
    const char* Xt = (const char*)(X + (size_t)(mt_ * 256) * ldx);
    const char* Wtb = (const char*)(Wt + (size_t)(nt_ * 256) * K);
    const unsigned xoff = (unsigned)(lrow * ldx + lch * 8) * 2u, woff = (unsigned)(lrow * K + lch * 8) * 2u;
    const bool has_next = (chunk + 8 < nchunks);
    const int Ln = (has_next ? chunk + 8 : chunk) * 32 + slot, band_n = Ln / (4 * nNt), rem_n = Ln % (4 * nNt);
    const char* Xt_n = (const char*)(X + (size_t)((band_n * 4 + (rem_n & 3)) * 256) * ldx);
    const char* Wtb_n = (const char*)(Wt + (size_t)((rem_n >> 2) * 256) * K);
    f32x16 acc[2][2][2];
#define G_GLOAD(XR, WR, KT) { _Pragma("unroll") for (int i_ = 0; i_ < 4; ++i_) XR[i_] = *(const u32x4*)(Xt + ((size_t)(64 * i_) * ldx + (KT) * 64) * 2 + xoff); \
    _Pragma("unroll") for (int i_ = 0; i_ < 4; ++i_) WR[i_] = *(const u32x4*)(Wtb + ((size_t)(64 * i_) * K + (KT) * 64) * 2 + woff); }
#define G_LSTORE(XR, WR, STG) { char* xs_ = lds + (STG) * G_STAGE; char* ws_ = xs_ + G_XB; \
    _Pragma("unroll") for (int i_ = 0; i_ < 4; ++i_) *(u32x4*)(xs_ + (lrow + 64 * i_) * LROW + lch * 16) = XR[i_]; \
    _Pragma("unroll") for (int i_ = 0; i_ < 4; ++i_) *(u32x4*)(ws_ + (lrow + 64 * i_) * LROW + lch * 16) = WR[i_]; }
#define G_PART(Q, STG, KT, DOLOAD) { char* xs_ = lds + (STG) * G_STAGE; char* ws_ = xs_ + G_XB; \
    if ((Q) < 2) { _Pragma("unroll") for (int i_ = 2 * (Q); i_ < 2 * (Q) + 2; ++i_) { *(u32x4*)(xs_ + (lrow + 64 * i_) * LROW + lch * 16) = xr0[i_]; \
        if (DOLOAD) xr0[i_] = *(const u32x4*)(xb_ + ((size_t)(64 * i_) * ldx + (KT) * 64) * 2 + xoff); } } \
    else { _Pragma("unroll") for (int i_ = 2 * ((Q) - 2); i_ < 2 * ((Q) - 2) + 2; ++i_) { *(u32x4*)(ws_ + (lrow + 64 * i_) * LROW + lch * 16) = wr0[i_]; \
        if (DOLOAD) wr0[i_] = *(const u32x4*)(wb_ + ((size_t)(64 * i_) * K + (KT) * 64) * 2 + woff); } } \
    __builtin_amdgcn_sched_barrier(0); }
#define G_LDX(XF, KS) { _Pragma("unroll") for (int m = 0; m < 2; ++m) XF[m] = *(const bf16x8*)(xs + (tw * 64 + m * 32 + r) * LROW + (KS) * 32 + hh * 16); }
#define G_LDW(WF, N0, KS) { _Pragma("unroll") for (int n = 0; n < 2; ++n) WF[n] = *(const bf16x8*)(wsm + (fw * 128 + ((N0) + n) * 32 + r) * LROW + (KS) * 32 + hh * 16); }
#define G_MFMA4S(XF, WF, H) { _Pragma("unroll") for (int n = 0; n < 2; ++n) _Pragma("unroll") for (int m = 0; m < 2; ++m) acc[H][n][m] = MFMA32(XF[m], WF[n], acc[H][n][m]); }
#define G_MFMA4(XF, WF, H) { _Pragma("unroll") for (int n = 0; n < 2; ++n) _Pragma("unroll") for (int m = 0; m < 2; ++m) acc[H][n][m] = MFMA32(WF[n], XF[m], acc[H][n][m]); }
#define G_STEP(MM, KS, XC, XN) { G_LDW(wc, 2, KS); if ((KS) < 3) { G_LDX(XN, (KS) + 1); } __builtin_amdgcn_sched_barrier(0); \
    MM(XC, w01, 0); __builtin_amdgcn_sched_barrier(0); if ((KS) < 3) { G_LDW(w01, 0, (KS) + 1); } MM(XC, wc, 1); __builtin_amdgcn_sched_barrier(0); }
#define G_COMPUTE_ST(MM, STG, DOSTORE, NSTG, KTL, DOLOAD) { const char* xs = lds + (STG) * G_STAGE; const char* wsm = xs + G_XB; \
    bf16x8 xfa[2], xfb[2], w01[2], wc[2]; \
    G_LDX(xfa, 0); G_LDW(w01, 0, 0); \
    G_STEP(MM, 0, xfa, xfb); if (DOSTORE) { G_PART(0, NSTG, KTL, DOLOAD); G_PART(1, NSTG, KTL, DOLOAD); } \
    G_STEP(MM, 1, xfb, xfa); if (DOSTORE) G_PART(2, NSTG, KTL, DOLOAD); \
    G_STEP(MM, 2, xfa, xfb); if (DOSTORE) G_PART(3, NSTG, KTL, DOLOAD); \
    G_STEP(MM, 3, xfb, xfa); }
#define G_COMPUTE(MM, STG) { const char* xs = lds + (STG) * G_STAGE; const char* wsm = xs + G_XB; \
    bf16x8 xfa[2], xfb[2], w01[2], wc[2]; \
    G_LDX(xfa, 0); G_LDW(w01, 0, 0); \
    G_STEP(MM, 0, xfa, xfb); G_STEP(MM, 1, xfb, xfa); G_STEP(MM, 2, xfa, xfb); G_STEP(MM, 3, xfb, xfa); }
    asm volatile("" ::: "memory");
    if (chunk == xcd) {
      G_GLOAD(xr0, wr0, 0);
      G_LSTORE(xr0, wr0, 0);
      __syncthreads();
      G_GLOAD(xr0, wr0, 1);
    }
#pragma unroll
    for (int c = 0; c < 2; ++c)
#pragma unroll
      for (int a = 0; a < 2; ++a)
#pragma unroll
        for (int b = 0; b < 2; ++b)
#pragma unroll
          for (int i = 0; i < 16; ++i) acc[c][a][b][i] = 0.f;
#define G_KLOOP(MM) for (int kt = 0; kt < nk; kt += 2) { \
        \
        \
      { const bool in_ = (kt + 2 < nk); const char* xb_ = in_ ? Xt : Xt_n; const char* wb_ = in_ ? Wtb : Wtb_n; \
        const int k2_ = in_ ? kt + 2 : (has_next ? 0 : nk - 1); G_COMPUTE_ST(MM, 0, true, 1, k2_, true); } \
      __syncthreads(); \
      { const bool in_ = (kt + 3 < nk); const char* xb_ = in_ ? Xt : Xt_n; const char* wb_ = in_ ? Wtb : Wtb_n; \
        const int k3_ = in_ ? kt + 3 : (has_next ? 1 : nk - 1); G_COMPUTE_ST(MM, 1, true, 0, k3_, true); } \
      __syncthreads(); \
    }
    const bool sw = Epi::kSwap && epi.swap_tile(nt_);
#define G_EPI_IDS const int t2 = tid_l(); const int r2 = t2 & 31, hh2 = (t2 >> 5) & 1, tw2 = (t2 >> 6) & 3, fw2 = t2 >> 8;
    if (sw) {
      G_KLOOP(G_MFMA4S)
      if constexpr (Epi::kSwap) {
        G_EPI_IDS
        epi.swapped(mt_ * 256 + tw2 * 64, nt_ * 256 + fw2 * 128, acc[0], r2, hh2);
        __builtin_amdgcn_sched_barrier(0);
        epi.swapped(mt_ * 256 + tw2 * 64, nt_ * 256 + fw2 * 128 + 64, acc[1], r2, hh2);
      }
    } else {
      G_KLOOP(G_MFMA4)
      G_EPI_IDS
      if constexpr (Epi::kFull) {
        epi.full(mt_, nt_, acc, tw2, fw2, r2, hh2, lds, t2);
      } else {
        epi(mt_ * 256 + tw2 * 64, nt_ * 256 + fw2 * 128, acc[0], r2, hh2);
        __builtin_amdgcn_sched_barrier(0);
        epi(mt_ * 256 + tw2 * 64, nt_ * 256 + fw2 * 128 + 64, acc[1], r2, hh2);
      }
    }
#undef G_EPI_IDS
#undef G_KLOOP
#undef G_GLOAD
#undef G_LSTORE
#undef G_COMPUTE
#undef G_PART
#undef G_COMPUTE_ST
#undef G_LDX
#undef G_LDW
#undef G_MFMA4
#undef G_MFMA4S
#undef G_STEP
    __builtin_amdgcn_sched_barrier(0);
  }
}

struct EpiEvenIn {
  static constexpr bool kFull = false, kSwap = false;
  DI bool swap_tile(int nt_) const { const int seg = nt_ >> 1; return seg == 2 || seg == 6; }
  char* r1; const float* lb;
#define aq  ((bf16_t*)(r1))
#define alf ((float*)(r1 + 32 * MiB))
#define aiT ((bf16_t*)(r1 + 96 * MiB))
#define ag  ((bf16_t*)(r1 + 128 * MiB))
#define bq  ((bf16_t*)(r1 + 160 * MiB))
#define bk  ((bf16_t*)(r1 + 192 * MiB))
#define bvT ((bf16_t*)(r1 + 224 * MiB))
  DI void operator()(int tok0, int feat0, f32x16 (&acc)[2][2], int r, int hh) const {
    const int seg = feat0 >> 9, c0 = feat0 & 511;
#pragma unroll
    for (int mt = 0; mt < 2; ++mt) {
      const int tok = tok0 + mt * 32 + r, b = tok >> 14, s = tok & (SEQ - 1);
#pragma unroll
      for (int nt = 0; nt < 2; ++nt)
#pragma unroll
        for (int g = 0; g < 4; ++g) {
          const int c = c0 + nt * 32 + 8 * g + 4 * hh;
          const float v0 = acc[nt][mt][4 * g], v1 = acc[nt][mt][4 * g + 1], v2 = acc[nt][mt][4 * g + 2], v3 = acc[nt][mt][4 * g + 3];
          if (seg == 0) { u32x2 o = {pk2(siluf_(v0), siluf_(v1)), pk2(siluf_(v2), siluf_(v3))}; *(u32x2*)(aq + (size_t)tok * 512 + c) = o; }
          else if (seg == 1) {
            f32x4 lbv = *(const f32x4*)(lb + c);
            f32x4 o;
            o[0] = __logf(lbv[0] + (1.f - lbv[0]) * sigmoidf_(v0)); o[1] = __logf(lbv[1] + (1.f - lbv[1]) * sigmoidf_(v1));
            o[2] = __logf(lbv[2] + (1.f - lbv[2]) * sigmoidf_(v2)); o[3] = __logf(lbv[3] + (1.f - lbv[3]) * sigmoidf_(v3));
            *(f32x4*)(alf + (size_t)tok * 512 + c) = o;
          }
          else if (seg == 3) { u32x2 o = {pk2(siluf_(v0), siluf_(v1)), pk2(siluf_(v2), siluf_(v3))}; *(u32x2*)(ag + (size_t)tok * 512 + c) = o; }
          else if (seg == 4) { const float sc = 0.125f * LOG2E; u32x2 o = {pk2(v0 * sc, v1 * sc), pk2(v2 * sc, v3 * sc)}; *(u32x2*)(bq + (size_t)tok * 512 + c) = o; }
          else if (seg == 5) { u32x2 o = {pk2(v0, v1), pk2(v2, v3)}; *(u32x2*)(bk + (size_t)tok * 512 + c) = o; }
          else if (seg == 2) {
            bf16_t* dst = aiT + ((size_t)((b * 4 + (c >> 7)) * 128 + (c & 127))) * SEQ + s;
            dst[0] = f2bf(v0); dst[SEQ] = f2bf(v1); dst[2 * SEQ] = f2bf(v2); dst[3 * SEQ] = f2bf(v3);
          }
          else if (seg == 6) {
            bf16_t* dst = bvT + ((size_t)((b * 4 + (c >> 7)) * 128 + (c & 127))) * SEQ + swz32(s);
            dst[0] = f2bf(v0); dst[SEQ] = f2bf(v1); dst[2 * SEQ] = f2bf(v2); dst[3 * SEQ] = f2bf(v3);
          }
          __builtin_amdgcn_sched_barrier(0);
        }
    }
  }
  DI void swapped(int tok0, int feat0, f32x16 (&acc)[2][2], int r, int hh) const {
    const int seg = feat0 >> 9, c0 = feat0 & 511;
#pragma unroll
    for (int nt = 0; nt < 2; ++nt) {
      const int c = c0 + nt * 32 + r;
#pragma unroll
      for (int mt = 0; mt < 2; ++mt)
#pragma unroll
        for (int g = 0; g < 4; ++g) {
          const int tok = tok0 + mt * 32 + 8 * g + 4 * hh, b = tok >> 14, s = tok & (SEQ - 1);
          u32x2 o = {pk2(acc[nt][mt][4 * g], acc[nt][mt][4 * g + 1]), pk2(acc[nt][mt][4 * g + 2], acc[nt][mt][4 * g + 3])};
          bf16_t* base = (seg == 2 ? aiT : bvT) + ((size_t)((b * 4 + (c >> 7)) * 128 + (c & 127))) * SEQ;
          *(u32x2*)(base + (seg == 2 ? s : swz32(s))) = o;
        }
    }
  }
};

#undef aq
#undef alf
#undef aiT
#undef ag
#undef bq
#undef bk
#undef bvT
struct EpiOddIn {
  static constexpr bool kFull = false, kSwap = false;
  DI bool swap_tile(int nt_) const { return (nt_ >> 2) == 2; }
  char* r1; float* lf; const float *qg, *kg, *bf;
#define fq  ((bf16_t*)(r1))
#define fk  ((bf16_t*)(r1 + 64 * MiB))
#define fvT ((bf16_t*)(r1 + 128 * MiB))
#define fg  ((bf16_t*)(r1 + 192 * MiB))
  DI void operator()(int tok0, int feat0, f32x16 (&acc)[2][2], int r, int hh) const {
    const int seg = feat0 >> 10, c0 = feat0 & 1023;
#pragma unroll
    for (int mt = 0; mt < 2; ++mt) {
      const int tok = tok0 + mt * 32 + r, b = tok >> 14, s = tok & (SEQ - 1);
      if (seg < 2) {
        float ssq = 0.f;
#pragma unroll
        for (int nt = 0; nt < 2; ++nt)
#pragma unroll
          for (int i = 0; i < 16; ++i) ssq += acc[nt][mt][i] * acc[nt][mt][i];
        ssq += xor32(ssq);
        float rs = rsqrtf(ssq * (1.f / 64.f) + 1e-6f);
        if (seg == 0) rs *= 0.125f * LOG2E;
        const float* gg = seg == 0 ? qg : kg;
        bf16_t* dstb = (seg == 0 ? fq : fk) + (size_t)tok * 1024 + c0;
#pragma unroll
        for (int nt = 0; nt < 2; ++nt)
#pragma unroll
          for (int g = 0; g < 4; ++g) {
            const int d = nt * 32 + 8 * g + 4 * hh;
            f32x4 gv = *(const f32x4*)(gg + d);
            u32x2 o = {pk2(acc[nt][mt][4 * g] * rs * gv[0], acc[nt][mt][4 * g + 1] * rs * gv[1]), pk2(acc[nt][mt][4 * g + 2] * rs * gv[2], acc[nt][mt][4 * g + 3] * rs * gv[3])};
            *(u32x2*)(dstb + d) = o;
            __builtin_amdgcn_sched_barrier(0);
          }
      } else if (seg == 2) {
        const int head = c0 >> 6;
#pragma unroll
        for (int nt = 0; nt < 2; ++nt)
#pragma unroll
          for (int g = 0; g < 4; ++g) {
            const int d = nt * 32 + 8 * g + 4 * hh;
            bf16_t* dst = fvT + ((size_t)((b * 16 + head) * 64 + d)) * SEQ + swz32(s);
            dst[0] = f2bf(acc[nt][mt][4 * g]); dst[SEQ] = f2bf(acc[nt][mt][4 * g + 1]); dst[2 * SEQ] = f2bf(acc[nt][mt][4 * g + 2]); dst[3 * SEQ] = f2bf(acc[nt][mt][4 * g + 3]);
          }
      } else if (seg == 3) {
#pragma unroll
        for (int nt = 0; nt < 2; ++nt)
#pragma unroll
          for (int g = 0; g < 4; ++g) {
            const int c = c0 + nt * 32 + 8 * g + 4 * hh;
            u32x2 o = {pk2(sigmoidf_(acc[nt][mt][4 * g]), sigmoidf_(acc[nt][mt][4 * g + 1])), pk2(sigmoidf_(acc[nt][mt][4 * g + 2]), sigmoidf_(acc[nt][mt][4 * g + 3]))};
            *(u32x2*)(fg + (size_t)tok * 1024 + c) = o;
            __builtin_amdgcn_sched_barrier(0);
          }
      } else if (feat0 == 4096) {
#pragma unroll
        for (int g = 0; g < 2; ++g)
#pragma unroll
          for (int j = 0; j < 4; ++j) {
            const int hd = 8 * g + 4 * hh + j;
            const float xv = acc[0][mt][4 * g + j] + bf[hd];
            const float ls = fminf(xv, 0.f) - log1pf(expf(-fabsf(xv)));
            lf[((size_t)(b * 16 + hd)) * SEQ + s] = ls;
          }
      }
    }
  }
  DI void swapped(int tok0, int feat0, f32x16 (&acc)[2][2], int r, int hh) const {
    const int head = (feat0 & 1023) >> 6;
#pragma unroll
    for (int nt = 0; nt < 2; ++nt) {
      const int d = nt * 32 + r;
#pragma unroll
      for (int mt = 0; mt < 2; ++mt)
#pragma unroll
        for (int g = 0; g < 4; ++g) {
          const int tok = tok0 + mt * 32 + 8 * g + 4 * hh, b = tok >> 14, s = tok & (SEQ - 1);
          u32x2 o = {pk2(acc[nt][mt][4 * g], acc[nt][mt][4 * g + 1]), pk2(acc[nt][mt][4 * g + 2], acc[nt][mt][4 * g + 3])};
          *(u32x2*)(fvT + ((size_t)((b * 16 + head) * 64 + d)) * SEQ + swz32(s)) = o;
        }
    }
  }
};

#undef fq
#undef fk
#undef fvT
#undef fg
struct EpiRes {
  static constexpr bool kFull = false;
  const float* xin; float* y;
  DI void operator()(int tok0, int feat0, f32x16 (&acc)[2][2], int r, int hh) const {
#pragma unroll
    for (int mt = 0; mt < 2; ++mt) {
      const size_t rowo = (size_t)(tok0 + mt * 32 + r) * 1024;
#pragma unroll
      for (int nt = 0; nt < 2; ++nt)
#pragma unroll
        for (int g = 0; g < 4; ++g) {
          const int c = feat0 + nt * 32 + 8 * g + 4 * hh;
          f32x4 xv = *(const f32x4*)(xin + rowo + c);
          f32x4 o = {ALPHA * xv[0] + acc[nt][mt][4 * g], ALPHA * xv[1] + acc[nt][mt][4 * g + 1], ALPHA * xv[2] + acc[nt][mt][4 * g + 2], ALPHA * xv[3] + acc[nt][mt][4 * g + 3]};
          *(f32x4*)(y + rowo + c) = o;
          if (g & 1) __builtin_amdgcn_sched_barrier(0);
        }
    }
  }
};

struct EpiResLN {
  static constexpr bool kFull = true, kSwap = false;
  DI bool swap_tile(int) const { return false; }
  const float* xin; float* xout; bf16_t* xb; const float *g, *b; float* xchg; unsigned* cnt; unsigned target;
  DI void full(const int mt_, const int nt_, f32x16 (&acc)[2][2][2], const int tw, const int fw, const int r, const int hh, char* lds, const int tid) const {
    float* part = (float*)(lds + G_STAGE);
#pragma unroll
    for (int mt = 0; mt < 2; ++mt) {
      const size_t rowo = (size_t)(mt_ * 256 + tw * 64 + mt * 32 + r) * 1024 + nt_ * 256 + fw * 128 + 4 * hh;
      float sm = 0.f, sq = 0.f;
#pragma unroll
      for (int half = 0; half < 2; ++half)
#pragma unroll
        for (int nt = 0; nt < 2; ++nt) {
#pragma unroll
          for (int gq = 0; gq < 4; ++gq) {
            f32x4 xv = *(const f32x4*)(xin + rowo + half * 64 + nt * 32 + 8 * gq);
#pragma unroll
            for (int jj = 0; jj < 4; ++jj) { const float y = ALPHA * xv[jj] + acc[half][nt][mt][4 * gq + jj]; acc[half][nt][mt][4 * gq + jj] = y; sm += y; sq += y * y; }
          }
          __builtin_amdgcn_sched_barrier(0);
        }
      sm += xor32(sm); sq += xor32(sq);
      if (hh == 0) { float* pp = part + ((fw * 256) + tw * 64 + mt * 32 + r) * 2; pp[0] = sm; pp[1] = sq; }
    }
    __syncthreads();
    if (tid < 256) {
      f32x2 a = *(const f32x2*)(part + tid * 2), c = *(const f32x2*)(part + (256 + tid) * 2);
      const unsigned long long pk = ((unsigned long long)__float_as_uint(a[1] + c[1]) << 32) | (unsigned long long)__float_as_uint(a[0] + c[0]);
      __hip_atomic_store((GAS unsigned long long*)(xchg + ((size_t)(mt_ * 4 + nt_) * 256 + tid) * 2), pk, __ATOMIC_RELAXED, __HIP_MEMORY_SCOPE_AGENT);
    }
    asm volatile("s_waitcnt vmcnt(0)" ::: "memory");
    __syncthreads();
    if (tid == 0) {
      __hip_atomic_fetch_add((GAS unsigned*)(cnt + mt_), 1u, __ATOMIC_RELAXED, __HIP_MEMORY_SCOPE_AGENT);
      while (__hip_atomic_load((GAS unsigned*)(cnt + mt_), __ATOMIC_RELAXED, __HIP_MEMORY_SCOPE_AGENT) < target) __builtin_amdgcn_s_sleep(1);
    }
    __syncthreads();
#pragma unroll
    for (int mt = 0; mt < 2; ++mt) {
      const int tl = tw * 64 + mt * 32 + r;
      float S = 0.f, Q = 0.f;
#pragma unroll
      for (int k = 0; k < 4; ++k) {
        const unsigned long long pk = __hip_atomic_load((GAS unsigned long long*)(xchg + ((size_t)(mt_ * 4 + k) * 256 + tl) * 2), __ATOMIC_RELAXED, __HIP_MEMORY_SCOPE_AGENT);
        S += __uint_as_float((unsigned)pk);
        Q += __uint_as_float((unsigned)(pk >> 32));
      }
      const float mean = S * (1.f / 1024.f);
      const float rstd = rsqrtf(fmaxf(Q * (1.f / 1024.f) - mean * mean, 0.f) + 1e-5f);
      const int c0 = nt_ * 256 + fw * 128 + 4 * hh;
      const size_t rowo = (size_t)(mt_ * 256 + tl) * 1024 + c0;
#pragma unroll
      for (int half = 0; half < 2; ++half)
#pragma unroll
        for (int nt = 0; nt < 2; ++nt) {
#pragma unroll
          for (int gq = 0; gq < 4; ++gq) {
            const int co = half * 64 + nt * 32 + 8 * gq;
            f32x4 gv = *(const f32x4*)(g + c0 + co), bv = *(const f32x4*)(b + c0 + co), o;
#pragma unroll
            for (int jj = 0; jj < 4; ++jj) o[jj] = (acc[half][nt][mt][4 * gq + jj] - mean) * rstd * gv[jj] + bv[jj];
            *(f32x4*)(xout + rowo + co) = o;
            u32x2 ob = {pk2(o[0], o[1]), pk2(o[2], o[3])};
            *(u32x2*)(xb + rowo + co) = ob;
          }
          __builtin_amdgcn_sched_barrier(0);
        }
    }
    __syncthreads();
  }
};

struct EpiW1 {
  static constexpr bool kFull = false, kSwap = false;
  DI bool swap_tile(int) const { return false; }
  DI void swapped(int, int, f32x16 (&)[2][2], int, int) const {}
  bf16_t* act;
  DI void operator()(int tok0, int feat0, f32x16 (&acc)[2][2], int r, int hh) const {
    const int u0 = (feat0 >> 6) * 32;
#pragma unroll
    for (int mt = 0; mt < 2; ++mt) {
      bf16_t* dst = act + (size_t)(tok0 + mt * 32 + r) * DFF + u0 + 4 * hh;
#pragma unroll
      for (int g = 0; g < 4; ++g) {
        u32x2 o = {pk2(siluf_(acc[0][mt][4 * g]) * acc[1][mt][4 * g], siluf_(acc[0][mt][4 * g + 1]) * acc[1][mt][4 * g + 1]),
                   pk2(siluf_(acc[0][mt][4 * g + 2]) * acc[1][mt][4 * g + 2], siluf_(acc[0][mt][4 * g + 3]) * acc[1][mt][4 * g + 3])};
        *(u32x2*)(dst + 8 * g) = o;
      }
    }
  }
};

DI float wave_sum(float v) {
#pragma unroll
  for (int o = 32; o >= 1; o >>= 1) v += __shfl_xor(v, o, 64);
  return v;
}
DI void ln_phase(float* x, bf16_t* xb, const float* __restrict__ g, const float* __restrict__ bta) {
  const int tid = tid_l(); const int lane = tid & 63, wave = tid >> 6;
  for (int row = blockIdx.x * 8 + wave; row < NTOK; row += gridDim.x * 8) {
    float* xr = x + (size_t)row * 1024;
    f32x4 v[4];
    float s = 0.f;
#pragma unroll
    for (int i = 0; i < 4; ++i) { v[i] = *(const f32x4*)(xr + (i * 64 + lane) * 4); s += v[i][0] + v[i][1] + v[i][2] + v[i][3]; }
    const float mean = wave_sum(s) * (1.f / 1024.f);
    float q = 0.f;
#pragma unroll
    for (int i = 0; i < 4; ++i)
#pragma unroll
      for (int j = 0; j < 4; ++j) { const float d = v[i][j] - mean; q += d * d; }
    const float rstd = rsqrtf(wave_sum(q) * (1.f / 1024.f) + 1e-5f);
#pragma unroll
    for (int i = 0; i < 4; ++i) {
      const int c = (i * 64 + lane) * 4;
      f32x4 gv = *(const f32x4*)(g + c), bv = *(const f32x4*)(bta + c), o;
#pragma unroll
      for (int j = 0; j < 4; ++j) o[j] = (v[i][j] - mean) * rstd * gv[j] + bv[j];
      *(f32x4*)(xr + c) = o;
      u32x2 ob = {pk2(o[0], o[1]), pk2(o[2], o[3])};
      *(u32x2*)(xb + (size_t)row * 1024 + c) = ob;
    }
  }
}

DI void cumsum_phase(const float* __restrict__ lf, float* __restrict__ c2, char* lds) {
  float* wt = (float*)lds;
  const int tid = tid_l(), lane = tid & 63, wave = tid >> 6;
  for (int row = blockIdx.x; row < 32; row += gridDim.x) {
    const float* src = lf + (size_t)row * SEQ + tid * 32;
    float v[32];
#pragma unroll
    for (int i = 0; i < 8; ++i) { f32x4 t = *(const f32x4*)(src + 4 * i); v[4 * i] = t[0]; v[4 * i + 1] = t[1]; v[4 * i + 2] = t[2]; v[4 * i + 3] = t[3]; }
    float run = 0.f;
#pragma unroll
    for (int i = 0; i < 32; ++i) { run += v[i]; v[i] = run; }
    float inc = run;
#pragma unroll
    for (int o = 1; o < 64; o <<= 1) { const float t = __shfl_up(inc, o, 64); if (lane >= o) inc += t; }
    if (lane == 63) wt[wave] = inc;
    __syncthreads();
    float pre = inc - run;
    for (int w = 0; w < wave; ++w) pre += wt[w];
    float* dst = c2 + (size_t)row * SEQ + tid * 32;
#pragma unroll
    for (int i = 0; i < 8; ++i) { f32x4 o = {(pre + v[4 * i]) * LOG2E, (pre + v[4 * i + 1]) * LOG2E, (pre + v[4 * i + 2]) * LOG2E, (pre + v[4 * i + 3]) * LOG2E}; *(f32x4*)(dst + 4 * i) = o; }
    __syncthreads();
  }
}

template <int DVT, bool FOX>
DI void attn_step(const char* kb, const bf16x8 (&qf)[4], f32x16 (&o)[DVT], float& m, float& l, const bool diag, const int j, const int tq, const int r, const int hh) {
  constexpr int VB = DVT * 32 * LROW;
  const char* vb = kb + 64 * LROW; const char* cb = vb + VB;
  f32x16 st[2];
  bf16x8 kf[8];
#pragma unroll
  for (int ks = 0; ks < 4; ++ks)
#pragma unroll
    for (int kt = 0; kt < 2; ++kt) kf[ks * 2 + kt] = *(const bf16x8*)(kb + (kt * 32 + r) * LROW + ks * 32 + hh * 16);
  if (FOX) {
#pragma unroll
    for (int kt = 0; kt < 2; ++kt)
#pragma unroll
      for (int g = 0; g < 4; ++g) {
        f32x4 cs = *(const f32x4*)(cb + (kt * 32 + 8 * g + 4 * hh) * 4);
        st[kt][4 * g] = cs[0]; st[kt][4 * g + 1] = cs[1]; st[kt][4 * g + 2] = cs[2]; st[kt][4 * g + 3] = cs[3];
      }
  } else {
#pragma unroll
    for (int kt = 0; kt < 2; ++kt)
#pragma unroll
      for (int i = 0; i < 16; ++i) st[kt][i] = 0.f;
  }
  __builtin_amdgcn_sched_barrier(0);
#pragma unroll
  for (int ks = 0; ks < 4; ++ks)
#pragma unroll
    for (int kt = 0; kt < 2; ++kt) st[kt] = MFMA32(kf[ks * 2 + kt], qf[ks], st[kt]);
  bf16x8 va[DVT], vn[DVT];
#pragma unroll
  for (int d = 0; d < DVT; ++d) va[d] = *(const bf16x8*)(vb + (d * 32 + r) * LROW + (8 * hh) * 2);
  __builtin_amdgcn_sched_barrier(0);
  {
    const f32x2 mm = {m, m};
#pragma unroll
    for (int kt = 0; kt < 2; ++kt)
#pragma unroll
      for (int i = 0; i < 8; ++i) { f32x2 z = {st[kt][2 * i], st[kt][2 * i + 1]}; z = z - mm; st[kt][2 * i] = z[0]; st[kt][2 * i + 1] = z[1]; }
  }
  if (FOX) {
    if (diag) {
#pragma unroll
      for (int kt = 0; kt < 2; ++kt)
#pragma unroll
        for (int i = 0; i < 16; ++i) {
          const int key = j * 64 + kt * 32 + (i & 3) + 8 * (i >> 2) + 4 * hh;
          if (key > tq) st[kt][i] = -INFINITY;
        }
    }
  }
  float mx;
  {
    float a0 = fmaxf(fmaxf(st[0][0], st[0][1]), st[0][2]), a1 = fmaxf(fmaxf(st[1][0], st[1][1]), st[1][2]);
#pragma unroll
    for (int i = 3; i < 15; i += 2) { a0 = fmaxf(fmaxf(a0, st[0][i]), st[0][i + 1]); a1 = fmaxf(fmaxf(a1, st[1][i]), st[1][i + 1]); }
    mx = fmaxf(fmaxf(a0, a1), fmaxf(st[0][15], st[1][15]));
  }
  mx = fmaxf(mx, xor32(mx));
  if (__any(diag || mx > 8.f)) {
    const float d = (diag || mx > 0.f) ? mx : 0.f;
    const float alpha = diag ? 0.f : __builtin_amdgcn_exp2f(-d);
    m += d;
    l *= alpha;
#pragma unroll
    for (int dd = 0; dd < DVT; ++dd)
#pragma unroll
      for (int i = 0; i < 16; ++i) o[dd][i] *= alpha;
    const f32x2 d2 = {d, d};
#pragma unroll
    for (int kt = 0; kt < 2; ++kt)
#pragma unroll
      for (int i = 0; i < 8; ++i) { f32x2 z = {st[kt][2 * i], st[kt][2 * i + 1]}; z = z - d2; st[kt][2 * i] = z[0]; st[kt][2 * i + 1] = z[1]; }
  }
  f32x2 ls2 = {0.f, 0.f};
#pragma unroll
  for (int kt = 0; kt < 2; ++kt)
#pragma unroll
    for (int i = 0; i < 8; ++i) {
      f32x2 pv = {__builtin_amdgcn_exp2f(st[kt][2 * i]), __builtin_amdgcn_exp2f(st[kt][2 * i + 1])};
      st[kt][2 * i] = pv[0]; st[kt][2 * i + 1] = pv[1];
      ls2 = ls2 + pv;
    }
  l += ls2[0] + ls2[1];
  __builtin_amdgcn_sched_barrier(0);
#define A_PVGROUP(GK, VC, VN) { constexpr int kt_ = (GK) >> 1, s2_ = (GK) & 1; \
    if ((GK) < 3) { constexpr int kt1_ = ((GK) + 1) >> 1, s21_ = ((GK) + 1) & 1; \
      _Pragma("unroll") for (int d = 0; d < DVT; ++d) VN[d] = *(const bf16x8*)(vb + (d * 32 + r) * LROW + (kt1_ * 32 + 16 * s21_ + 8 * hh) * 2); } \
    u32x4 pw_ = {pk2(st[kt_][8 * s2_], st[kt_][8 * s2_ + 1]), pk2(st[kt_][8 * s2_ + 2], st[kt_][8 * s2_ + 3]), pk2(st[kt_][8 * s2_ + 4], st[kt_][8 * s2_ + 5]), pk2(st[kt_][8 * s2_ + 6], st[kt_][8 * s2_ + 7])}; \
    const bf16x8 pf_ = __builtin_bit_cast(bf16x8, pw_); \
    __builtin_amdgcn_sched_barrier(0); \
    _Pragma("unroll") for (int d = 0; d < DVT; ++d) o[d] = MFMA32(VC[d], pf_, o[d]); \
    __builtin_amdgcn_sched_barrier(0); }
  A_PVGROUP(0, va, vn); A_PVGROUP(1, vn, va); A_PVGROUP(2, va, vn); A_PVGROUP(3, vn, va);
#undef A_PVGROUP
}

template <int DVT, bool FOX>
DI void attn_pass(const bf16_t* __restrict__ qrow, const bf16_t* __restrict__ kbase, const int ldk, const bf16_t* __restrict__ vtbase,
                  const float* __restrict__ cbase, const int j_hi, const int my_last, const int j_lo_diag, const int tq, const float prune_c,
                  f32x16 (&o)[DVT], float& l_out, char* lds) {
  constexpr int VB = DVT * 32 * LROW;
  constexpr int STAGE = 64 * LROW + VB + 256;
  const int tid = tid_l(), lane = tid & 63;
  const int r = lane & 31, hh = lane >> 5;
  const int lrow = tid >> 3, lch = tid & 7;
  bf16x8 qf[4];
#pragma unroll
  for (int ks = 0; ks < 4; ++ks) qf[ks] = *(const bf16x8*)(qrow + ks * 16 + hh * 8);
#pragma unroll
  for (int d = 0; d < DVT; ++d)
#pragma unroll
    for (int i = 0; i < 16; ++i) o[d][i] = 0.f;
  float m = 0.f, l = 0.f;
  u32x4 kr0, kr1, vr0[DVT / 2], vr1[DVT / 2]; f32x4 cr0 = {0.f, 0.f, 0.f, 0.f}, cr1 = {0.f, 0.f, 0.f, 0.f};
  const bf16_t* kp = kbase + (size_t)lrow * ldk + lch * 8;
  const bf16_t* vp = vtbase + (size_t)lrow * SEQ + lch * 8;
#define A_GLOAD(KR, VR, CR, JT) { const int s1_ = (JT) * 64; KR = *(const u32x4*)(kp + (size_t)s1_ * ldk); \
    _Pragma("unroll") for (int i_ = 0; i_ < DVT / 2; ++i_) VR[i_] = *(const u32x4*)(vp + (size_t)(64 * i_) * SEQ + s1_); \
    if (FOX) { if (tid < 16) { f32x4 t_ = *(const f32x4*)(cbase + s1_ + tid * 4); CR[0] = -t_[0]; CR[1] = -t_[1]; CR[2] = -t_[2]; CR[3] = -t_[3]; } } }
#define A_LSTORE(KR, VR, CR, STG) { char* kb_ = lds + (STG) * STAGE; char* vb_ = kb_ + 64 * LROW; char* cb_ = vb_ + VB; \
    *(u32x4*)(kb_ + lrow * LROW + lch * 16) = KR; \
    _Pragma("unroll") for (int i_ = 0; i_ < DVT / 2; ++i_) *(u32x4*)(vb_ + (lrow + 64 * i_) * LROW + lch * 16) = VR[i_]; \
    if (FOX) { if (tid < 16) *(f32x4*)(cb_ + tid * 16) = CR; } }
#define A_PRUNE(STG) (FOX && j < j_lo_diag && (prune_c + *(const float*)(lds + (STG) * STAGE + 64 * LROW + VB + 63 * 4) < -160.f))
  int j = j_hi;
  A_GLOAD(kr0, vr0, cr0, j);
  if (j >= 1) A_GLOAD(kr1, vr1, cr1, j - 1);
  A_LSTORE(kr0, vr0, cr0, 0);
  __syncthreads();
  for (;;) {
    if (A_PRUNE(0)) break;
    if (j >= 2) A_GLOAD(kr0, vr0, cr0, j - 2);
    if (j <= my_last) attn_step<DVT, FOX>(lds, qf, o, m, l, j == my_last, j, tq, r, hh);
    if (j == 0) break;
    A_LSTORE(kr1, vr1, cr1, 1);
    __syncthreads();
    --j;
    if (A_PRUNE(1)) break;
    if (j >= 2) A_GLOAD(kr1, vr1, cr1, j - 2);
    if (j <= my_last) attn_step<DVT, FOX>(lds + STAGE, qf, o, m, l, j == my_last, j, tq, r, hh);
    if (j == 0) break;
    A_LSTORE(kr0, vr0, cr0, 0);
    __syncthreads();
    --j;
  }
  __syncthreads();
#undef A_GLOAD
#undef A_LSTORE
#undef A_PRUNE
  l_out = l + xor32(l);
}

DI void fox_phase(const Params& p, const int j_odd, char* lds) {
  char* ws = (char*)launder(p.ws);
  const bf16_t* fq = (const bf16_t*)(ws + OFF_R1);
  const bf16_t* fk = (const bf16_t*)(ws + OFF_R1 + 64 * MiB);
  const bf16_t* fvT = (const bf16_t*)(ws + OFF_R1 + 128 * MiB);
  const bf16_t* fg = (const bf16_t*)(ws + OFF_R1 + 192 * MiB);
  const float* c2 = (const float*)(ws + OFF_C2);
  bf16_t* ab = (bf16_t*)(ws + OFF_AB);
  const float b2 = ((const float*)(ws + OFF_MISC))[1032 + j_odd];
  const int tid = tid_l(); const int lane = tid & 63, wave = __builtin_amdgcn_readfirstlane(tid >> 6), r = lane & 31, hh = lane >> 5;
  for (int rnd = 0; rnd < 4; ++rnd) {
    const int bh = rnd * 8 + (blockIdx.x & 7), pp = blockIdx.x >> 3, b = bh >> 4, h = bh & 15;
    for (int half = 0; half < 2; ++half) {
      const int qb = half == 0 ? 63 - pp : pp;
      const int t0 = qb * 256, tq0 = t0 + wave * 32, tq = tq0 + r;
      const int nkv = (t0 + 256) >> 6, my_last = (tq0 + 31) >> 6;
      const float prune_c = b2 + c2[(size_t)bh * SEQ + t0];
      f32x16 o[2]; float l;
      attn_pass<2, true>(fq + (size_t)(b * SEQ + tq) * 1024 + h * 64, fk + (size_t)(b * SEQ) * 1024 + h * 64, 1024,
                         fvT + (size_t)(bh * 64) * SEQ, c2 + (size_t)bh * SEQ, nkv - 1, my_last, t0 >> 6, tq, prune_c, o, l, lds);
      const float inv = 1.f / l;
      const size_t rowo = (size_t)(b * SEQ + tq) * 1024 + h * 64;
#pragma unroll
      for (int d = 0; d < 2; ++d)
#pragma unroll
        for (int g = 0; g < 4; ++g) {
          const int c = d * 32 + 8 * g + 4 * hh;
          u32x2 gv = *(const u32x2*)(fg + rowo + c);
          const float g0 = __uint_as_float(gv[0] << 16), g1 = __uint_as_float(gv[0] & 0xffff0000u), g2 = __uint_as_float(gv[1] << 16), g3 = __uint_as_float(gv[1] & 0xffff0000u);
          u32x2 ov = {pk2(o[d][4 * g] * inv * g0, o[d][4 * g + 1] * inv * g1), pk2(o[d][4 * g + 2] * inv * g2, o[d][4 * g + 3] * inv * g3)};
          *(u32x2*)(ab + rowo + c) = ov;
        }
    }
  }
}

DI void diff_phase(const Params& p, const int j_even, char* lds) {
  char* ws = (char*)launder(p.ws);
  const bf16_t* bq = (const bf16_t*)(ws + OFF_R1 + 160 * MiB);
  const bf16_t* bk = (const bf16_t*)(ws + OFF_R1 + 192 * MiB);
  const bf16_t* bvT = (const bf16_t*)(ws + OFF_R1 + 224 * MiB);
  bf16_t* ab = (bf16_t*)(ws + OFF_AB);
  const float* misc = (const float*)(ws + OFF_MISC);
  const float lam = misc[1024 + j_even];
  const float lam_init = 0.8f - 0.6f * expf(-0.3f * (float)(2 * j_even));
  const float* dg = ((const float*)p.diff_g) + j_even * 128;
  const int tid = tid_l(); const int lane = tid & 63, wave = __builtin_amdgcn_readfirstlane(tid >> 6), r = lane & 31, hh = lane >> 5;
  {
    const int bh = blockIdx.x & 7, pp = blockIdx.x >> 3, b = bh >> 2, h = bh & 3;
    for (int half = 0; half < 2; ++half) {
      const int qb = half == 0 ? 63 - pp : pp;
      const int t0 = qb * 256, tq0 = t0 + wave * 32, tq = tq0 + r;
      const int nkv = (t0 + 256) >> 6, my_last = tq0 >> 6;
      f32x16 o1[4], o2[4]; float l1, l2;
      attn_pass<4, false>(bq + (size_t)(b * SEQ + tq) * 512 + h * 128, bk + (size_t)(b * SEQ) * 512 + h * 128, 512,
                          bvT + (size_t)(bh * 128) * SEQ, nullptr, nkv - 1, my_last, 0, tq, 0.f, o1, l1, lds);
      const float i1 = 1.f / l1;
      unsigned* o1s = (unsigned*)(lds + DIFF_STASH_OFF) + tid;
#pragma unroll
      for (int d = 0; d < 4; ++d)
#pragma unroll
        for (int i = 0; i < 8; ++i) o1s[(d * 8 + i) * 512] = pk2(o1[d][2 * i] * i1, o1[d][2 * i + 1] * i1);
      attn_pass<4, false>(bq + (size_t)(b * SEQ + tq) * 512 + h * 128 + 64, bk + (size_t)(b * SEQ) * 512 + h * 128 + 64, 512,
                          bvT + (size_t)(bh * 128) * SEQ, nullptr, nkv - 1, my_last, 0, tq, 0.f, o2, l2, lds);
      const float i2 = lam / l2;
      float ssq = 0.f;
#pragma unroll
      for (int d = 0; d < 4; ++d)
#pragma unroll
        for (int i = 0; i < 8; ++i) {
          const unsigned pw = o1s[(d * 8 + i) * 512];
          const float va = __uint_as_float(pw << 16) - i2 * o2[d][2 * i], vb = __uint_as_float(pw & 0xffff0000u) - i2 * o2[d][2 * i + 1];
          o2[d][2 * i] = va; o2[d][2 * i + 1] = vb; ssq += va * va + vb * vb; }
      ssq += xor32(ssq);
      const float rs = rsqrtf(ssq * (1.f / 128.f) + 1e-6f) * (1.f - lam_init);
      const size_t rowo = (size_t)(b * SEQ + tq) * 1024 + 512 + h * 128;
#pragma unroll
      for (int d = 0; d < 4; ++d)
#pragma unroll
        for (int g = 0; g < 4; ++g) {
          const int c = d * 32 + 8 * g + 4 * hh;
          f32x4 gv = *(const f32x4*)(dg + c);
          u32x2 ov = {pk2(o2[d][4 * g] * rs * gv[0], o2[d][4 * g + 1] * rs * gv[1]), pk2(o2[d][4 * g + 2] * rs * gv[2], o2[d][4 * g + 3] * rs * gv[3])};
          *(u32x2*)(ab + rowo + c) = ov;
        }
    }
  }
}

DI void hgrn_stageA(const Params& p, char* lds) {
  char* ws = (char*)launder(p.ws);
  const float* alf = (const float*)(ws + OFF_R1 + 32 * MiB);
  const bf16_t* aiT = (const bf16_t*)(ws + OFF_R1 + 96 * MiB);
  bf16_t* UT = (bf16_t*)(ws + OFF_UT);
  float* dbuf = (float*)(ws + OFF_DB);
  float* lfT = (float*)lds;
  float* part = (float*)(lds + 32768);
  char* KT = lds + 34816;
  char* IT = KT + 18432;
  const int tid = tid_l(), lane = tid & 63, wave = tid >> 6, r = lane & 31, hh = lane >> 5;
  f32x4 lfr[4]; u32x4 itr[2];
#define HA_FETCH(TASK) { const int bh_ = (TASK) >> 8, c_ = (TASK) & 255, tok0_ = (bh_ >> 2) * SEQ + c_ * 64, h_ = bh_ & 3; \
    _Pragma("unroll") for (int i = 0; i < 4; ++i) { const int idx = tid + 512 * i, row = idx >> 5, c4 = idx & 31; \
      lfr[i] = *(const f32x4*)(alf + (size_t)(tok0_ + row) * 512 + h_ * 128 + c4 * 4); } \
    _Pragma("unroll") for (int i = 0; i < 2; ++i) { const int idx = tid + 512 * i, row = idx >> 3, ch = idx & 7; \
      itr[i] = *(const u32x4*)(aiT + (size_t)(bh_ * 128 + row) * SEQ + c_ * 64 + ch * 8); } }
  if (blockIdx.x < 2048) HA_FETCH(blockIdx.x);
  for (int task = blockIdx.x; task < 2048; task += gridDim.x) {
    const int bh = task >> 8, c = task & 255;
#pragma unroll
    for (int i = 0; i < 4; ++i) { const int idx = tid + 512 * i, row = idx >> 5, c4 = idx & 31; *(f32x4*)(lfT + row * 128 + c4 * 4) = lfr[i]; }
#pragma unroll
    for (int i = 0; i < 2; ++i) { const int idx = tid + 512 * i, row = idx >> 3, ch = idx & 7; *(u32x4*)(IT + row * LROW + ch * 16) = itr[i]; }
    if (task + (int)gridDim.x < 2048) HA_FETCH(task + (int)gridDim.x);
    (void)bh; (void)c;
    __syncthreads();
    const int k = tid & 127, seg = tid >> 7;
    float lv[16], bv[16];
    float run = 0.f;
#pragma unroll
    for (int i = 0; i < 16; ++i) { lv[i] = lfT[(seg * 16 + i) * 128 + k]; run += lv[i]; bv[i] = run; }
    part[seg * 128 + k] = run;
    __syncthreads();
    float pre = 0.f, tot = 0.f;
#pragma unroll
    for (int s2 = 0; s2 < 4; ++s2) { const float pv = part[s2 * 128 + k]; if (s2 < seg) pre += pv; tot += pv; }
    {
      float kv[16];
#pragma unroll
      for (int i = 0; i < 16; ++i) kv[i] = (1.f - __expf(lv[i])) * __expf(tot - (pre + bv[i]));
      u32x4 w0 = {pk2(kv[0], kv[1]), pk2(kv[2], kv[3]), pk2(kv[4], kv[5]), pk2(kv[6], kv[7])};
      u32x4 w1 = {pk2(kv[8], kv[9]), pk2(kv[10], kv[11]), pk2(kv[12], kv[13]), pk2(kv[14], kv[15])};
      *(u32x4*)(KT + k * LROW + seg * 32) = w0;
      *(u32x4*)(KT + k * LROW + seg * 32 + 16) = w1;
    }
    if (seg == 0) dbuf[(size_t)task * 128 + k] = __expf(tot);
    __syncthreads();
    {
      const int ktile = wave & 3, vhalf = wave >> 2;
      f32x16 acc[2];
#pragma unroll
      for (int vt = 0; vt < 2; ++vt)
#pragma unroll
        for (int i = 0; i < 16; ++i) acc[vt][i] = 0.f;
#pragma unroll
      for (int ks = 0; ks < 4; ++ks) {
        bf16x8 a = *(const bf16x8*)(KT + (ktile * 32 + r) * LROW + ks * 32 + hh * 16);
#pragma unroll
        for (int vt = 0; vt < 2; ++vt) {
          bf16x8 bb = *(const bf16x8*)(IT + (vhalf * 64 + vt * 32 + r) * LROW + ks * 32 + hh * 16);
          acc[vt] = MFMA32(a, bb, acc[vt]);
        }
      }
#pragma unroll
      for (int vt = 0; vt < 2; ++vt) {
        bf16_t* dst = UT + ((size_t)task * 128 + vhalf * 64 + vt * 32 + r) * 128 + ktile * 32 + 4 * hh;
#pragma unroll
        for (int g = 0; g < 4; ++g) { u32x2 ov = {pk2(acc[vt][4 * g], acc[vt][4 * g + 1]), pk2(acc[vt][4 * g + 2], acc[vt][4 * g + 3])}; *(u32x2*)(dst + 8 * g) = ov; }
      }
    }
    __syncthreads();
  }
}

#undef HA_FETCH
DI void hgrn_scan(const Params& p) {
  char* ws = (char*)launder(p.ws);
  bf16_t* UT = (bf16_t*)(ws + OFF_UT);
  const float* dbuf = (const float*)(ws + OFF_DB);
  const int gid = blockIdx.x * 512 + tid_l();
  if (gid >= 8 * 16384) return;
  const int bh = gid >> 14, e = gid & 16383;
  bf16_t* up = UT + (size_t)bh * 256 * 16384 + e;
  const float* dp = dbuf + (size_t)bh * 256 * 128 + (e & 127);
  float st = 0.f;
  for (int c0 = 0; c0 < 256; c0 += 32) {
    bf16_t u[32]; float dv[32];
#pragma unroll
    for (int i = 0; i < 32; ++i) { u[i] = up[(size_t)(c0 + i) * 16384]; dv[i] = dp[(size_t)(c0 + i) * 128]; }
#pragma unroll
    for (int i = 0; i < 32; ++i) {
      up[(size_t)(c0 + i) * 16384] = f2bf(st);
      st = dv[i] * st + bf2f(u[i]);
    }
  }
}

constexpr int QROW = 272;
DI void hgrn_stageC(const Params& p, const int j_even, char* lds) {
  char* ws = (char*)launder(p.ws);
  const bf16_t* aq = (const bf16_t*)(ws + OFF_R1);
  const float* alf = (const float*)(ws + OFF_R1 + 32 * MiB);
  const bf16_t* aiT = (const bf16_t*)(ws + OFF_R1 + 96 * MiB);
  const bf16_t* ag = (const bf16_t*)(ws + OFF_R1 + 128 * MiB);
  const bf16_t* UT = (const bf16_t*)(ws + OFF_UT);
  bf16_t* ab = (bf16_t*)(ws + OFF_AB);
  const float* hg = ((const float*)p.hgrn_g) + j_even * 128;
  float* lfT = (float*)lds;
  char* ST = lds;
  char* Q1 = lds + 34816;
  char* Q2 = Q1 + 64 * QROW;
  char* K2 = Q2 + 64 * QROW;
  char* IT = K2 + 64 * QROW;
  float* part = (float*)(IT + 128 * LROW);
  const int tid = tid_l(), lane = tid & 63, wave = tid >> 6, r = lane & 31, hh = lane >> 5;
  f32x4 lfr[4]; u32x4 itr[2]; bf16_t qr[16];
#define HC_FETCH(TASK) { const int bh_ = (TASK) >> 8, c_ = (TASK) & 255, tok0_ = (bh_ >> 2) * SEQ + c_ * 64, h_ = bh_ & 3; \
    _Pragma("unroll") for (int i = 0; i < 4; ++i) { const int idx = tid + 512 * i, row = idx >> 5, c4 = idx & 31; \
      lfr[i] = *(const f32x4*)(alf + (size_t)(tok0_ + row) * 512 + h_ * 128 + c4 * 4); } \
    _Pragma("unroll") for (int i = 0; i < 2; ++i) { const int idx = tid + 512 * i, row = idx >> 3, ch = idx & 7; \
      itr[i] = *(const u32x4*)(aiT + (size_t)(bh_ * 128 + row) * SEQ + c_ * 64 + ch * 8); } \
    _Pragma("unroll") for (int i = 0; i < 16; ++i) qr[i] = aq[(size_t)(tok0_ + (tid >> 7) * 16 + i) * 512 + h_ * 128 + (tid & 127)]; }
  if (blockIdx.x < 2048) HC_FETCH(blockIdx.x);
  for (int task = blockIdx.x; task < 2048; task += gridDim.x) {
    const int bh = task >> 8, c = task & 255, b = bh >> 2, h = bh & 3;
    const int tok0 = b * SEQ + c * 64;
#pragma unroll
    for (int i = 0; i < 4; ++i) { const int idx = tid + 512 * i, row = idx >> 5, c4 = idx & 31; *(f32x4*)(lfT + row * 128 + c4 * 4) = lfr[i]; }
#pragma unroll
    for (int i = 0; i < 2; ++i) { const int idx = tid + 512 * i, row = idx >> 3, ch = idx & 7; *(u32x4*)(IT + row * LROW + ch * 16) = itr[i]; }
    float qcur[16];
#pragma unroll
    for (int i = 0; i < 16; ++i) qcur[i] = bf2f(qr[i]);
    u32x4 sreg[4];
#pragma unroll
    for (int i = 0; i < 4; ++i) sreg[i] = *(const u32x4*)(UT + (size_t)task * 16384 + (size_t)(tid + 512 * i) * 8);
    if (task + (int)gridDim.x < 2048) HC_FETCH(task + (int)gridDim.x);
    __syncthreads();
    const int k = tid & 127, seg = tid >> 7;
    float lv[16], bv[16];
    float run = 0.f;
#pragma unroll
    for (int i = 0; i < 16; ++i) { lv[i] = lfT[(seg * 16 + i) * 128 + k]; run += lv[i]; bv[i] = run; }
    part[seg * 128 + k] = run;
    __syncthreads();
    {
      const float p0 = part[k], p1 = part[128 + k], p2 = part[256 + k];
      const float pre = (seg > 0 ? p0 : 0.f) + (seg > 1 ? p1 : 0.f) + (seg > 2 ? p2 : 0.f);
      const float bmid = p0 + p1;
#pragma unroll
      for (int i = 0; i < 16; ++i) {
        const int t = seg * 16 + i;
        const float bt = pre + bv[i];
        const float qv = qcur[i];
        const float kk = 1.f - __expf(lv[i]);
        *(bf16_t*)(Q1 + t * QROW + k * 2) = f2bf(qv * __expf(bt));
        *(bf16_t*)(Q2 + t * QROW + k * 2) = f2bf(qv * __expf(fminf(bt - bmid, 80.f)));
        *(bf16_t*)(K2 + t * QROW + k * 2) = f2bf(kk * __expf(fminf(bmid - bt, 80.f)));
      }
    }
#pragma unroll
    for (int i = 0; i < 4; ++i) { const int idx = tid + 512 * i, row = idx >> 4, ch = idx & 15; *(u32x4*)(ST + row * QROW + ch * 16) = sreg[i]; }
    __syncthreads();
    {
      const int vt = wave & 3, tt = wave >> 2;
      const int t = tt * 32 + r;
      f32x16 sc[2];
#pragma unroll
      for (int st = 0; st < 2; ++st)
#pragma unroll
        for (int i = 0; i < 16; ++i) sc[st][i] = 0.f;
#pragma unroll
      for (int ks = 0; ks < 8; ++ks) {
        bf16x8 qb = *(const bf16x8*)(Q2 + t * QROW + ks * 32 + hh * 16);
#pragma unroll
        for (int st = 0; st < 2; ++st) {
          if (st <= tt) {
            bf16x8 a = *(const bf16x8*)(K2 + (st * 32 + r) * QROW + ks * 32 + hh * 16);
            sc[st] = MFMA32(a, qb, sc[st]);
          }
        }
      }
      f32x16 acc;
#pragma unroll
      for (int i = 0; i < 16; ++i) acc[i] = 0.f;
#pragma unroll
      for (int st = 0; st < 2; ++st) {
        if (st <= tt) {
#pragma unroll
          for (int i = 0; i < 16; ++i) { const int s = st * 32 + (i & 3) + 8 * (i >> 2) + 4 * hh; if (s > t) sc[st][i] = 0.f; }
#pragma unroll
          for (int s2 = 0; s2 < 2; ++s2) {
            u32x4 pw = {pk2(sc[st][8 * s2], sc[st][8 * s2 + 1]), pk2(sc[st][8 * s2 + 2], sc[st][8 * s2 + 3]), pk2(sc[st][8 * s2 + 4], sc[st][8 * s2 + 5]), pk2(sc[st][8 * s2 + 6], sc[st][8 * s2 + 7])};
            const bf16x8 pf = __builtin_bit_cast(bf16x8, pw);
            const char* ip = IT + (vt * 32 + r) * LROW + (st * 32 + 16 * s2 + 4 * hh) * 2;
            u32x2 lo = *(const u32x2*)ip, hi = *(const u32x2*)(ip + 16);
            u32x4 aw = {lo[0], lo[1], hi[0], hi[1]};
            acc = MFMA32(__builtin_bit_cast(bf16x8, aw), pf, acc);
          }
        }
      }
#pragma unroll
      for (int ks = 0; ks < 8; ++ks) {
        bf16x8 a = *(const bf16x8*)(ST + (vt * 32 + r) * QROW + ks * 32 + hh * 16);
        bf16x8 qb = *(const bf16x8*)(Q1 + t * QROW + ks * 32 + hh * 16);
        acc = MFMA32(a, qb, acc);
      }
      float ssq = 0.f;
#pragma unroll
      for (int i = 0; i < 16; ++i) ssq += acc[i] * acc[i];
      ssq += xor32(ssq);
      if (hh == 0) part[vt * 64 + t] = ssq;
      __syncthreads();
      const float tot = part[t] + part[64 + t] + part[128 + t] + part[192 + t];
      const float rs = rsqrtf(tot * (1.f / 128.f) + 1e-6f);
      const size_t go = (size_t)(tok0 + t) * 512 + h * 128 + vt * 32 + 4 * hh;
      const size_t oo = (size_t)(tok0 + t) * 1024 + h * 128 + vt * 32 + 4 * hh;
#pragma unroll
      for (int g = 0; g < 4; ++g) {
        f32x4 gn = *(const f32x4*)(hg + vt * 32 + 4 * hh + 8 * g);
        u32x2 gv = *(const u32x2*)(ag + go + 8 * g);
        const float g0 = __uint_as_float(gv[0] << 16), g1 = __uint_as_float(gv[0] & 0xffff0000u), g2 = __uint_as_float(gv[1] << 16), g3 = __uint_as_float(gv[1] & 0xffff0000u);
        u32x2 ov = {pk2(acc[4 * g] * rs * gn[0] * g0, acc[4 * g + 1] * rs * gn[1] * g1), pk2(acc[4 * g + 2] * rs * gn[2] * g2, acc[4 * g + 3] * rs * gn[3] * g3)};
        *(u32x2*)(ab + oo + 8 * g) = ov;
      }
    }
    __syncthreads();
  }
}

#undef HC_FETCH
DI void grid_barrier(unsigned* ctr, const unsigned target) {
  asm volatile("s_waitcnt vmcnt(0)" ::: "memory");
  __syncthreads();
  if (threadIdx.x == 0) {
    __builtin_amdgcn_fence(__ATOMIC_RELEASE, "agent");
    asm volatile("s_waitcnt vmcnt(0)" ::: "memory");
    __hip_atomic_fetch_add((GAS unsigned*)ctr, 1u, __ATOMIC_RELAXED, __HIP_MEMORY_SCOPE_AGENT);
    while (__hip_atomic_load((GAS unsigned*)ctr, __ATOMIC_RELAXED, __HIP_MEMORY_SCOPE_AGENT) < target) __builtin_amdgcn_s_sleep(1);
    __builtin_amdgcn_fence(__ATOMIC_ACQUIRE, "agent");
    asm volatile("s_waitcnt vmcnt(0)" ::: "memory");
  }
  __syncthreads();
}
typedef const __attribute__((address_space(4))) Params* kparams_t;
#if defined(__HIP_DEVICE_COMPILE__)
DI kparams_t launder_k(kparams_t q) { asm volatile("" : "+s"(q)); return q; }
#endif
#if defined(__HIP_DEVICE_COMPILE__)
#define KPARAMS (*launder_k((kparams_t)__builtin_amdgcn_kernarg_segment_ptr()))
#else
#define KPARAMS p_arg
#endif
__global__ void __launch_bounds__(512) fwd_mega(Params p_arg) {
  extern __shared__ __attribute__((aligned(16))) char lds[];
  int ph = 0;
  const int p_lo = p_arg.lo, p_hi = p_arg.hi;
#define PHASE(id, ...) { if (ph >= p_lo && ph < p_hi) { const Params p = KPARAMS; char* ws = (char*)launder(p.ws); float* outp = (float*)launder((GAS char*)p.out); bf16_t* ab = (bf16_t*)(ws + OFF_AB); (void)outp; (void)ab; \
    if (ONLY < 0 || ONLY == id) { __VA_ARGS__; } if ((DUPMASK >> id) & 1) { __syncthreads(); __VA_ARGS__; } if (ph + 1 < p_hi) { if (ph == p_lo) cg::this_grid().sync(); else grid_barrier((unsigned*)(ws + OFF_CNT) + 256, (unsigned)(ph - p_lo) * gridDim.x); } } ++ph; }
  PHASE(0, phase0(p, lds));
  for (int l = 0; l < 4; ++l) {
    const int j = l >> 1;
    if ((l & 1) == 0) {
      PHASE(1,
        EpiEvenIn e;
        e.r1 = ws + OFF_R1; e.lb = (const float*)(ws + OFF_MISC) + j * 512;
        gemm_phase(ab, 1024, (const bf16_t*)(ws + OFF_WEI) + (size_t)j * EVEN_IN * D, EVEN_IN, D, e, lds));
      PHASE(2, hgrn_stageA(p, lds));
      PHASE(3, hgrn_scan(p));
      PHASE(4, hgrn_stageC(p, j, lds); diff_phase(p, j, lds));
      PHASE(6,
        EpiResLN er; er.xin = (l == 0) ? (const float*)launder((GAS char*)p.x_in) : outp; er.xout = outp; er.xb = ab;
        er.g = ((const float*)p.ln1g) + l * D; er.b = ((const float*)p.ln1b) + l * D;
        er.xchg = (float*)(ws + OFF_XCHG); er.cnt = (unsigned*)(ws + OFF_CNT); er.target = 4u * (unsigned)(2 * l + 1);
        gemm_phase(ab, 1024, (const bf16_t*)(ws + OFF_WEO) + (size_t)j * D * D, D, D, er, lds));
    } else {
      PHASE(7,
        EpiOddIn e;
        e.r1 = ws + OFF_R1;
        e.lf = (float*)(ws + OFF_LF); e.qg = ((const float*)p.fox_qg) + j * 64; e.kg = ((const float*)p.fox_kg) + j * 64; e.bf = ((const float*)p.fox_bf) + j * 16;
        gemm_phase(ab, 1024, (const bf16_t*)(ws + OFF_WFI) + (size_t)j * ODD_PAD * D, ODD_PAD, D, e, lds));
      PHASE(8, cumsum_phase((const float*)(ws + OFF_LF), (float*)(ws + OFF_C2), lds));
      PHASE(9, fox_phase(p, j, lds));
      PHASE(6,
        EpiResLN er; er.xin = outp; er.xout = outp; er.xb = ab;
        er.g = ((const float*)p.ln1g) + l * D; er.b = ((const float*)p.ln1b) + l * D;
        er.xchg = (float*)(ws + OFF_XCHG); er.cnt = (unsigned*)(ws + OFF_CNT); er.target = 4u * (unsigned)(2 * l + 1);
        gemm_phase(ab, 1024, (const bf16_t*)(ws + OFF_WFO) + (size_t)j * D * D, D, D, er, lds));
    }
    PHASE(11,
      EpiW1 e1; e1.act = (bf16_t*)(ws + OFF_R1);
      gemm_phase(ab, 1024, (const bf16_t*)(ws + OFF_W1) + (size_t)l * 2 * DFF * D, 2 * DFF, D, e1, lds));
    PHASE(6,
      EpiResLN e2; e2.xin = outp; e2.xout = outp; e2.xb = ab;
      e2.g = ((const float*)p.ln2g) + l * D; e2.b = ((const float*)p.ln2b) + l * D;
      e2.xchg = (float*)(ws + OFF_XCHG); e2.cnt = (unsigned*)(ws + OFF_CNT); e2.target = 4u * (unsigned)(2 * l + 2);
      gemm_phase((const bf16_t*)(ws + OFF_R1), DFF, (const bf16_t*)(ws + OFF_W2) + (size_t)l * D * DFF, D, DFF, e2, lds));
  }
#undef PHASE
}
constexpr int N_PHASES = 1 + 2 * 7 + 2 * 6;

extern "C" void kernel_launch(void* const* d_in, const int* in_sizes, int n_in, void* d_out, int out_size, void* d_ws, size_t ws_size, hipStream_t stream) {
  static bool attr = false;
  if (!attr) { hipFuncSetAttribute((const void*)fwd_mega, hipFuncAttributeMaxDynamicSharedMemorySize, LDS_BYTES); attr = true; }
  Params p{};
  p.x_in = (const GAS float*)d_in[0];
  p.even_w_in = (const GAS float*)d_in[1]; p.even_w_out = (const GAS float*)d_in[2]; p.lb_logits = (const GAS float*)d_in[3];
  p.lq1 = (const GAS float*)d_in[4]; p.lk1 = (const GAS float*)d_in[5]; p.lq2 = (const GAS float*)d_in[6]; p.lk2 = (const GAS float*)d_in[7];
  p.hgrn_g = (const GAS float*)d_in[8]; p.diff_g = (const GAS float*)d_in[9];
  p.fox_w_in = (const GAS float*)d_in[10]; p.fox_w_out = (const GAS float*)d_in[11]; p.fox_bf = (const GAS float*)d_in[12];
  p.fox_qg = (const GAS float*)d_in[13]; p.fox_kg = (const GAS float*)d_in[14];
  p.w1 = (const GAS float*)d_in[15]; p.w2 = (const GAS float*)d_in[16];
  p.ln1g = (const GAS float*)d_in[17]; p.ln1b = (const GAS float*)d_in[18]; p.ln2g = (const GAS float*)d_in[19]; p.ln2b = (const GAS float*)d_in[20];
  p.out = (GAS float*)d_out; p.ws = (GAS char*)d_ws;
#if COOP
  p.lo = 0; p.hi = N_PHASES;
  void* args[] = {&p};
  hipError_t e = hipLaunchCooperativeKernel((const void*)fwd_mega, dim3(256), dim3(512), args, LDS_BYTES, stream);
  if (e != hipSuccess) fprintf(stderr, "cooperative launch failed: %s\n", hipGetErrorString(e));
#else
  for (int ph = 0; ph < N_PHASES; ++ph) {
    p.lo = ph; p.hi = ph + 1;
    hipLaunchKernelGGL(fwd_mega, dim3(256), dim3(512), LDS_BYTES, stream, p);
  }
#endif
}
```

```cpp
#include <hip/hip_runtime.h>
#include <hip/hip_cooperative_groups.h>
#include <cstdio>
#include <cstdint>
namespace cg = cooperative_groups;

#ifndef COOP
#define COOP 1
#endif
#ifndef ONLY
#define ONLY -1
#endif
#ifndef DUPMASK
#define DUPMASK 0
#endif

typedef unsigned short bf16_t;
typedef short bf16x8 __attribute__((ext_vector_type(8)));
typedef float f32x16 __attribute__((ext_vector_type(16)));
typedef float f32x4 __attribute__((ext_vector_type(4)));
typedef float f32x2 __attribute__((ext_vector_type(2)));
typedef unsigned u32x4 __attribute__((ext_vector_type(4)));
typedef unsigned u32x2 __attribute__((ext_vector_type(2)));
typedef __bf16 bf16x2v __attribute__((ext_vector_type(2)));

#define DI __device__ __forceinline__
#define MFMA32(a, b, c) __builtin_amdgcn_mfma_f32_32x32x16_bf16((a), (b), (c), 0, 0, 0)

constexpr int D = 1024, SEQ = 16384, NTOK = 32768, DFF = 2816;
constexpr int EVEN_IN = 3584, ODD_IN = 4112, ODD_PAD = 4352;
constexpr float ALPHA = 1.6817928305074290f;
constexpr float LOG2E = 1.4426950408889634f;
constexpr size_t MiB = 1u << 20;

constexpr size_t OFF_WEI = 0;
constexpr size_t OFF_WEO = OFF_WEI + (size_t)2 * EVEN_IN * D * 2;
constexpr size_t OFF_WFI = OFF_WEO + (size_t)2 * D * D * 2;
constexpr size_t OFF_WFO = OFF_WFI + (size_t)2 * ODD_PAD * D * 2;
constexpr size_t OFF_W1  = OFF_WFO + (size_t)2 * D * D * 2;
constexpr size_t OFF_W2  = OFF_W1 + (size_t)4 * 2 * DFF * D * 2;
constexpr size_t W_END   = OFF_W2 + (size_t)4 * D * DFF * 2;
static_assert(W_END <= 105 * MiB, "weights region");
constexpr size_t OFF_R1 = 105 * MiB;
constexpr size_t OFF_AB = 361 * MiB;
constexpr size_t OFF_UT = 425 * MiB;
constexpr size_t OFF_DB = 489 * MiB;
constexpr size_t OFF_LF = 490 * MiB;
constexpr size_t OFF_C2 = 492 * MiB;
constexpr size_t OFF_MISC = 494 * MiB;
constexpr size_t OFF_CNT = OFF_MISC + 80 * 1024;
constexpr size_t OFF_XCHG = OFF_MISC + 128 * 1024;

#define GAS __attribute__((address_space(1)))
struct Params {
  const GAS float* x_in;
  const GAS float *even_w_in, *even_w_out, *lb_logits, *lq1, *lk1, *lq2, *lk2, *hgrn_g, *diff_g;
  const GAS float *fox_w_in, *fox_w_out, *fox_bf, *fox_qg, *fox_kg;
  const GAS float *w1, *w2, *ln1g, *ln1b, *ln2g, *ln2b;
  GAS float* out;
  GAS char* ws;
  int lo, hi;
};

DI unsigned pk2(float lo, float hi) { f32x2 v = {lo, hi}; bf16x2v b = __builtin_convertvector(v, bf16x2v); return __builtin_bit_cast(unsigned, b); }
DI bf16_t f2bf(float x) { return (bf16_t)(pk2(x, 0.f) & 0xffffu); }
DI float bf2f(bf16_t v) { return __uint_as_float(((unsigned)v) << 16); }
DI float sigmoidf_(float x) { return __builtin_amdgcn_rcpf(1.f + __builtin_amdgcn_exp2f(-LOG2E * x)); }
DI float siluf_(float x) { return x * __builtin_amdgcn_rcpf(1.f + __builtin_amdgcn_exp2f(-LOG2E * x)); }
DI GAS char* launder(GAS char* q) { asm volatile("" : "+s"(q)); return q; }
DI int tid_l() { int t = threadIdx.x; asm volatile("" : "+v"(t)); return t; }
DI int swz32(int s) { return (s & ~12) | ((s & 4) << 1) | ((s & 8) >> 1); }
DI float xor32(float v) { return __shfl_xor(v, 32, 64); }

DI void convert_w(const float* __restrict__ w, bf16_t* __restrict__ wt, int K, int N, int Npad, int mode, float* tl) {
  const int tid = tid_l();
  const int nkt = K >> 6, nnt = Npad >> 6;
  for (int tile = blockIdx.x; tile < nkt * nnt; tile += gridDim.x) {
    const int k0 = (tile / nnt) << 6, n0 = (tile % nnt) << 6;
#pragma unroll
    for (int i = 0; i < 2; ++i) {
      const int kk = (tid >> 4) + 32 * i, n4 = (tid & 15) << 2;
      const int np = n0 + n4;
      int src = np;
      if (mode == 1) { const int grp = np >> 6, j = np & 63; src = (j < 32) ? grp * 32 + j : DFF + grp * 32 + (j - 32); }
      f32x4 v = {0.f, 0.f, 0.f, 0.f};
      if (src < N) v = *(const f32x4*)(w + (size_t)(k0 + kk) * N + src);
      tl[kk * 65 + n4 + 0] = v[0]; tl[kk * 65 + n4 + 1] = v[1]; tl[kk * 65 + n4 + 2] = v[2]; tl[kk * 65 + n4 + 3] = v[3];
    }
    __syncthreads();
    {
      const int n = tid >> 3, kc = (tid & 7) << 3;
      float f[8];
#pragma unroll
      for (int j = 0; j < 8; ++j) f[j] = tl[(kc + j) * 65 + n];
      u32x4 o = {pk2(f[0], f[1]), pk2(f[2], f[3]), pk2(f[4], f[5]), pk2(f[6], f[7])};
      *(u32x4*)(wt + (size_t)(n0 + n) * K + k0 + kc) = o;
    }
    __syncthreads();
  }
}

DI void phase0(const Params& p, char* lds) {
  float* tl = (float*)lds;
  char* ws = (char*)launder(p.ws);
  for (int j = 0; j < 2; ++j) {
    convert_w(((const float*)p.even_w_in) + (size_t)j * D * EVEN_IN, (bf16_t*)(ws + OFF_WEI) + (size_t)j * EVEN_IN * D, D, EVEN_IN, EVEN_IN, 0, tl);
    convert_w(((const float*)p.even_w_out) + (size_t)j * D * D, (bf16_t*)(ws + OFF_WEO) + (size_t)j * D * D, D, D, D, 0, tl);
    convert_w(((const float*)p.fox_w_in) + (size_t)j * D * ODD_IN, (bf16_t*)(ws + OFF_WFI) + (size_t)j * ODD_PAD * D, D, ODD_IN, ODD_PAD, 0, tl);
    convert_w(((const float*)p.fox_w_out) + (size_t)j * D * D, (bf16_t*)(ws + OFF_WFO) + (size_t)j * D * D, D, D, D, 0, tl);
  }
  for (int l = 0; l < 4; ++l) {
    convert_w(((const float*)p.w1) + (size_t)l * D * 2 * DFF, (bf16_t*)(ws + OFF_W1) + (size_t)l * 2 * DFF * D, D, 2 * DFF, 2 * DFF, 1, tl);
    convert_w(((const float*)p.w2) + (size_t)l * DFF * D, (bf16_t*)(ws + OFF_W2) + (size_t)l * D * DFF, DFF, D, D, 0, tl);
  }
  {
    bf16_t* ab = (bf16_t*)(ws + OFF_AB);
    const size_t n8 = (size_t)NTOK * D / 8;
    for (size_t i = (size_t)blockIdx.x * 512 + tid_l(); i < n8; i += (size_t)gridDim.x * 512) {
      f32x4 a = *(const f32x4*)(((const float*)p.x_in) + i * 8), b = *(const f32x4*)(((const float*)p.x_in) + i * 8 + 4);
      u32x4 o = {pk2(a[0], a[1]), pk2(a[2], a[3]), pk2(b[0], b[1]), pk2(b[2], b[3])};
      *(u32x4*)(ab + i * 8) = o;
    }
  }
  if (blockIdx.x == 0) { const int t_ = tid_l(); if (t_ < 128) ((unsigned*)(ws + OFF_CNT))[t_] = 0u; if (t_ == 128) ((unsigned*)(ws + OFF_CNT))[256] = 0u; }
  if (blockIdx.x == 0) {
    float* misc = (float*)(ws + OFF_MISC);
    const int tid = tid_l();
    {
      const float l0 = ((const float*)p.lb_logits)[tid], l1 = ((const float*)p.lb_logits)[512 + tid];
      const float mx = fmaxf(l0, l1);
      const float e0 = expf(l0 - mx), e1 = expf(l1 - mx);
      const float s0 = e0 / (e0 + e1), s1 = e1 / (e0 + e1);
      misc[tid] = s0 - s0;
      misc[512 + tid] = (s0 + s1) - s0;
    }
    if (tid < 2) {
      float d1 = 0.f, d2 = 0.f;
      for (int i = 0; i < 64; ++i) { d1 += ((const float*)p.lq1)[tid * 64 + i] * ((const float*)p.lk1)[tid * 64 + i]; d2 += ((const float*)p.lq2)[tid * 64 + i] * ((const float*)p.lk2)[tid * 64 + i]; }
      const float lam_init = 0.8f - 0.6f * expf(-0.3f * (float)(2 * tid));
      misc[1024 + tid] = expf(d1) - expf(d2) + lam_init;
      float mq = 0.f, mk = 0.f;
      for (int i = 0; i < 64; ++i) { mq = fmaxf(mq, fabsf(((const float*)p.fox_qg)[tid * 64 + i])); mk = fmaxf(mk, fabsf(((const float*)p.fox_kg)[tid * 64 + i])); }
      const float B = 0.125f * LOG2E * 64.f * mq * mk * 1.02f;
      misc[1032 + tid] = 2.f * B + 8.f;
    }
  }
}

constexpr int LROW = 144;
constexpr int G_XB = 256 * LROW, G_WB = 256 * LROW, G_STAGE = G_XB + G_WB;
constexpr int DIFF_STASH_OFF = 2 * (64 * LROW + 128 * LROW + 256);
constexpr int LDS_BYTES = 2 * G_STAGE;
static_assert(LDS_BYTES >= DIFF_STASH_OFF + 512 * 32 * 4, "lds");

template <class Epi>
DI void gemm_phase(const bf16_t* __restrict__ X, const int ldx, const bf16_t* __restrict__ Wt, const int N, const int K, const Epi& epi, char* lds) {
  const int tid = tid_l(), lane = tid & 63, wave = tid >> 6;
  const int r = lane & 31, hh = lane >> 5;
  const int tw = wave & 3, fw = wave >> 2;
  const int nNt = N >> 8;
  const int ntiles = nNt * (NTOK / 256);
  const int nk = K >> 6;
  const int lrow = tid >> 3, lch = tid & 7;
  const int xcd = blockIdx.x & 7, slot = blockIdx.x >> 3, nchunks = 4 * nNt;
  (void)ntiles;
  u32x4 xr0[4], wr0[4];
  for (int chunk = xcd; chunk < nchunks; chunk += 8) {
    const int L = chunk * 32 + slot, band = L / (4 * nNt), rem = L % (4 * nNt);
    const int mt_ = band * 4 + (rem & 3), nt_ = rem >> 2;
    const char* Xt = (const char*)(X + (size_t)(mt_ * 256) * ldx);
    const char* Wtb = (const char*)(Wt + (size_t)(nt_ * 256) * K);
    const unsigned xoff = (unsigned)(lrow * ldx + lch * 8) * 2u, woff = (unsigned)(lrow * K + lch * 8) * 2u;
    const bool has_next = !Epi::kFull && (chunk + 8 < nchunks);
    const int Ln = (has_next ? chunk + 8 : chunk) * 32 + slot, band_n = Ln / (4 * nNt), rem_n = Ln % (4 * nNt);
    const char* Xt_n = (const char*)(X + (size_t)((band_n * 4 + (rem_n & 3)) * 256) * ldx);
    const char* Wtb_n = (const char*)(Wt + (size_t)((rem_n >> 2) * 256) * K);
    f32x16 acc[2][2][2];
#define G_GLOAD(XR, WR, KT) { _Pragma("unroll") for (int i_ = 0; i_ < 4; ++i_) XR[i_] = *(const u32x4*)(Xt + ((size_t)(64 * i_) * ldx + (KT) * 64) * 2 + xoff); \
    _Pragma("unroll") for (int i_ = 0; i_ < 4; ++i_) WR[i_] = *(const u32x4*)(Wtb + ((size_t)(64 * i_) * K + (KT) * 64) * 2 + woff); }
#define G_LSTORE(XR, WR, STG) { char* xs_ = lds + (STG) * G_STAGE; char* ws_ = xs_ + G_XB; \
    _Pragma("unroll") for (int i_ = 0; i_ < 4; ++i_) *(u32x4*)(xs_ + (lrow + 64 * i_) * LROW + lch * 16) = XR[i_]; \
    _Pragma("unroll") for (int i_ = 0; i_ < 4; ++i_) *(u32x4*)(ws_ + (lrow + 64 * i_) * LROW + lch * 16) = WR[i_]; }
#define G_PART(Q, STG, KT, DOLOAD) { char* xs_ = lds + (STG) * G_STAGE; char* ws_ = xs_ + G_XB; \
    if ((Q) < 2) { _Pragma("unroll") for (int i_ = 2 * (Q); i_ < 2 * (Q) + 2; ++i_) { *(u32x4*)(xs_ + (lrow + 64 * i_) * LROW + lch * 16) = xr0[i_]; \
        if (DOLOAD) xr0[i_] = *(const u32x4*)(xb_ + ((size_t)(64 * i_) * ldx + (KT) * 64) * 2 + xoff); } } \
    else { _Pragma("unroll") for (int i_ = 2 * ((Q) - 2); i_ < 2 * ((Q) - 2) + 2; ++i_) { *(u32x4*)(ws_ + (lrow + 64 * i_) * LROW + lch * 16) = wr0[i_]; \
        if (DOLOAD) wr0[i_] = *(const u32x4*)(wb_ + ((size_t)(64 * i_) * K + (KT) * 64) * 2 + woff); } } \
    __builtin_amdgcn_sched_barrier(0); }
#define G_LDX(XF, KS) { _Pragma("unroll") for (int m = 0; m < 2; ++m) XF[m] = *(const bf16x8*)(xs + (tw * 64 + m * 32 + r) * LROW + (KS) * 32 + hh * 16); }
#define G_LDW(WF, N0, KS) { _Pragma("unroll") for (int n = 0; n < 2; ++n) WF[n] = *(const bf16x8*)(wsm + (fw * 128 + ((N0) + n) * 32 + r) * LROW + (KS) * 32 + hh * 16); }
#define G_MFMA4S(XF, WF, H) { _Pragma("unroll") for (int n = 0; n < 2; ++n) _Pragma("unroll") for (int m = 0; m < 2; ++m) acc[H][n][m] = MFMA32(XF[m], WF[n], acc[H][n][m]); }
#define G_MFMA4(XF, WF, H) { _Pragma("unroll") for (int n = 0; n < 2; ++n) _Pragma("unroll") for (int m = 0; m < 2; ++m) acc[H][n][m] = MFMA32(WF[n], XF[m], acc[H][n][m]); }
#define G_STEP(MM, KS, XC, XN) { G_LDW(wc, 2, KS); if ((KS) < 3) { G_LDX(XN, (KS) + 1); } __builtin_amdgcn_sched_barrier(0); \
    MM(XC, w01, 0); __builtin_amdgcn_sched_barrier(0); if ((KS) < 3) { G_LDW(w01, 0, (KS) + 1); } MM(XC, wc, 1); __builtin_amdgcn_sched_barrier(0); }
#define G_COMPUTE_ST(MM, STG, DOSTORE, NSTG, KTL, DOLOAD) { const char* xs = lds + (STG) * G_STAGE; const char* wsm = xs + G_XB; \
    bf16x8 xfa[2], xfb[2], w01[2], wc[2]; \
    G_LDX(xfa, 0); G_LDW(w01, 0, 0); \
    G_STEP(MM, 0, xfa, xfb); if (DOSTORE) { G_PART(0, NSTG, KTL, DOLOAD); G_PART(1, NSTG, KTL, DOLOAD); } \
    G_STEP(MM, 1, xfb, xfa); if (DOSTORE) G_PART(2, NSTG, KTL, DOLOAD); \
    G_STEP(MM, 2, xfa, xfb); if (DOSTORE) G_PART(3, NSTG, KTL, DOLOAD); \
    G_STEP(MM, 3, xfb, xfa); }
#define G_COMPUTE(MM, STG) { const char* xs = lds + (STG) * G_STAGE; const char* wsm = xs + G_XB; \
    bf16x8 xfa[2], xfb[2], w01[2], wc[2]; \
    G_LDX(xfa, 0); G_LDW(w01, 0, 0); \
    G_STEP(MM, 0, xfa, xfb); G_STEP(MM, 1, xfb, xfa); G_STEP(MM, 2, xfa, xfb); G_STEP(MM, 3, xfb, xfa); }
    asm volatile("" ::: "memory");
    if (Epi::kFull || chunk == xcd) {
      G_GLOAD(xr0, wr0, 0);
      G_LSTORE(xr0, wr0, 0);
      __syncthreads();
      G_GLOAD(xr0, wr0, 1);
    }
#pragma unroll
    for (int c = 0; c < 2; ++c)
#pragma unroll
      for (int a = 0; a < 2; ++a)
#pragma unroll
        for (int b = 0; b < 2; ++b)
#pragma unroll
          for (int i = 0; i < 16; ++i) acc[c][a][b][i] = 0.f;
#define G_KLOOP(MM) for (int kt = 0; kt < nk; kt += 2) { \
        \
        \
      { const bool in_ = (kt + 2 < nk); const char* xb_ = in_ ? Xt : Xt_n; const char* wb_ = in_ ? Wtb : Wtb_n; \
        const int k2_ = in_ ? kt + 2 : (has_next ? 0 : nk - 1); G_COMPUTE_ST(MM, 0, true, 1, k2_, true); } \
      __syncthreads(); \
      { const bool in_ = (kt + 3 < nk); const char* xb_ = in_ ? Xt : Xt_n; const char* wb_ = in_ ? Wtb : Wtb_n; \
        const int k3_ = in_ ? kt + 3 : (has_next ? 1 : nk - 1); G_COMPUTE_ST(MM, 1, true, 0, k3_, true); } \
      __syncthreads(); \
    }
    const bool sw = Epi::kSwap && epi.swap_tile(nt_);
#define G_EPI_IDS const int t2 = tid_l(); const int r2 = t2 & 31, hh2 = (t2 >> 5) & 1, tw2 = (t2 >> 6) & 3, fw2 = t2 >> 8;
    if (sw) {
      G_KLOOP(G_MFMA4S)
      if constexpr (Epi::kSwap) {
        G_EPI_IDS
        epi.swapped(mt_ * 256 + tw2 * 64, nt_ * 256 + fw2 * 128, acc[0], r2, hh2);
        __builtin_amdgcn_sched_barrier(0);
        epi.swapped(mt_ * 256 + tw2 * 64, nt_ * 256 + fw2 * 128 + 64, acc[1], r2, hh2);
      }
    } else {
      G_KLOOP(G_MFMA4)
      G_EPI_IDS
      if constexpr (Epi::kFull) {
        epi.full(mt_, nt_, acc, tw2, fw2, r2, hh2, lds, t2);
      } else {
        epi(mt_ * 256 + tw2 * 64, nt_ * 256 + fw2 * 128, acc[0], r2, hh2);
        __builtin_amdgcn_sched_barrier(0);
        epi(mt_ * 256 + tw2 * 64, nt_ * 256 + fw2 * 128 + 64, acc[1], r2, hh2);
      }
    }
#undef G_EPI_IDS
#undef G_KLOOP
#undef G_GLOAD
#undef G_LSTORE
#undef G_COMPUTE
#undef G_PART
#undef G_COMPUTE_ST
#undef G_LDX
#undef G_LDW
#undef G_MFMA4
#undef G_MFMA4S
#undef G_STEP
    __builtin_amdgcn_sched_barrier(0);
  }
}

struct EpiEvenIn {
  static constexpr bool kFull = false, kSwap = false;
  DI bool swap_tile(int nt_) const { const int seg = nt_ >> 1; return seg == 2 || seg == 6; }
  char* r1; const float* lb;
#define aq  ((bf16_t*)(r1))
#define alf ((float*)(r1 + 32 * MiB))
#define aiT ((bf16_t*)(r1 + 96 * MiB))
#define ag  ((bf16_t*)(r1 + 128 * MiB))
#define bq  ((bf16_t*)(r1 + 160 * MiB))
#define bk  ((bf16_t*)(r1 + 192 * MiB))
#define bvT ((bf16_t*)(r1 + 224 * MiB))
  DI void operator()(int tok0, int feat0, f32x16 (&acc)[2][2], int r, int hh) const {
    const int seg = feat0 >> 9, c0 = feat0 & 511;
#pragma unroll
    for (int mt = 0; mt < 2; ++mt) {
      const int tok = tok0 + mt * 32 + r, b = tok >> 14, s = tok & (SEQ - 1);
#pragma unroll
      for (int nt = 0; nt < 2; ++nt)
#pragma unroll
        for (int g = 0; g < 4; ++g) {
          const int c = c0 + nt * 32 + 8 * g + 4 * hh;
          const float v0 = acc[nt][mt][4 * g], v1 = acc[nt][mt][4 * g + 1], v2 = acc[nt][mt][4 * g + 2], v3 = acc[nt][mt][4 * g + 3];
          if (seg == 0) { u32x2 o = {pk2(siluf_(v0), siluf_(v1)), pk2(siluf_(v2), siluf_(v3))}; *(u32x2*)(aq + (size_t)tok * 512 + c) = o; }
          else if (seg == 1) {
            f32x4 lbv = *(const f32x4*)(lb + c);
            f32x4 o;
            o[0] = __logf(lbv[0] + (1.f - lbv[0]) * sigmoidf_(v0)); o[1] = __logf(lbv[1] + (1.f - lbv[1]) * sigmoidf_(v1));
            o[2] = __logf(lbv[2] + (1.f - lbv[2]) * sigmoidf_(v2)); o[3] = __logf(lbv[3] + (1.f - lbv[3]) * sigmoidf_(v3));
            *(f32x4*)(alf + (size_t)tok * 512 + c) = o;
          }
          else if (seg == 3) { u32x2 o = {pk2(siluf_(v0), siluf_(v1)), pk2(siluf_(v2), siluf_(v3))}; *(u32x2*)(ag + (size_t)tok * 512 + c) = o; }
          else if (seg == 4) { const float sc = 0.125f * LOG2E; u32x2 o = {pk2(v0 * sc, v1 * sc), pk2(v2 * sc, v3 * sc)}; *(u32x2*)(bq + (size_t)tok * 512 + c) = o; }
          else if (seg == 5) { u32x2 o = {pk2(v0, v1), pk2(v2, v3)}; *(u32x2*)(bk + (size_t)tok * 512 + c) = o; }
          else if (seg == 2) {
            bf16_t* dst = aiT + ((size_t)((b * 4 + (c >> 7)) * 128 + (c & 127))) * SEQ + s;
            dst[0] = f2bf(v0); dst[SEQ] = f2bf(v1); dst[2 * SEQ] = f2bf(v2); dst[3 * SEQ] = f2bf(v3);
          }
          else if (seg == 6) {
            bf16_t* dst = bvT + ((size_t)((b * 4 + (c >> 7)) * 128 + (c & 127))) * SEQ + swz32(s);
            dst[0] = f2bf(v0); dst[SEQ] = f2bf(v1); dst[2 * SEQ] = f2bf(v2); dst[3 * SEQ] = f2bf(v3);
          }
          __builtin_amdgcn_sched_barrier(0);
        }
    }
  }
  DI void swapped(int tok0, int feat0, f32x16 (&acc)[2][2], int r, int hh) const {
    const int seg = feat0 >> 9, c0 = feat0 & 511;
#pragma unroll
    for (int nt = 0; nt < 2; ++nt) {
      const int c = c0 + nt * 32 + r;
#pragma unroll
      for (int mt = 0; mt < 2; ++mt)
#pragma unroll
        for (int g = 0; g < 4; ++g) {
          const int tok = tok0 + mt * 32 + 8 * g + 4 * hh, b = tok >> 14, s = tok & (SEQ - 1);
          u32x2 o = {pk2(acc[nt][mt][4 * g], acc[nt][mt][4 * g + 1]), pk2(acc[nt][mt][4 * g + 2], acc[nt][mt][4 * g + 3])};
          bf16_t* base = (seg == 2 ? aiT : bvT) + ((size_t)((b * 4 + (c >> 7)) * 128 + (c & 127))) * SEQ;
          *(u32x2*)(base + (seg == 2 ? s : swz32(s))) = o;
        }
    }
  }
};

#undef aq
#undef alf
#undef aiT
#undef ag
#undef bq
#undef bk
#undef bvT
struct EpiOddIn {
  static constexpr bool kFull = false, kSwap = false;
  DI bool swap_tile(int nt_) const { return (nt_ >> 2) == 2; }
  char* r1; float* lf; const float *qg, *kg, *bf;
#define fq  ((bf16_t*)(r1))
#define fk  ((bf16_t*)(r1 + 64 * MiB))
#define fvT ((bf16_t*)(r1 + 128 * MiB))
#define fg  ((bf16_t*)(r1 + 192 * MiB))
  DI void operator()(int tok0, int feat0, f32x16 (&acc)[2][2], int r, int hh) const {
    const int seg = feat0 >> 10, c0 = feat0 & 1023;
#pragma unroll
    for (int mt = 0; mt < 2; ++mt) {
      const int tok = tok0 + mt * 32 + r, b = tok >> 14, s = tok & (SEQ - 1);
      if (seg < 2) {
        float ssq = 0.f;
#pragma unroll
        for (int nt = 0; nt < 2; ++nt)
#pragma unroll
          for (int i = 0; i < 16; ++i) ssq += acc[nt][mt][i] * acc[nt][mt][i];
        ssq += xor32(ssq);
        float rs = rsqrtf(ssq * (1.f / 64.f) + 1e-6f);
        if (seg == 0) rs *= 0.125f * LOG2E;
        const float* gg = seg == 0 ? qg : kg;
        bf16_t* dstb = (seg == 0 ? fq : fk) + (size_t)tok * 1024 + c0;
#pragma unroll
        for (int nt = 0; nt < 2; ++nt)
#pragma unroll
          for (int g = 0; g < 4; ++g) {
            const int d = nt * 32 + 8 * g + 4 * hh;
            f32x4 gv = *(const f32x4*)(gg + d);
            u32x2 o = {pk2(acc[nt][mt][4 * g] * rs * gv[0], acc[nt][mt][4 * g + 1] * rs * gv[1]), pk2(acc[nt][mt][4 * g + 2] * rs * gv[2], acc[nt][mt][4 * g + 3] * rs * gv[3])};
            *(u32x2*)(dstb + d) = o;
            __builtin_amdgcn_sched_barrier(0);
          }
      } else if (seg == 2) {
        const int head = c0 >> 6;
#pragma unroll
        for (int nt = 0; nt < 2; ++nt)
#pragma unroll
          for (int g = 0; g < 4; ++g) {
            const int d = nt * 32 + 8 * g + 4 * hh;
            bf16_t* dst = fvT + ((size_t)((b * 16 + head) * 64 + d)) * SEQ + swz32(s);
            dst[0] = f2bf(acc[nt][mt][4 * g]); dst[SEQ] = f2bf(acc[nt][mt][4 * g + 1]); dst[2 * SEQ] = f2bf(acc[nt][mt][4 * g + 2]); dst[3 * SEQ] = f2bf(acc[nt][mt][4 * g + 3]);
          }
      } else if (seg == 3) {
#pragma unroll
        for (int nt = 0; nt < 2; ++nt)
#pragma unroll
          for (int g = 0; g < 4; ++g) {
            const int c = c0 + nt * 32 + 8 * g + 4 * hh;
            u32x2 o = {pk2(sigmoidf_(acc[nt][mt][4 * g]), sigmoidf_(acc[nt][mt][4 * g + 1])), pk2(sigmoidf_(acc[nt][mt][4 * g + 2]), sigmoidf_(acc[nt][mt][4 * g + 3]))};
            *(u32x2*)(fg + (size_t)tok * 1024 + c) = o;
            __builtin_amdgcn_sched_barrier(0);
          }
      } else if (feat0 == 4096) {
#pragma unroll
        for (int g = 0; g < 2; ++g)
#pragma unroll
          for (int j = 0; j < 4; ++j) {
            const int hd = 8 * g + 4 * hh + j;
            const float xv = acc[0][mt][4 * g + j] + bf[hd];
            const float ls = fminf(xv, 0.f) - log1pf(expf(-fabsf(xv)));
            lf[((size_t)(b * 16 + hd)) * SEQ + s] = ls;
          }
      }
    }
  }
  DI void swapped(int tok0, int feat0, f32x16 (&acc)[2][2], int r, int hh) const {
    const int head = (feat0 & 1023) >> 6;
#pragma unroll
    for (int nt = 0; nt < 2; ++nt) {
      const int d = nt * 32 + r;
#pragma unroll
      for (int mt = 0; mt < 2; ++mt)
#pragma unroll
        for (int g = 0; g < 4; ++g) {
          const int tok = tok0 + mt * 32 + 8 * g + 4 * hh, b = tok >> 14, s = tok & (SEQ - 1);
          u32x2 o = {pk2(acc[nt][mt][4 * g], acc[nt][mt][4 * g + 1]), pk2(acc[nt][mt][4 * g + 2], acc[nt][mt][4 * g + 3])};
          *(u32x2*)(fvT + ((size_t)((b * 16 + head) * 64 + d)) * SEQ + swz32(s)) = o;
        }
    }
  }
};

#undef fq
#undef fk
#undef fvT
#undef fg
struct EpiRes {
  static constexpr bool kFull = false;
  const float* xin; float* y;
  DI void operator()(int tok0, int feat0, f32x16 (&acc)[2][2], int r, int hh) const {
#pragma unroll
    for (int mt = 0; mt < 2; ++mt) {
      const size_t rowo = (size_t)(tok0 + mt * 32 + r) * 1024;
#pragma unroll
      for (int nt = 0; nt < 2; ++nt)
#pragma unroll
        for (int g = 0; g < 4; ++g) {
          const int c = feat0 + nt * 32 + 8 * g + 4 * hh;
          f32x4 xv = *(const f32x4*)(xin + rowo + c);
          f32x4 o = {ALPHA * xv[0] + acc[nt][mt][4 * g], ALPHA * xv[1] + acc[nt][mt][4 * g + 1], ALPHA * xv[2] + acc[nt][mt][4 * g + 2], ALPHA * xv[3] + acc[nt][mt][4 * g + 3]};
          *(f32x4*)(y + rowo + c) = o;
          if (g & 1) __builtin_amdgcn_sched_barrier(0);
        }
    }
  }
};

struct EpiResLN {
  static constexpr bool kFull = true, kSwap = false;
  DI bool swap_tile(int) const { return false; }
  const float* xin; float* xout; bf16_t* xb; const float *g, *b; float* xchg; unsigned* cnt; unsigned target;
  DI void full(const int mt_, const int nt_, f32x16 (&acc)[2][2][2], const int tw, const int fw, const int r, const int hh, char* lds, const int tid) const {
    float* part = (float*)(lds + G_STAGE);
    const size_t rbase = (size_t)(mt_ * 256 + tw * 64 + r) * 1024 + nt_ * 256 + fw * 128 + 4 * hh;
    f32x4 xa[4], xc[4], xe[4];
#define RL_LOAD(XV, G) { constexpr int mt__ = (G) >> 2, half__ = ((G) >> 1) & 1, nt__ = (G) & 1; \
    _Pragma("unroll") for (int gq = 0; gq < 4; ++gq) XV[gq] = *(const f32x4*)(xin + rbase + (size_t)mt__ * 32 * 1024 + half__ * 64 + nt__ * 32 + 8 * gq); }
#define RL_FOLD(XV, G, SM, SQ) { constexpr int mt__ = (G) >> 2, half__ = ((G) >> 1) & 1, nt__ = (G) & 1; \
    _Pragma("unroll") for (int gq = 0; gq < 4; ++gq) _Pragma("unroll") for (int jj = 0; jj < 4; ++jj) { \
      const float y = ALPHA * XV[gq][jj] + acc[half__][nt__][mt__][4 * gq + jj]; acc[half__][nt__][mt__][4 * gq + jj] = y; SM += y; SQ += y * y; } }
#define SB __builtin_amdgcn_sched_barrier(0)
    float sm0 = 0.f, sq0 = 0.f, sm1 = 0.f, sq1 = 0.f;
    RL_LOAD(xa, 0); RL_LOAD(xc, 1); RL_LOAD(xe, 2); SB;
    RL_FOLD(xa, 0, sm0, sq0); SB; RL_LOAD(xa, 3); SB;
    RL_FOLD(xc, 1, sm0, sq0); SB; RL_LOAD(xc, 4); SB;
    RL_FOLD(xe, 2, sm0, sq0); SB; RL_LOAD(xe, 5); SB;
    RL_FOLD(xa, 3, sm0, sq0); SB; RL_LOAD(xa, 6); SB;
    RL_FOLD(xc, 4, sm1, sq1); SB; RL_LOAD(xc, 7); SB;
    RL_FOLD(xe, 5, sm1, sq1); SB;
    RL_FOLD(xa, 6, sm1, sq1); SB;
    RL_FOLD(xc, 7, sm1, sq1);
#undef SB
#undef RL_LOAD
#undef RL_FOLD
    sm0 += xor32(sm0); sq0 += xor32(sq0); sm1 += xor32(sm1); sq1 += xor32(sq1);
    if (hh == 0) {
      float* pp = part + ((fw * 256) + tw * 64 + r) * 2; pp[0] = sm0; pp[1] = sq0;
      pp[64] = sm1; pp[65] = sq1;
    }
    __syncthreads();
    if (tid < 256) {
      f32x2 a = *(const f32x2*)(part + tid * 2), c = *(const f32x2*)(part + (256 + tid) * 2);
      const unsigned long long pk = ((unsigned long long)__float_as_uint(a[1] + c[1]) << 32) | (unsigned long long)__float_as_uint(a[0] + c[0]);
      __hip_atomic_store((GAS unsigned long long*)(xchg + ((size_t)(mt_ * 4 + nt_) * 256 + tid) * 2), pk, __ATOMIC_RELAXED, __HIP_MEMORY_SCOPE_AGENT);
    }
    asm volatile("s_waitcnt vmcnt(0)" ::: "memory");
    __syncthreads();
    if (tid == 0) {
      __hip_atomic_fetch_add((GAS unsigned*)(cnt + mt_), 1u, __ATOMIC_RELAXED, __HIP_MEMORY_SCOPE_AGENT);
      while (__hip_atomic_load((GAS unsigned*)(cnt + mt_), __ATOMIC_RELAXED, __HIP_MEMORY_SCOPE_AGENT) < target) __builtin_amdgcn_s_sleep(1);
    }
    __syncthreads();
#pragma unroll
    for (int mt = 0; mt < 2; ++mt) {
      const int tl = tw * 64 + mt * 32 + r;
      float S = 0.f, Q = 0.f;
#pragma unroll
      for (int k = 0; k < 4; ++k) {
        const unsigned long long pk = __hip_atomic_load((GAS unsigned long long*)(xchg + ((size_t)(mt_ * 4 + k) * 256 + tl) * 2), __ATOMIC_RELAXED, __HIP_MEMORY_SCOPE_AGENT);
        S += __uint_as_float((unsigned)pk);
        Q += __uint_as_float((unsigned)(pk >> 32));
      }
      const float mean = S * (1.f / 1024.f);
      const float rstd = rsqrtf(fmaxf(Q * (1.f / 1024.f) - mean * mean, 0.f) + 1e-5f);
      const int c0 = nt_ * 256 + fw * 128 + 4 * hh;
      const size_t rowo = (size_t)(mt_ * 256 + tl) * 1024 + c0;
#pragma unroll
      for (int half = 0; half < 2; ++half)
#pragma unroll
        for (int nt = 0; nt < 2; ++nt) {
#pragma unroll
          for (int gq = 0; gq < 4; ++gq) {
            const int co = half * 64 + nt * 32 + 8 * gq;
            f32x4 gv = *(const f32x4*)(g + c0 + co), bv = *(const f32x4*)(b + c0 + co), o;
#pragma unroll
            for (int jj = 0; jj < 4; ++jj) o[jj] = (acc[half][nt][mt][4 * gq + jj] - mean) * rstd * gv[jj] + bv[jj];
            *(f32x4*)(xout + rowo + co) = o;
            u32x2 ob = {pk2(o[0], o[1]), pk2(o[2], o[3])};
            *(u32x2*)(xb + rowo + co) = ob;
          }
          __builtin_amdgcn_sched_barrier(0);
        }
    }
    __syncthreads();
  }
};

struct EpiW1 {
  static constexpr bool kFull = false, kSwap = false;
  DI bool swap_tile(int) const { return false; }
  DI void swapped(int, int, f32x16 (&)[2][2], int, int) const {}
  bf16_t* act;
  DI void operator()(int tok0, int feat0, f32x16 (&acc)[2][2], int r, int hh) const {
    const int u0 = (feat0 >> 6) * 32;
#pragma unroll
    for (int mt = 0; mt < 2; ++mt) {
      bf16_t* dst = act + (size_t)(tok0 + mt * 32 + r) * DFF + u0 + 4 * hh;
#pragma unroll
      for (int g = 0; g < 4; ++g) {
        u32x2 o = {pk2(siluf_(acc[0][mt][4 * g]) * acc[1][mt][4 * g], siluf_(acc[0][mt][4 * g + 1]) * acc[1][mt][4 * g + 1]),
                   pk2(siluf_(acc[0][mt][4 * g + 2]) * acc[1][mt][4 * g + 2], siluf_(acc[0][mt][4 * g + 3]) * acc[1][mt][4 * g + 3])};
        *(u32x2*)(dst + 8 * g) = o;
      }
    }
  }
};

DI float wave_sum(float v) {
#pragma unroll
  for (int o = 32; o >= 1; o >>= 1) v += __shfl_xor(v, o, 64);
  return v;
}
DI void ln_phase(float* x, bf16_t* xb, const float* __restrict__ g, const float* __restrict__ bta) {
  const int tid = tid_l(); const int lane = tid & 63, wave = tid >> 6;
  for (int row = blockIdx.x * 8 + wave; row < NTOK; row += gridDim.x * 8) {
    float* xr = x + (size_t)row * 1024;
    f32x4 v[4];
    float s = 0.f;
#pragma unroll
    for (int i = 0; i < 4; ++i) { v[i] = *(const f32x4*)(xr + (i * 64 + lane) * 4); s += v[i][0] + v[i][1] + v[i][2] + v[i][3]; }
    const float mean = wave_sum(s) * (1.f / 1024.f);
    float q = 0.f;
#pragma unroll
    for (int i = 0; i < 4; ++i)
#pragma unroll
      for (int j = 0; j < 4; ++j) { const float d = v[i][j] - mean; q += d * d; }
    const float rstd = rsqrtf(wave_sum(q) * (1.f / 1024.f) + 1e-5f);
#pragma unroll
    for (int i = 0; i < 4; ++i) {
      const int c = (i * 64 + lane) * 4;
      f32x4 gv = *(const f32x4*)(g + c), bv = *(const f32x4*)(bta + c), o;
#pragma unroll
      for (int j = 0; j < 4; ++j) o[j] = (v[i][j] - mean) * rstd * gv[j] + bv[j];
      *(f32x4*)(xr + c) = o;
      u32x2 ob = {pk2(o[0], o[1]), pk2(o[2], o[3])};
      *(u32x2*)(xb + (size_t)row * 1024 + c) = ob;
    }
  }
}

DI void cumsum_phase(const float* __restrict__ lf, float* __restrict__ c2, char* lds) {
  float* wt = (float*)lds;
  const int tid = tid_l(), lane = tid & 63, wave = tid >> 6;
  for (int row = blockIdx.x; row < 32; row += gridDim.x) {
    const float* src = lf + (size_t)row * SEQ + tid * 32;
    float v[32];
#pragma unroll
    for (int i = 0; i < 8; ++i) { f32x4 t = *(const f32x4*)(src + 4 * i); v[4 * i] = t[0]; v[4 * i + 1] = t[1]; v[4 * i + 2] = t[2]; v[4 * i + 3] = t[3]; }
    float run = 0.f;
#pragma unroll
    for (int i = 0; i < 32; ++i) { run += v[i]; v[i] = run; }
    float inc = run;
#pragma unroll
    for (int o = 1; o < 64; o <<= 1) { const float t = __shfl_up(inc, o, 64); if (lane >= o) inc += t; }
    if (lane == 63) wt[wave] = inc;
    __syncthreads();
    float pre = inc - run;
    for (int w = 0; w < wave; ++w) pre += wt[w];
    float* dst = c2 + (size_t)row * SEQ + tid * 32;
#pragma unroll
    for (int i = 0; i < 8; ++i) { f32x4 o = {(pre + v[4 * i]) * LOG2E, (pre + v[4 * i + 1]) * LOG2E, (pre + v[4 * i + 2]) * LOG2E, (pre + v[4 * i + 3]) * LOG2E}; *(f32x4*)(dst + 4 * i) = o; }
    __syncthreads();
  }
}

template <int DVT, bool FOX>
DI void attn_step(const char* kb, const bf16x8 (&qf)[4], f32x16 (&o)[DVT], float& m, float& l, const bool diag, const int j, const int tq, const int r, const int hh) {
  constexpr int VB = DVT * 32 * LROW;
  const char* vb = kb + 64 * LROW; const char* cb = vb + VB;
  f32x16 st[2];
  bf16x8 kf[8];
#pragma unroll
  for (int ks = 0; ks < 4; ++ks)
#pragma unroll
    for (int kt = 0; kt < 2; ++kt) kf[ks * 2 + kt] = *(const bf16x8*)(kb + (kt * 32 + r) * LROW + ks * 32 + hh * 16);
  if (FOX) {
#pragma unroll
    for (int kt = 0; kt < 2; ++kt)
#pragma unroll
      for (int g = 0; g < 4; ++g) {
        f32x4 cs = *(const f32x4*)(cb + (kt * 32 + 8 * g + 4 * hh) * 4);
        st[kt][4 * g] = cs[0]; st[kt][4 * g + 1] = cs[1]; st[kt][4 * g + 2] = cs[2]; st[kt][4 * g + 3] = cs[3];
      }
  } else {
#pragma unroll
    for (int kt = 0; kt < 2; ++kt)
#pragma unroll
      for (int i = 0; i < 16; ++i) st[kt][i] = 0.f;
  }
  __builtin_amdgcn_sched_barrier(0);
#pragma unroll
  for (int ks = 0; ks < 4; ++ks)
#pragma unroll
    for (int kt = 0; kt < 2; ++kt) st[kt] = MFMA32(kf[ks * 2 + kt], qf[ks], st[kt]);
  bf16x8 va[DVT], vn[DVT];
#pragma unroll
  for (int d = 0; d < DVT; ++d) va[d] = *(const bf16x8*)(vb + (d * 32 + r) * LROW + (8 * hh) * 2);
  __builtin_amdgcn_sched_barrier(0);
  {
    const f32x2 mm = {m, m};
#pragma unroll
    for (int kt = 0; kt < 2; ++kt)
#pragma unroll
      for (int i = 0; i < 8; ++i) { f32x2 z = {st[kt][2 * i], st[kt][2 * i + 1]}; z = z - mm; st[kt][2 * i] = z[0]; st[kt][2 * i + 1] = z[1]; }
  }
  if (FOX) {
    if (diag) {
#pragma unroll
      for (int kt = 0; kt < 2; ++kt)
#pragma unroll
        for (int i = 0; i < 16; ++i) {
          const int key = j * 64 + kt * 32 + (i & 3) + 8 * (i >> 2) + 4 * hh;
          if (key > tq) st[kt][i] = -INFINITY;
        }
    }
  }
  float mx;
  {
    float a0 = fmaxf(fmaxf(st[0][0], st[0][1]), st[0][2]), a1 = fmaxf(fmaxf(st[1][0], st[1][1]), st[1][2]);
#pragma unroll
    for (int i = 3; i < 15; i += 2) { a0 = fmaxf(fmaxf(a0, st[0][i]), st[0][i + 1]); a1 = fmaxf(fmaxf(a1, st[1][i]), st[1][i + 1]); }
    mx = fmaxf(fmaxf(a0, a1), fmaxf(st[0][15], st[1][15]));
  }
  mx = fmaxf(mx, xor32(mx));
  if (__any(diag || mx > 8.f)) {
    const float d = (diag || mx > 0.f) ? mx : 0.f;
    const float alpha = diag ? 0.f : __builtin_amdgcn_exp2f(-d);
    m += d;
    l *= alpha;
#pragma unroll
    for (int dd = 0; dd < DVT; ++dd)
#pragma unroll
      for (int i = 0; i < 16; ++i) o[dd][i] *= alpha;
    const f32x2 d2 = {d, d};
#pragma unroll
    for (int kt = 0; kt < 2; ++kt)
#pragma unroll
      for (int i = 0; i < 8; ++i) { f32x2 z = {st[kt][2 * i], st[kt][2 * i + 1]}; z = z - d2; st[kt][2 * i] = z[0]; st[kt][2 * i + 1] = z[1]; }
  }
  f32x2 ls2 = {0.f, 0.f};
#pragma unroll
  for (int kt = 0; kt < 2; ++kt)
#pragma unroll
    for (int i = 0; i < 8; ++i) {
      f32x2 pv = {__builtin_amdgcn_exp2f(st[kt][2 * i]), __builtin_amdgcn_exp2f(st[kt][2 * i + 1])};
      st[kt][2 * i] = pv[0]; st[kt][2 * i + 1] = pv[1];
      ls2 = ls2 + pv;
    }
  l += ls2[0] + ls2[1];
  __builtin_amdgcn_sched_barrier(0);
#define A_PVGROUP(GK, VC, VN) { constexpr int kt_ = (GK) >> 1, s2_ = (GK) & 1; \
    if ((GK) < 3) { constexpr int kt1_ = ((GK) + 1) >> 1, s21_ = ((GK) + 1) & 1; \
      _Pragma("unroll") for (int d = 0; d < DVT; ++d) VN[d] = *(const bf16x8*)(vb + (d * 32 + r) * LROW + (kt1_ * 32 + 16 * s21_ + 8 * hh) * 2); } \
    u32x4 pw_ = {pk2(st[kt_][8 * s2_], st[kt_][8 * s2_ + 1]), pk2(st[kt_][8 * s2_ + 2], st[kt_][8 * s2_ + 3]), pk2(st[kt_][8 * s2_ + 4], st[kt_][8 * s2_ + 5]), pk2(st[kt_][8 * s2_ + 6], st[kt_][8 * s2_ + 7])}; \
    const bf16x8 pf_ = __builtin_bit_cast(bf16x8, pw_); \
    __builtin_amdgcn_sched_barrier(0); \
    _Pragma("unroll") for (int d = 0; d < DVT; ++d) o[d] = MFMA32(VC[d], pf_, o[d]); \
    __builtin_amdgcn_sched_barrier(0); }
  A_PVGROUP(0, va, vn); A_PVGROUP(1, vn, va); A_PVGROUP(2, va, vn); A_PVGROUP(3, vn, va);
#undef A_PVGROUP
}

template <int DVT, bool FOX>
DI void attn_pass(const bf16_t* __restrict__ qrow, const bf16_t* __restrict__ kbase, const int ldk, const bf16_t* __restrict__ vtbase,
                  const float* __restrict__ cbase, const int j_hi, const int my_last, const int j_lo_diag, const int tq, const float prune_c,
                  f32x16 (&o)[DVT], float& l_out, char* lds) {
  constexpr int VB = DVT * 32 * LROW;
  constexpr int STAGE = 64 * LROW + VB + 256;
  const int tid = tid_l(), lane = tid & 63;
  const int r = lane & 31, hh = lane >> 5;
  const int lrow = tid >> 3, lch = tid & 7;
  bf16x8 qf[4];
#pragma unroll
  for (int ks = 0; ks < 4; ++ks) qf[ks] = *(const bf16x8*)(qrow + ks * 16 + hh * 8);
#pragma unroll
  for (int d = 0; d < DVT; ++d)
#pragma unroll
    for (int i = 0; i < 16; ++i) o[d][i] = 0.f;
  float m = 0.f, l = 0.f;
  u32x4 kr0, kr1, vr0[DVT / 2], vr1[DVT / 2]; f32x4 cr0 = {0.f, 0.f, 0.f, 0.f}, cr1 = {0.f, 0.f, 0.f, 0.f};
  const bf16_t* kp = kbase + (size_t)lrow * ldk + lch * 8;
  const bf16_t* vp = vtbase + (size_t)lrow * SEQ + lch * 8;
#define A_GLOAD(KR, VR, CR, JT) { const int s1_ = (JT) * 64; KR = *(const u32x4*)(kp + (size_t)s1_ * ldk); \
    _Pragma("unroll") for (int i_ = 0; i_ < DVT / 2; ++i_) VR[i_] = *(const u32x4*)(vp + (size_t)(64 * i_) * SEQ + s1_); \
    if (FOX) { if (tid < 16) { f32x4 t_ = *(const f32x4*)(cbase + s1_ + tid * 4); CR[0] = -t_[0]; CR[1] = -t_[1]; CR[2] = -t_[2]; CR[3] = -t_[3]; } } }
#define A_LSTORE(KR, VR, CR, STG) { char* kb_ = lds + (STG) * STAGE; char* vb_ = kb_ + 64 * LROW; char* cb_ = vb_ + VB; \
    *(u32x4*)(kb_ + lrow * LROW + lch * 16) = KR; \
    _Pragma("unroll") for (int i_ = 0; i_ < DVT / 2; ++i_) *(u32x4*)(vb_ + (lrow + 64 * i_) * LROW + lch * 16) = VR[i_]; \
    if (FOX) { if (tid < 16) *(f32x4*)(cb_ + tid * 16) = CR; } }
#define A_PRUNE(STG) (FOX && j < j_lo_diag && (prune_c + *(const float*)(lds + (STG) * STAGE + 64 * LROW + VB + 63 * 4) < -160.f))
  int j = j_hi;
  A_GLOAD(kr0, vr0, cr0, j);
  if (j >= 1) A_GLOAD(kr1, vr1, cr1, j - 1);
  A_LSTORE(kr0, vr0, cr0, 0);
  __syncthreads();
  for (;;) {
    if (A_PRUNE(0)) break;
    if (j >= 2) A_GLOAD(kr0, vr0, cr0, j - 2);
    if (j <= my_last) attn_step<DVT, FOX>(lds, qf, o, m, l, j == my_last, j, tq, r, hh);
    if (j == 0) break;
    A_LSTORE(kr1, vr1, cr1, 1);
    __syncthreads();
    --j;
    if (A_PRUNE(1)) break;
    if (j >= 2) A_GLOAD(kr1, vr1, cr1, j - 2);
    if (j <= my_last) attn_step<DVT, FOX>(lds + STAGE, qf, o, m, l, j == my_last, j, tq, r, hh);
    if (j == 0) break;
    A_LSTORE(kr0, vr0, cr0, 0);
    __syncthreads();
    --j;
  }
  __syncthreads();
#undef A_GLOAD
#undef A_LSTORE
#undef A_PRUNE
  l_out = l + xor32(l);
}

DI void fox_phase(const Params& p, const int j_odd, char* lds) {
  char* ws = (char*)launder(p.ws);
  const bf16_t* fq = (const bf16_t*)(ws + OFF_R1);
  const bf16_t* fk = (const bf16_t*)(ws + OFF_R1 + 64 * MiB);
  const bf16_t* fvT = (const bf16_t*)(ws + OFF_R1 + 128 * MiB);
  const bf16_t* fg = (const bf16_t*)(ws + OFF_R1 + 192 * MiB);
  const float* c2 = (const float*)(ws + OFF_C2);
  bf16_t* ab = (bf16_t*)(ws + OFF_AB);
  const float b2 = ((const float*)(ws + OFF_MISC))[1032 + j_odd];
  const int tid = tid_l(); const int lane = tid & 63, wave = __builtin_amdgcn_readfirstlane(tid >> 6), r = lane & 31, hh = lane >> 5;
  for (int rnd = 0; rnd < 4; ++rnd) {
    const int bh = rnd * 8 + (blockIdx.x & 7), pp = blockIdx.x >> 3, b = bh >> 4, h = bh & 15;
    for (int half = 0; half < 2; ++half) {
      const int qb = half == 0 ? 63 - pp : pp;
      const int t0 = qb * 256, tq0 = t0 + wave * 32, tq = tq0 + r;
      const int nkv = (t0 + 256) >> 6, my_last = (tq0 + 31) >> 6;
      const float prune_c = b2 + c2[(size_t)bh * SEQ + t0];
      f32x16 o[2]; float l;
      attn_pass<2, true>(fq + (size_t)(b * SEQ + tq) * 1024 + h * 64, fk + (size_t)(b * SEQ) * 1024 + h * 64, 1024,
                         fvT + (size_t)(bh * 64) * SEQ, c2 + (size_t)bh * SEQ, nkv - 1, my_last, t0 >> 6, tq, prune_c, o, l, lds);
      const float inv = 1.f / l;
      const size_t rowo = (size_t)(b * SEQ + tq) * 1024 + h * 64;
#pragma unroll
      for (int d = 0; d < 2; ++d)
#pragma unroll
        for (int g = 0; g < 4; ++g) {
          const int c = d * 32 + 8 * g + 4 * hh;
          u32x2 gv = *(const u32x2*)(fg + rowo + c);
          const float g0 = __uint_as_float(gv[0] << 16), g1 = __uint_as_float(gv[0] & 0xffff0000u), g2 = __uint_as_float(gv[1] << 16), g3 = __uint_as_float(gv[1] & 0xffff0000u);
          u32x2 ov = {pk2(o[d][4 * g] * inv * g0, o[d][4 * g + 1] * inv * g1), pk2(o[d][4 * g + 2] * inv * g2, o[d][4 * g + 3] * inv * g3)};
          *(u32x2*)(ab + rowo + c) = ov;
        }
    }
  }
}

DI void diff_phase(const Params& p, const int j_even, char* lds) {
  char* ws = (char*)launder(p.ws);
  const bf16_t* bq = (const bf16_t*)(ws + OFF_R1 + 160 * MiB);
  const bf16_t* bk = (const bf16_t*)(ws + OFF_R1 + 192 * MiB);
  const bf16_t* bvT = (const bf16_t*)(ws + OFF_R1 + 224 * MiB);
  bf16_t* ab = (bf16_t*)(ws + OFF_AB);
  const float* misc = (const float*)(ws + OFF_MISC);
  const float lam = misc[1024 + j_even];
  const float lam_init = 0.8f - 0.6f * expf(-0.3f * (float)(2 * j_even));
  const float* dg = ((const float*)p.diff_g) + j_even * 128;
  const int tid = tid_l(); const int lane = tid & 63, wave = __builtin_amdgcn_readfirstlane(tid >> 6), r = lane & 31, hh = lane >> 5;
  {
    const int bh = blockIdx.x & 7, pp = blockIdx.x >> 3, b = bh >> 2, h = bh & 3;
    for (int half = 0; half < 2; ++half) {
      const int qb = half == 0 ? 63 - pp : pp;
      const int t0 = qb * 256, tq0 = t0 + wave * 32, tq = tq0 + r;
      const int nkv = (t0 + 256) >> 6, my_last = tq0 >> 6;
      f32x16 o1[4], o2[4]; float l1, l2;
      attn_pass<4, false>(bq + (size_t)(b * SEQ + tq) * 512 + h * 128, bk + (size_t)(b * SEQ) * 512 + h * 128, 512,
                          bvT + (size_t)(bh * 128) * SEQ, nullptr, nkv - 1, my_last, 0, tq, 0.f, o1, l1, lds);
      const float i1 = 1.f / l1;
      unsigned* o1s = (unsigned*)(lds + DIFF_STASH_OFF) + tid;
#pragma unroll
      for (int d = 0; d < 4; ++d)
#pragma unroll
        for (int i = 0; i < 8; ++i) o1s[(d * 8 + i) * 512] = pk2(o1[d][2 * i] * i1, o1[d][2 * i + 1] * i1);
      attn_pass<4, false>(bq + (size_t)(b * SEQ + tq) * 512 + h * 128 + 64, bk + (size_t)(b * SEQ) * 512 + h * 128 + 64, 512,
                          bvT + (size_t)(bh * 128) * SEQ, nullptr, nkv - 1, my_last, 0, tq, 0.f, o2, l2, lds);
      const float i2 = lam / l2;
      float ssq = 0.f;
#pragma unroll
      for (int d = 0; d < 4; ++d)
#pragma unroll
        for (int i = 0; i < 8; ++i) {
          const unsigned pw = o1s[(d * 8 + i) * 512];
          const float va = __uint_as_float(pw << 16) - i2 * o2[d][2 * i], vb = __uint_as_float(pw & 0xffff0000u) - i2 * o2[d][2 * i + 1];
          o2[d][2 * i] = va; o2[d][2 * i + 1] = vb; ssq += va * va + vb * vb; }
      ssq += xor32(ssq);
      const float rs = rsqrtf(ssq * (1.f / 128.f) + 1e-6f) * (1.f - lam_init);
      const size_t rowo = (size_t)(b * SEQ + tq) * 1024 + 512 + h * 128;
#pragma unroll
      for (int d = 0; d < 4; ++d)
#pragma unroll
        for (int g = 0; g < 4; ++g) {
          const int c = d * 32 + 8 * g + 4 * hh;
          f32x4 gv = *(const f32x4*)(dg + c);
          u32x2 ov = {pk2(o2[d][4 * g] * rs * gv[0], o2[d][4 * g + 1] * rs * gv[1]), pk2(o2[d][4 * g + 2] * rs * gv[2], o2[d][4 * g + 3] * rs * gv[3])};
          *(u32x2*)(ab + rowo + c) = ov;
        }
    }
  }
}

DI void hgrn_stageA(const Params& p, char* lds) {
  char* ws = (char*)launder(p.ws);
  const float* alf = (const float*)(ws + OFF_R1 + 32 * MiB);
  const bf16_t* aiT = (const bf16_t*)(ws + OFF_R1 + 96 * MiB);
  bf16_t* UT = (bf16_t*)(ws + OFF_UT);
  float* dbuf = (float*)(ws + OFF_DB);
  float* lfT = (float*)lds;
  float* part = (float*)(lds + 32768);
  char* KT = lds + 34816;
  char* IT = KT + 18432;
  const int tid = tid_l(), lane = tid & 63, wave = tid >> 6, r = lane & 31, hh = lane >> 5;
  f32x4 lfr[4]; u32x4 itr[2];
#define HA_FETCH(TASK) { const int bh_ = (TASK) >> 8, c_ = (TASK) & 255, tok0_ = (bh_ >> 2) * SEQ + c_ * 64, h_ = bh_ & 3; \
    _Pragma("unroll") for (int i = 0; i < 4; ++i) { const int idx = tid + 512 * i, row = idx >> 5, c4 = idx & 31; \
      lfr[i] = *(const f32x4*)(alf + (size_t)(tok0_ + row) * 512 + h_ * 128 + c4 * 4); } \
    _Pragma("unroll") for (int i = 0; i < 2; ++i) { const int idx = tid + 512 * i, row = idx >> 3, ch = idx & 7; \
      itr[i] = *(const u32x4*)(aiT + (size_t)(bh_ * 128 + row) * SEQ + c_ * 64 + ch * 8); } }
  if (blockIdx.x < 2048) HA_FETCH(blockIdx.x);
  for (int task = blockIdx.x; task < 2048; task += gridDim.x) {
    const int bh = task >> 8, c = task & 255;
#pragma unroll
    for (int i = 0; i < 4; ++i) { const int idx = tid + 512 * i, row = idx >> 5, c4 = idx & 31; *(f32x4*)(lfT + row * 128 + c4 * 4) = lfr[i]; }
#pragma unroll
    for (int i = 0; i < 2; ++i) { const int idx = tid + 512 * i, row = idx >> 3, ch = idx & 7; *(u32x4*)(IT + row * LROW + ch * 16) = itr[i]; }
    if (task + (int)gridDim.x < 2048) HA_FETCH(task + (int)gridDim.x);
    (void)bh; (void)c;
    __syncthreads();
    const int k = tid & 127, seg = tid >> 7;
    float lv[16], bv[16];
    float run = 0.f;
#pragma unroll
    for (int i = 0; i < 16; ++i) { lv[i] = lfT[(seg * 16 + i) * 128 + k]; run += lv[i]; bv[i] = run; }
    part[seg * 128 + k] = run;
    __syncthreads();
    float pre = 0.f, tot = 0.f;
#pragma unroll
    for (int s2 = 0; s2 < 4; ++s2) { const float pv = part[s2 * 128 + k]; if (s2 < seg) pre += pv; tot += pv; }
    {
      float kv[16];
#pragma unroll
      for (int i = 0; i < 16; ++i) kv[i] = (1.f - __expf(lv[i])) * __expf(tot - (pre + bv[i]));
      u32x4 w0 = {pk2(kv[0], kv[1]), pk2(kv[2], kv[3]), pk2(kv[4], kv[5]), pk2(kv[6], kv[7])};
      u32x4 w1 = {pk2(kv[8], kv[9]), pk2(kv[10], kv[11]), pk2(kv[12], kv[13]), pk2(kv[14], kv[15])};
      *(u32x4*)(KT + k * LROW + seg * 32) = w0;
      *(u32x4*)(KT + k * LROW + seg * 32 + 16) = w1;
    }
    if (seg == 0) dbuf[(size_t)task * 128 + k] = __expf(tot);
    __syncthreads();
    {
      const int ktile = wave & 3, vhalf = wave >> 2;
      f32x16 acc[2];
#pragma unroll
      for (int vt = 0; vt < 2; ++vt)
#pragma unroll
        for (int i = 0; i < 16; ++i) acc[vt][i] = 0.f;
#pragma unroll
      for (int ks = 0; ks < 4; ++ks) {
        bf16x8 a = *(const bf16x8*)(KT + (ktile * 32 + r) * LROW + ks * 32 + hh * 16);
#pragma unroll
        for (int vt = 0; vt < 2; ++vt) {
          bf16x8 bb = *(const bf16x8*)(IT + (vhalf * 64 + vt * 32 + r) * LROW + ks * 32 + hh * 16);
          acc[vt] = MFMA32(a, bb, acc[vt]);
        }
      }
#pragma unroll
      for (int vt = 0; vt < 2; ++vt) {
        bf16_t* dst = UT + ((size_t)task * 128 + vhalf * 64 + vt * 32 + r) * 128 + ktile * 32 + 4 * hh;
#pragma unroll
        for (int g = 0; g < 4; ++g) { u32x2 ov = {pk2(acc[vt][4 * g], acc[vt][4 * g + 1]), pk2(acc[vt][4 * g + 2], acc[vt][4 * g + 3])}; *(u32x2*)(dst + 8 * g) = ov; }
      }
    }
    __syncthreads();
  }
}

#undef HA_FETCH
DI void hgrn_scan(const Params& p) {
  char* ws = (char*)launder(p.ws);
  bf16_t* UT = (bf16_t*)(ws + OFF_UT);
  const float* dbuf = (const float*)(ws + OFF_DB);
  const int gid = blockIdx.x * 512 + tid_l();
  if (gid >= 8 * 16384) return;
  const int bh = gid >> 14, e = gid & 16383;
  bf16_t* up = UT + (size_t)bh * 256 * 16384 + e;
  const float* dp = dbuf + (size_t)bh * 256 * 128 + (e & 127);
  float st = 0.f;
  for (int c0 = 0; c0 < 256; c0 += 32) {
    bf16_t u[32]; float dv[32];
#pragma unroll
    for (int i = 0; i < 32; ++i) { u[i] = up[(size_t)(c0 + i) * 16384]; dv[i] = dp[(size_t)(c0 + i) * 128]; }
#pragma unroll
    for (int i = 0; i < 32; ++i) {
      up[(size_t)(c0 + i) * 16384] = f2bf(st);
      st = dv[i] * st + bf2f(u[i]);
    }
  }
}

constexpr int QROW = 272;
DI void hgrn_stageC(const Params& p, const int j_even, char* lds) {
  char* ws = (char*)launder(p.ws);
  const bf16_t* aq = (const bf16_t*)(ws + OFF_R1);
  const float* alf = (const float*)(ws + OFF_R1 + 32 * MiB);
  const bf16_t* aiT = (const bf16_t*)(ws + OFF_R1 + 96 * MiB);
  const bf16_t* ag = (const bf16_t*)(ws + OFF_R1 + 128 * MiB);
  const bf16_t* UT = (const bf16_t*)(ws + OFF_UT);
  bf16_t* ab = (bf16_t*)(ws + OFF_AB);
  const float* hg = ((const float*)p.hgrn_g) + j_even * 128;
  float* lfT = (float*)lds;
  char* ST = lds;
  char* Q1 = lds + 34816;
  char* Q2 = Q1 + 64 * QROW;
  char* K2 = Q2 + 64 * QROW;
  char* IT = K2 + 64 * QROW;
  float* part = (float*)(IT + 128 * LROW);
  const int tid = tid_l(), lane = tid & 63, wave = tid >> 6, r = lane & 31, hh = lane >> 5;
  f32x4 lfr[4]; u32x4 itr[2]; bf16_t qr[16];
#define HC_FETCH(TASK) { const int bh_ = (TASK) >> 8, c_ = (TASK) & 255, tok0_ = (bh_ >> 2) * SEQ + c_ * 64, h_ = bh_ & 3; \
    _Pragma("unroll") for (int i = 0; i < 4; ++i) { const int idx = tid + 512 * i, row = idx >> 5, c4 = idx & 31; \
      lfr[i] = *(const f32x4*)(alf + (size_t)(tok0_ + row) * 512 + h_ * 128 + c4 * 4); } \
    _Pragma("unroll") for (int i = 0; i < 2; ++i) { const int idx = tid + 512 * i, row = idx >> 3, ch = idx & 7; \
      itr[i] = *(const u32x4*)(aiT + (size_t)(bh_ * 128 + row) * SEQ + c_ * 64 + ch * 8); } \
    _Pragma("unroll") for (int i = 0; i < 16; ++i) qr[i] = aq[(size_t)(tok0_ + (tid >> 7) * 16 + i) * 512 + h_ * 128 + (tid & 127)]; }
  if (blockIdx.x < 2048) HC_FETCH(blockIdx.x);
  for (int task = blockIdx.x; task < 2048; task += gridDim.x) {
    const int bh = task >> 8, c = task & 255, b = bh >> 2, h = bh & 3;
    const int tok0 = b * SEQ + c * 64;
#pragma unroll
    for (int i = 0; i < 4; ++i) { const int idx = tid + 512 * i, row = idx >> 5, c4 = idx & 31; *(f32x4*)(lfT + row * 128 + c4 * 4) = lfr[i]; }
#pragma unroll
    for (int i = 0; i < 2; ++i) { const int idx = tid + 512 * i, row = idx >> 3, ch = idx & 7; *(u32x4*)(IT + row * LROW + ch * 16) = itr[i]; }
    float qcur[16];
#pragma unroll
    for (int i = 0; i < 16; ++i) qcur[i] = bf2f(qr[i]);
    u32x4 sreg[4];
#pragma unroll
    for (int i = 0; i < 4; ++i) sreg[i] = *(const u32x4*)(UT + (size_t)task * 16384 + (size_t)(tid + 512 * i) * 8);
    if (task + (int)gridDim.x < 2048) HC_FETCH(task + (int)gridDim.x);
    __syncthreads();
    const int k = tid & 127, seg = tid >> 7;
    float lv[16], bv[16];
    float run = 0.f;
#pragma unroll
    for (int i = 0; i < 16; ++i) { lv[i] = lfT[(seg * 16 + i) * 128 + k]; run += lv[i]; bv[i] = run; }
    part[seg * 128 + k] = run;
    __syncthreads();
    {
      const float p0 = part[k], p1 = part[128 + k], p2 = part[256 + k];
      const float pre = (seg > 0 ? p0 : 0.f) + (seg > 1 ? p1 : 0.f) + (seg > 2 ? p2 : 0.f);
      const float bmid = p0 + p1;
#pragma unroll
      for (int i = 0; i < 16; ++i) {
        const int t = seg * 16 + i;
        const float bt = pre + bv[i];
        const float qv = qcur[i];
        const float kk = 1.f - __expf(lv[i]);
        *(bf16_t*)(Q1 + t * QROW + k * 2) = f2bf(qv * __expf(bt));
        *(bf16_t*)(Q2 + t * QROW + k * 2) = f2bf(qv * __expf(fminf(bt - bmid, 80.f)));
        *(bf16_t*)(K2 + t * QROW + k * 2) = f2bf(kk * __expf(fminf(bmid - bt, 80.f)));
      }
    }
#pragma unroll
    for (int i = 0; i < 4; ++i) { const int idx = tid + 512 * i, row = idx >> 4, ch = idx & 15; *(u32x4*)(ST + row * QROW + ch * 16) = sreg[i]; }
    __syncthreads();
    {
      const int vt = wave & 3, tt = wave >> 2;
      const int t = tt * 32 + r;
      f32x16 sc[2];
#pragma unroll
      for (int st = 0; st < 2; ++st)
#pragma unroll
        for (int i = 0; i < 16; ++i) sc[st][i] = 0.f;
#pragma unroll
      for (int ks = 0; ks < 8; ++ks) {
        bf16x8 qb = *(const bf16x8*)(Q2 + t * QROW + ks * 32 + hh * 16);
#pragma unroll
        for (int st = 0; st < 2; ++st) {
          if (st <= tt) {
            bf16x8 a = *(const bf16x8*)(K2 + (st * 32 + r) * QROW + ks * 32 + hh * 16);
            sc[st] = MFMA32(a, qb, sc[st]);
          }
        }
      }
      f32x16 acc;
#pragma unroll
      for (int i = 0; i < 16; ++i) acc[i] = 0.f;
#pragma unroll
      for (int st = 0; st < 2; ++st) {
        if (st <= tt) {
#pragma unroll
          for (int i = 0; i < 16; ++i) { const int s = st * 32 + (i & 3) + 8 * (i >> 2) + 4 * hh; if (s > t) sc[st][i] = 0.f; }
#pragma unroll
          for (int s2 = 0; s2 < 2; ++s2) {
            u32x4 pw = {pk2(sc[st][8 * s2], sc[st][8 * s2 + 1]), pk2(sc[st][8 * s2 + 2], sc[st][8 * s2 + 3]), pk2(sc[st][8 * s2 + 4], sc[st][8 * s2 + 5]), pk2(sc[st][8 * s2 + 6], sc[st][8 * s2 + 7])};
            const bf16x8 pf = __builtin_bit_cast(bf16x8, pw);
            const char* ip = IT + (vt * 32 + r) * LROW + (st * 32 + 16 * s2 + 4 * hh) * 2;
            u32x2 lo = *(const u32x2*)ip, hi = *(const u32x2*)(ip + 16);
            u32x4 aw = {lo[0], lo[1], hi[0], hi[1]};
            acc = MFMA32(__builtin_bit_cast(bf16x8, aw), pf, acc);
          }
        }
      }
#pragma unroll
      for (int ks = 0; ks < 8; ++ks) {
        bf16x8 a = *(const bf16x8*)(ST + (vt * 32 + r) * QROW + ks * 32 + hh * 16);
        bf16x8 qb = *(const bf16x8*)(Q1 + t * QROW + ks * 32 + hh * 16);
        acc = MFMA32(a, qb, acc);
      }
      float ssq = 0.f;
#pragma unroll
      for (int i = 0; i < 16; ++i) ssq += acc[i] * acc[i];
      ssq += xor32(ssq);
      if (hh == 0) part[vt * 64 + t] = ssq;
      __syncthreads();
      const float tot = part[t] + part[64 + t] + part[128 + t] + part[192 + t];
      const float rs = rsqrtf(tot * (1.f / 128.f) + 1e-6f);
      const size_t go = (size_t)(tok0 + t) * 512 + h * 128 + vt * 32 + 4 * hh;
      const size_t oo = (size_t)(tok0 + t) * 1024 + h * 128 + vt * 32 + 4 * hh;
#pragma unroll
      for (int g = 0; g < 4; ++g) {
        f32x4 gn = *(const f32x4*)(hg + vt * 32 + 4 * hh + 8 * g);
        u32x2 gv = *(const u32x2*)(ag + go + 8 * g);
        const float g0 = __uint_as_float(gv[0] << 16), g1 = __uint_as_float(gv[0] & 0xffff0000u), g2 = __uint_as_float(gv[1] << 16), g3 = __uint_as_float(gv[1] & 0xffff0000u);
        u32x2 ov = {pk2(acc[4 * g] * rs * gn[0] * g0, acc[4 * g + 1] * rs * gn[1] * g1), pk2(acc[4 * g + 2] * rs * gn[2] * g2, acc[4 * g + 3] * rs * gn[3] * g3)};
        *(u32x2*)(ab + oo + 8 * g) = ov;
      }
    }
    __syncthreads();
  }
}

#undef HC_FETCH
DI void grid_barrier(unsigned* ctr, const unsigned target) {
  asm volatile("s_waitcnt vmcnt(0)" ::: "memory");
  __syncthreads();
  if (threadIdx.x == 0) {
    __builtin_amdgcn_fence(__ATOMIC_RELEASE, "agent");
    asm volatile("s_waitcnt vmcnt(0)" ::: "memory");
    __hip_atomic_fetch_add((GAS unsigned*)ctr, 1u, __ATOMIC_RELAXED, __HIP_MEMORY_SCOPE_AGENT);
    while (__hip_atomic_load((GAS unsigned*)ctr, __ATOMIC_RELAXED, __HIP_MEMORY_SCOPE_AGENT) < target) __builtin_amdgcn_s_sleep(1);
    __builtin_amdgcn_fence(__ATOMIC_ACQUIRE, "agent");
    asm volatile("s_waitcnt vmcnt(0)" ::: "memory");
  }
  __syncthreads();
}
typedef const __attribute__((address_space(4))) Params* kparams_t;
#if defined(__HIP_DEVICE_COMPILE__)
DI kparams_t launder_k(kparams_t q) { asm volatile("" : "+s"(q)); return q; }
#endif
#if defined(__HIP_DEVICE_COMPILE__)
#define KPARAMS (*launder_k((kparams_t)__builtin_amdgcn_kernarg_segment_ptr()))
#else
#define KPARAMS p_arg
#endif
__global__ void __launch_bounds__(512) fwd_mega(Params p_arg) {
  extern __shared__ __attribute__((aligned(16))) char lds[];
  int ph = 0;
  const int p_lo = p_arg.lo, p_hi = p_arg.hi;
#define PHASE(id, ...) { if (ph >= p_lo && ph < p_hi) { const Params p = KPARAMS; char* ws = (char*)launder(p.ws); float* outp = (float*)launder((GAS char*)p.out); bf16_t* ab = (bf16_t*)(ws + OFF_AB); (void)outp; (void)ab; \
    if (ONLY < 0 || ONLY == id) { __VA_ARGS__; } if ((DUPMASK >> id) & 1) { __syncthreads(); __VA_ARGS__; } if (ph + 1 < p_hi) { if (ph == p_lo) cg::this_grid().sync(); else grid_barrier((unsigned*)(ws + OFF_CNT) + 256, (unsigned)(ph - p_lo) * gridDim.x); } } ++ph; }
  PHASE(0, phase0(p, lds));
  for (int l = 0; l < 4; ++l) {
    const int j = l >> 1;
    if ((l & 1) == 0) {
      PHASE(1,
        EpiEvenIn e;
        e.r1 = ws + OFF_R1; e.lb = (const float*)(ws + OFF_MISC) + j * 512;
        gemm_phase(ab, 1024, (const bf16_t*)(ws + OFF_WEI) + (size_t)j * EVEN_IN * D, EVEN_IN, D, e, lds));
      PHASE(2, hgrn_stageA(p, lds));
      PHASE(3, hgrn_scan(p));
      PHASE(4, hgrn_stageC(p, j, lds); diff_phase(p, j, lds));
      PHASE(6,
        EpiResLN er; er.xin = (l == 0) ? (const float*)launder((GAS char*)p.x_in) : outp; er.xout = outp; er.xb = ab;
        er.g = ((const float*)p.ln1g) + l * D; er.b = ((const float*)p.ln1b) + l * D;
        er.xchg = (float*)(ws + OFF_XCHG); er.cnt = (unsigned*)(ws + OFF_CNT); er.target = 4u * (unsigned)(2 * l + 1);
        gemm_phase(ab, 1024, (const bf16_t*)(ws + OFF_WEO) + (size_t)j * D * D, D, D, er, lds));
    } else {
      PHASE(7,
        EpiOddIn e;
        e.r1 = ws + OFF_R1;
        e.lf = (float*)(ws + OFF_LF); e.qg = ((const float*)p.fox_qg) + j * 64; e.kg = ((const float*)p.fox_kg) + j * 64; e.bf = ((const float*)p.fox_bf) + j * 16;
        gemm_phase(ab, 1024, (const bf16_t*)(ws + OFF_WFI) + (size_t)j * ODD_PAD * D, ODD_PAD, D, e, lds));
      PHASE(8, cumsum_phase((const float*)(ws + OFF_LF), (float*)(ws + OFF_C2), lds));
      PHASE(9, fox_phase(p, j, lds));
      PHASE(6,
        EpiResLN er; er.xin = outp; er.xout = outp; er.xb = ab;
        er.g = ((const float*)p.ln1g) + l * D; er.b = ((const float*)p.ln1b) + l * D;
        er.xchg = (float*)(ws + OFF_XCHG); er.cnt = (unsigned*)(ws + OFF_CNT); er.target = 4u * (unsigned)(2 * l + 1);
        gemm_phase(ab, 1024, (const bf16_t*)(ws + OFF_WFO) + (size_t)j * D * D, D, D, er, lds));
    }
    PHASE(11,
      EpiW1 e1; e1.act = (bf16_t*)(ws + OFF_R1);
      gemm_phase(ab, 1024, (const bf16_t*)(ws + OFF_W1) + (size_t)l * 2 * DFF * D, 2 * DFF, D, e1, lds));
    PHASE(6,
      EpiResLN e2; e2.xin = outp; e2.xout = outp; e2.xb = ab;
      e2.g = ((const float*)p.ln2g) + l * D; e2.b = ((const float*)p.ln2b) + l * D;
      e2.xchg = (float*)(ws + OFF_XCHG); e2.cnt = (unsigned*)(ws + OFF_CNT); e2.target = 4u * (unsigned)(2 * l + 2);
      gemm_phase((const bf16_t*)(ws + OFF_R1), DFF, (const bf16_t*)(ws + OFF_W2) + (size_t)l * D * DFF, D, DFF, e2, lds));
  }
#undef PHASE
}
constexpr int N_PHASES = 1 + 2 * 7 + 2 * 6;

extern "C" void kernel_launch(void* const* d_in, const int* in_sizes, int n_in, void* d_out, int out_size, void* d_ws, size_t ws_size, hipStream_t stream) {
  static bool attr = false;
  if (!attr) { hipFuncSetAttribute((const void*)fwd_mega, hipFuncAttributeMaxDynamicSharedMemorySize, LDS_BYTES); attr = true; }
  Params p{};
  p.x_in = (const GAS float*)d_in[0];
  p.even_w_in = (const GAS float*)d_in[1]; p.even_w_out = (const GAS float*)d_in[2]; p.lb_logits = (const GAS float*)d_in[3];
  p.lq1 = (const GAS float*)d_in[4]; p.lk1 = (const GAS float*)d_in[5]; p.lq2 = (const GAS float*)d_in[6]; p.lk2 = (const GAS float*)d_in[7];
  p.hgrn_g = (const GAS float*)d_in[8]; p.diff_g = (const GAS float*)d_in[9];
  p.fox_w_in = (const GAS float*)d_in[10]; p.fox_w_out = (const GAS float*)d_in[11]; p.fox_bf = (const GAS float*)d_in[12];
  p.fox_qg = (const GAS float*)d_in[13]; p.fox_kg = (const GAS float*)d_in[14];
  p.w1 = (const GAS float*)d_in[15]; p.w2 = (const GAS float*)d_in[16];
  p.ln1g = (const GAS float*)d_in[17]; p.ln1b = (const GAS float*)d_in[18]; p.ln2g = (const GAS float*)d_in[19]; p.ln2b = (const GAS float*)d_in[20];
  p.out = (GAS float*)d_out; p.ws = (GAS char*)d_ws;
#if COOP
  p.lo = 0; p.hi = N_PHASES;
  void* args[] = {&p};
  hipError_t e = hipLaunchCooperativeKernel((const void*)fwd_mega, dim3(256), dim3(512), args, LDS_BYTES, stream);
  if (e != hipSuccess) fprintf(stderr, "cooperative launch failed: %s\n", hipGetErrorString(e));
#else
  for (int ph = 0; ph < N_PHASES; ++ph) {
    p.lo = ph; p.hi = ph + 1;
    hipLaunchKernelGGL(fwd_mega, dim3(256), dim3(512), LDS_BYTES, stream, p);
  }
#endif
}
```

```cpp
#include <hip/hip_runtime.h>
#include <hip/hip_cooperative_groups.h>
#include <cstdio>
#include <cstdint>
namespace cg = cooperative_groups;

#ifndef COOP
#define COOP 1
#endif
#ifndef ONLY
#define ONLY -1
#endif
#ifndef DUPMASK
#define DUPMASK 0
#endif

typedef unsigned short bf16_t;
typedef short bf16x8 __attribute__((ext_vector_type(8)));
typedef float f32x16 __attribute__((ext_vector_type(16)));
typedef float f32x4 __attribute__((ext_vector_type(4)));
typedef float f32x2 __attribute__((ext_vector_type(2)));
typedef unsigned u32x4 __attribute__((ext_vector_type(4)));
typedef unsigned u32x2 __attribute__((ext_vector_type(2)));
typedef __bf16 bf16x2v __attribute__((ext_vector_type(2)));

#define DI __device__ __forceinline__
#define MFMA32(a, b, c) __builtin_amdgcn_mfma_f32_32x32x16_bf16((a), (b), (c), 0, 0, 0)

constexpr int D = 1024, SEQ = 16384, NTOK = 32768, DFF = 2816;
constexpr int EVEN_IN = 3584, ODD_IN = 4112, ODD_PAD = 4352;
constexpr float ALPHA = 1.6817928305074290f;
constexpr float LOG2E = 1.4426950408889634f;
constexpr size_t MiB = 1u << 20;

constexpr size_t OFF_WEI = 0;
constexpr size_t OFF_WEO = OFF_WEI + (size_t)2 * EVEN_IN * D * 2;
constexpr size_t OFF_WFI = OFF_WEO + (size_t)2 * D * D * 2;
constexpr size_t OFF_WFO = OFF_WFI + (size_t)2 * ODD_PAD * D * 2;
constexpr size_t OFF_W1  = OFF_WFO + (size_t)2 * D * D * 2;
constexpr size_t OFF_W2  = OFF_W1 + (size_t)4 * 2 * DFF * D * 2;
constexpr size_t W_END   = OFF_W2 + (size_t)4 * D * DFF * 2;
static_assert(W_END <= 105 * MiB, "weights region");
constexpr size_t OFF_R1 = 105 * MiB;
constexpr size_t OFF_AB = 361 * MiB;
constexpr size_t OFF_UT = 425 * MiB;
constexpr size_t OFF_DB = 489 * MiB;
constexpr size_t OFF_LF = 490 * MiB;
constexpr size_t OFF_C2 = 492 * MiB;
constexpr size_t OFF_MISC = 494 * MiB;
constexpr size_t OFF_CNT = OFF_MISC + 80 * 1024;
constexpr size_t OFF_XCHG = OFF_MISC + 128 * 1024;

#define GAS __attribute__((address_space(1)))
struct Params {
  const GAS float* x_in;
  const GAS float *even_w_in, *even_w_out, *lb_logits, *lq1, *lk1, *lq2, *lk2, *hgrn_g, *diff_g;
  const GAS float *fox_w_in, *fox_w_out, *fox_bf, *fox_qg, *fox_kg;
  const GAS float *w1, *w2, *ln1g, *ln1b, *ln2g, *ln2b;
  GAS float* out;
  GAS char* ws;
  int lo, hi;
};

DI unsigned pk2(float lo, float hi) { f32x2 v = {lo, hi}; bf16x2v b = __builtin_convertvector(v, bf16x2v); return __builtin_bit_cast(unsigned, b); }
DI bf16_t f2bf(float x) { return (bf16_t)(pk2(x, 0.f) & 0xffffu); }
DI float bf2f(bf16_t v) { return __uint_as_float(((unsigned)v) << 16); }
DI float sigmoidf_(float x) { return __builtin_amdgcn_rcpf(1.f + __builtin_amdgcn_exp2f(-LOG2E * x)); }
DI float siluf_(float x) { return x * __builtin_amdgcn_rcpf(1.f + __builtin_amdgcn_exp2f(-LOG2E * x)); }
DI GAS char* launder(GAS char* q) { asm volatile("" : "+s"(q)); return q; }
DI int tid_l() { int t = threadIdx.x; asm volatile("" : "+v"(t)); return t; }
DI int swz32(int s) { return (s & ~12) | ((s & 4) << 1) | ((s & 8) >> 1); }
DI float xsum32(float v) { const u32x2 r_ = __builtin_amdgcn_permlane32_swap(__float_as_uint(v), __float_as_uint(v), false, false); return __uint_as_float(r_[0]) + __uint_as_float(r_[1]); }
DI float xmax32(float v) { const u32x2 r_ = __builtin_amdgcn_permlane32_swap(__float_as_uint(v), __float_as_uint(v), false, false); return fmaxf(__uint_as_float(r_[0]), __uint_as_float(r_[1])); }

DI void convert_w(const float* __restrict__ w, bf16_t* __restrict__ wt, int K, int N, int Npad, int mode, float* tl) {
  const int tid = tid_l();
  const int nkt = K >> 6, nnt = Npad >> 6;
  for (int tile = blockIdx.x; tile < nkt * nnt; tile += gridDim.x) {
    const int k0 = (tile / nnt) << 6, n0 = (tile % nnt) << 6;
#pragma unroll
    for (int i = 0; i < 2; ++i) {
      const int kk = (tid >> 4) + 32 * i, n4 = (tid & 15) << 2;
      const int np = n0 + n4;
      int src = np;
      if (mode == 1) { const int grp = np >> 6, j = np & 63; src = (j < 32) ? grp * 32 + j : DFF + grp * 32 + (j - 32); }
      f32x4 v = {0.f, 0.f, 0.f, 0.f};
      if (src < N) v = *(const f32x4*)(w + (size_t)(k0 + kk) * N + src);
      tl[kk * 65 + n4 + 0] = v[0]; tl[kk * 65 + n4 + 1] = v[1]; tl[kk * 65 + n4 + 2] = v[2]; tl[kk * 65 + n4 + 3] = v[3];
    }
    __syncthreads();
    {
      const int n = tid >> 3, kc = (tid & 7) << 3;
      float f[8];
#pragma unroll
      for (int j = 0; j < 8; ++j) f[j] = tl[(kc + j) * 65 + n];
      u32x4 o = {pk2(f[0], f[1]), pk2(f[2], f[3]), pk2(f[4], f[5]), pk2(f[6], f[7])};
      *(u32x4*)(wt + (size_t)(n0 + n) * K + k0 + kc) = o;
    }
    __syncthreads();
  }
}

DI void phase0(const Params& p, char* lds) {
  float* tl = (float*)lds;
  char* ws = (char*)launder(p.ws);
  for (int j = 0; j < 2; ++j) {
    convert_w(((const float*)p.even_w_in) + (size_t)j * D * EVEN_IN, (bf16_t*)(ws + OFF_WEI) + (size_t)j * EVEN_IN * D, D, EVEN_IN, EVEN_IN, 0, tl);
    convert_w(((const float*)p.even_w_out) + (size_t)j * D * D, (bf16_t*)(ws + OFF_WEO) + (size_t)j * D * D, D, D, D, 0, tl);
    convert_w(((const float*)p.fox_w_in) + (size_t)j * D * ODD_IN, (bf16_t*)(ws + OFF_WFI) + (size_t)j * ODD_PAD * D, D, ODD_IN, ODD_PAD, 0, tl);
    convert_w(((const float*)p.fox_w_out) + (size_t)j * D * D, (bf16_t*)(ws + OFF_WFO) + (size_t)j * D * D, D, D, D, 0, tl);
  }
  for (int l = 0; l < 4; ++l) {
    convert_w(((const float*)p.w1) + (size_t)l * D * 2 * DFF, (bf16_t*)(ws + OFF_W1) + (size_t)l * 2 * DFF * D, D, 2 * DFF, 2 * DFF, 1, tl);
    convert_w(((const float*)p.w2) + (size_t)l * DFF * D, (bf16_t*)(ws + OFF_W2) + (size_t)l * D * DFF, DFF, D, D, 0, tl);
  }
  {
    bf16_t* ab = (bf16_t*)(ws + OFF_AB);
    const size_t n8 = (size_t)NTOK * D / 8;
    for (size_t i = (size_t)blockIdx.x * 512 + tid_l(); i < n8; i += (size_t)gridDim.x * 512) {
      f32x4 a = *(const f32x4*)(((const float*)p.x_in) + i * 8), b = *(const f32x4*)(((const float*)p.x_in) + i * 8 + 4);
      u32x4 o = {pk2(a[0], a[1]), pk2(a[2], a[3]), pk2(b[0], b[1]), pk2(b[2], b[3])};
      *(u32x4*)(ab + i * 8) = o;
    }
  }
  if (blockIdx.x == 0) { const int t_ = tid_l(); if (t_ < 128) ((unsigned*)(ws + OFF_CNT))[t_] = 0u; if (t_ == 128) ((unsigned*)(ws + OFF_CNT))[256] = 0u; }
  if (blockIdx.x == 0) {
    float* misc = (float*)(ws + OFF_MISC);
    const int tid = tid_l();
    {
      const float l0 = ((const float*)p.lb_logits)[tid], l1 = ((const float*)p.lb_logits)[512 + tid];
      const float mx = fmaxf(l0, l1);
      const float e0 = expf(l0 - mx), e1 = expf(l1 - mx);
      const float s0 = e0 / (e0 + e1), s1 = e1 / (e0 + e1);
      misc[tid] = s0 - s0;
      misc[512 + tid] = (s0 + s1) - s0;
    }
    if (tid < 2) {
      float d1 = 0.f, d2 = 0.f;
      for (int i = 0; i < 64; ++i) { d1 += ((const float*)p.lq1)[tid * 64 + i] * ((const float*)p.lk1)[tid * 64 + i]; d2 += ((const float*)p.lq2)[tid * 64 + i] * ((const float*)p.lk2)[tid * 64 + i]; }
      const float lam_init = 0.8f - 0.6f * expf(-0.3f * (float)(2 * tid));
      misc[1024 + tid] = expf(d1) - expf(d2) + lam_init;
      float mq = 0.f, mk = 0.f;
      for (int i = 0; i < 64; ++i) { mq = fmaxf(mq, fabsf(((const float*)p.fox_qg)[tid * 64 + i])); mk = fmaxf(mk, fabsf(((const float*)p.fox_kg)[tid * 64 + i])); }
      const float B = 0.125f * LOG2E * 64.f * mq * mk * 1.02f;
      misc[1032 + tid] = 2.f * B + 8.f;
    }
  }
}

constexpr int LROW = 144;
constexpr int G_XB = 256 * LROW, G_WB = 256 * LROW, G_STAGE = G_XB + G_WB;
constexpr int DIFF_STASH_OFF = 2 * (64 * LROW + 128 * LROW + 256);
constexpr int LDS_BYTES = 2 * G_STAGE;
static_assert(LDS_BYTES >= DIFF_STASH_OFF + 512 * 32 * 4, "lds");

template <class Epi>
DI void gemm_phase(const bf16_t* __restrict__ X, const int ldx, const bf16_t* __restrict__ Wt, const int N, const int K, const Epi& epi, char* lds) {
  const int tid = tid_l(), lane = tid & 63, wave = tid >> 6;
  const int r = lane & 31, hh = lane >> 5;
  const int tw = wave & 3, fw = wave >> 2;
  const int nNt = N >> 8;
  const int ntiles = nNt * (NTOK / 256);
  const int nk = K >> 6;
  const int lrow = tid >> 3, lch = tid & 7;
  const int xcd = blockIdx.x & 7, slot = blockIdx.x >> 3, nchunks = 4 * nNt;
  (void)ntiles;
  u32x4 xr0[4], wr0[4];
  for (int chunk = xcd; chunk < nchunks; chunk += 8) {
    const int L = chunk * 32 + slot, band = L / (4 * nNt), rem = L % (4 * nNt);
    const int mt_ = band * 4 + (rem & 3), nt_ = rem >> 2;
    const char* Xt = (const char*)(X + (size_t)(mt_ * 256) * ldx);
    const char* Wtb = (const char*)(Wt + (size_t)(nt_ * 256) * K);
    const unsigned xoff = (unsigned)(lrow * ldx + lch * 8) * 2u, woff = (unsigned)(lrow * K + lch * 8) * 2u;
    const bool has_next = !Epi::kFull && (chunk + 8 < nchunks);
    const int Ln = (has_next ? chunk + 8 : chunk) * 32 + slot, band_n = Ln / (4 * nNt), rem_n = Ln % (4 * nNt);
    const char* Xt_n = (const char*)(X + (size_t)((band_n * 4 + (rem_n & 3)) * 256) * ldx);
    const char* Wtb_n = (const char*)(Wt + (size_t)((rem_n >> 2) * 256) * K);
    f32x16 acc[2][2][2];
#define G_GLOAD(XR, WR, KT) { _Pragma("unroll") for (int i_ = 0; i_ < 4; ++i_) XR[i_] = *(const u32x4*)(Xt + ((size_t)(64 * i_) * ldx + (KT) * 64) * 2 + xoff); \
    _Pragma("unroll") for (int i_ = 0; i_ < 4; ++i_) WR[i_] = *(const u32x4*)(Wtb + ((size_t)(64 * i_) * K + (KT) * 64) * 2 + woff); }
#define G_LSTORE(XR, WR, STG) { char* xs_ = lds + (STG) * G_STAGE; char* ws_ = xs_ + G_XB; \
    _Pragma("unroll") for (int i_ = 0; i_ < 4; ++i_) *(u32x4*)(xs_ + (lrow + 64 * i_) * LROW + lch * 16) = XR[i_]; \
    _Pragma("unroll") for (int i_ = 0; i_ < 4; ++i_) *(u32x4*)(ws_ + (lrow + 64 * i_) * LROW + lch * 16) = WR[i_]; }
#define G_PART(Q, STG, KT, DOLOAD) { char* xs_ = lds + (STG) * G_STAGE; char* ws_ = xs_ + G_XB; \
    if ((Q) < 2) { _Pragma("unroll") for (int i_ = 2 * (Q); i_ < 2 * (Q) + 2; ++i_) { *(u32x4*)(xs_ + (lrow + 64 * i_) * LROW + lch * 16) = xr0[i_]; \
        if (DOLOAD) xr0[i_] = *(const u32x4*)(xb_ + ((size_t)(64 * i_) * ldx + (KT) * 64) * 2 + xoff); } } \
    else { _Pragma("unroll") for (int i_ = 2 * ((Q) - 2); i_ < 2 * ((Q) - 2) + 2; ++i_) { *(u32x4*)(ws_ + (lrow + 64 * i_) * LROW + lch * 16) = wr0[i_]; \
        if (DOLOAD) wr0[i_] = *(const u32x4*)(wb_ + ((size_t)(64 * i_) * K + (KT) * 64) * 2 + woff); } } \
    __builtin_amdgcn_sched_barrier(0); }
#define G_LDX(XF, KS) { _Pragma("unroll") for (int m = 0; m < 2; ++m) XF[m] = *(const bf16x8*)(xs + (tw * 64 + m * 32 + r) * LROW + (KS) * 32 + hh * 16); }
#define G_LDW(WF, N0, KS) { _Pragma("unroll") for (int n = 0; n < 2; ++n) WF[n] = *(const bf16x8*)(wsm + (fw * 128 + ((N0) + n) * 32 + r) * LROW + (KS) * 32 + hh * 16); }
#define G_MFMA4S(XF, WF, H) { _Pragma("unroll") for (int n = 0; n < 2; ++n) _Pragma("unroll") for (int m = 0; m < 2; ++m) acc[H][n][m] = MFMA32(XF[m], WF[n], acc[H][n][m]); }
#define G_MFMA4(XF, WF, H) { _Pragma("unroll") for (int n = 0; n < 2; ++n) _Pragma("unroll") for (int m = 0; m < 2; ++m) acc[H][n][m] = MFMA32(WF[n], XF[m], acc[H][n][m]); }
#define G_STEP(MM, KS, XC, XN) { G_LDW(wc, 2, KS); if ((KS) < 3) { G_LDX(XN, (KS) + 1); } __builtin_amdgcn_sched_barrier(0); \
    MM(XC, w01, 0); __builtin_amdgcn_sched_barrier(0); if ((KS) < 3) { G_LDW(w01, 0, (KS) + 1); } MM(XC, wc, 1); __builtin_amdgcn_sched_barrier(0); }
#define G_COMPUTE_ST(MM, STG, DOSTORE, NSTG, KTL, DOLOAD) { const char* xs = lds + (STG) * G_STAGE; const char* wsm = xs + G_XB; \
    bf16x8 xfa[2], xfb[2], w01[2], wc[2]; \
    G_LDX(xfa, 0); G_LDW(w01, 0, 0); \
    G_STEP(MM, 0, xfa, xfb); if (DOSTORE) { G_PART(0, NSTG, KTL, DOLOAD); G_PART(1, NSTG, KTL, DOLOAD); } \
    G_STEP(MM, 1, xfb, xfa); if (DOSTORE) G_PART(2, NSTG, KTL, DOLOAD); \
    G_STEP(MM, 2, xfa, xfb); if (DOSTORE) G_PART(3, NSTG, KTL, DOLOAD); \
    G_STEP(MM, 3, xfb, xfa); }
#define G_COMPUTE(MM, STG) { const char* xs = lds + (STG) * G_STAGE; const char* wsm = xs + G_XB; \
    bf16x8 xfa[2], xfb[2], w01[2], wc[2]; \
    G_LDX(xfa, 0); G_LDW(w01, 0, 0); \
    G_STEP(MM, 0, xfa, xfb); G_STEP(MM, 1, xfb, xfa); G_STEP(MM, 2, xfa, xfb); G_STEP(MM, 3, xfb, xfa); }
    asm volatile("" ::: "memory");
    if (Epi::kFull || chunk == xcd) {
      G_GLOAD(xr0, wr0, 0);
      G_LSTORE(xr0, wr0, 0);
      __syncthreads();
      G_GLOAD(xr0, wr0, 1);
    }
#pragma unroll
    for (int c = 0; c < 2; ++c)
#pragma unroll
      for (int a = 0; a < 2; ++a)
#pragma unroll
        for (int b = 0; b < 2; ++b)
#pragma unroll
          for (int i = 0; i < 16; ++i) acc[c][a][b][i] = 0.f;
#define G_KLOOP(MM) for (int kt = 0; kt < nk; kt += 2) { \
        \
        \
      { const bool in_ = (kt + 2 < nk); const char* xb_ = in_ ? Xt : Xt_n; const char* wb_ = in_ ? Wtb : Wtb_n; \
        const int k2_ = in_ ? kt + 2 : (has_next ? 0 : nk - 1); G_COMPUTE_ST(MM, 0, true, 1, k2_, true); } \
      __syncthreads(); \
      { const bool in_ = (kt + 3 < nk); const char* xb_ = in_ ? Xt : Xt_n; const char* wb_ = in_ ? Wtb : Wtb_n; \
        const int k3_ = in_ ? kt + 3 : (has_next ? 1 : nk - 1); G_COMPUTE_ST(MM, 1, true, 0, k3_, true); } \
      __syncthreads(); \
    }
    const bool sw = Epi::kSwap && epi.swap_tile(nt_);
#define G_EPI_IDS const int t2 = tid_l(); const int r2 = t2 & 31, hh2 = (t2 >> 5) & 1, tw2 = (t2 >> 6) & 3, fw2 = t2 >> 8;
    if (sw) {
      G_KLOOP(G_MFMA4S)
      if constexpr (Epi::kSwap) {
        G_EPI_IDS
        epi.swapped(mt_ * 256 + tw2 * 64, nt_ * 256 + fw2 * 128, acc[0], r2, hh2);
        __builtin_amdgcn_sched_barrier(0);
        epi.swapped(mt_ * 256 + tw2 * 64, nt_ * 256 + fw2 * 128 + 64, acc[1], r2, hh2);
      }
    } else {
      G_KLOOP(G_MFMA4)
      G_EPI_IDS
      if constexpr (Epi::kFull) {
        epi.full(mt_, nt_, acc, tw2, fw2, r2, hh2, lds, t2);
      } else {
        epi(mt_ * 256 + tw2 * 64, nt_ * 256 + fw2 * 128, acc[0], r2, hh2);
        __builtin_amdgcn_sched_barrier(0);
        epi(mt_ * 256 + tw2 * 64, nt_ * 256 + fw2 * 128 + 64, acc[1], r2, hh2);
      }
    }
#undef G_EPI_IDS
#undef G_KLOOP
#undef G_GLOAD
#undef G_LSTORE
#undef G_COMPUTE
#undef G_PART
#undef G_COMPUTE_ST
#undef G_LDX
#undef G_LDW
#undef G_MFMA4
#undef G_MFMA4S
#undef G_STEP
    __builtin_amdgcn_sched_barrier(0);
  }
}

struct EpiEvenIn {
  static constexpr bool kFull = false, kSwap = false;
  DI bool swap_tile(int nt_) const { const int seg = nt_ >> 1; return seg == 2 || seg == 6; }
  char* r1; const float* lb;
#define aq  ((bf16_t*)(r1))
#define alf ((float*)(r1 + 32 * MiB))
#define aiT ((bf16_t*)(r1 + 96 * MiB))
#define ag  ((bf16_t*)(r1 + 128 * MiB))
#define bq  ((bf16_t*)(r1 + 160 * MiB))
#define bk  ((bf16_t*)(r1 + 192 * MiB))
#define bvT ((bf16_t*)(r1 + 224 * MiB))
  DI void operator()(int tok0, int feat0, f32x16 (&acc)[2][2], int r, int hh) const {
    const int seg = feat0 >> 9, c0 = feat0 & 511;
#pragma unroll
    for (int mt = 0; mt < 2; ++mt) {
      const int tok = tok0 + mt * 32 + r, b = tok >> 14, s = tok & (SEQ - 1);
#pragma unroll
      for (int nt = 0; nt < 2; ++nt)
#pragma unroll
        for (int g = 0; g < 4; ++g) {
          const int c = c0 + nt * 32 + 8 * g + 4 * hh;
          const float v0 = acc[nt][mt][4 * g], v1 = acc[nt][mt][4 * g + 1], v2 = acc[nt][mt][4 * g + 2], v3 = acc[nt][mt][4 * g + 3];
          if (seg == 0) { u32x2 o = {pk2(siluf_(v0), siluf_(v1)), pk2(siluf_(v2), siluf_(v3))}; *(u32x2*)(aq + (size_t)tok * 512 + c) = o; }
          else if (seg == 1) {
            f32x4 lbv = *(const f32x4*)(lb + c);
            f32x4 o;
            o[0] = __logf(lbv[0] + (1.f - lbv[0]) * sigmoidf_(v0)); o[1] = __logf(lbv[1] + (1.f - lbv[1]) * sigmoidf_(v1));
            o[2] = __logf(lbv[2] + (1.f - lbv[2]) * sigmoidf_(v2)); o[3] = __logf(lbv[3] + (1.f - lbv[3]) * sigmoidf_(v3));
            *(f32x4*)(alf + (size_t)tok * 512 + c) = o;
          }
          else if (seg == 3) { u32x2 o = {pk2(siluf_(v0), siluf_(v1)), pk2(siluf_(v2), siluf_(v3))}; *(u32x2*)(ag + (size_t)tok * 512 + c) = o; }
          else if (seg == 4) { const float sc = 0.125f * LOG2E; u32x2 o = {pk2(v0 * sc, v1 * sc), pk2(v2 * sc, v3 * sc)}; *(u32x2*)(bq + (size_t)tok * 512 + c) = o; }
          else if (seg == 5) { u32x2 o = {pk2(v0, v1), pk2(v2, v3)}; *(u32x2*)(bk + (size_t)tok * 512 + c) = o; }
          else if (seg == 2) {
            bf16_t* dst = aiT + ((size_t)((b * 4 + (c >> 7)) * 128 + (c & 127))) * SEQ + s;
            dst[0] = f2bf(v0); dst[SEQ] = f2bf(v1); dst[2 * SEQ] = f2bf(v2); dst[3 * SEQ] = f2bf(v3);
          }
          else if (seg == 6) {
            bf16_t* dst = bvT + ((size_t)((b * 4 + (c >> 7)) * 128 + (c & 127))) * SEQ + swz32(s);
            dst[0] = f2bf(v0); dst[SEQ] = f2bf(v1); dst[2 * SEQ] = f2bf(v2); dst[3 * SEQ] = f2bf(v3);
          }
          __builtin_amdgcn_sched_barrier(0);
        }
    }
  }
  DI void swapped(int tok0, int feat0, f32x16 (&acc)[2][2], int r, int hh) const {
    const int seg = feat0 >> 9, c0 = feat0 & 511;
#pragma unroll
    for (int nt = 0; nt < 2; ++nt) {
      const int c = c0 + nt * 32 + r;
#pragma unroll
      for (int mt = 0; mt < 2; ++mt)
#pragma unroll
        for (int g = 0; g < 4; ++g) {
          const int tok = tok0 + mt * 32 + 8 * g + 4 * hh, b = tok >> 14, s = tok & (SEQ - 1);
          u32x2 o = {pk2(acc[nt][mt][4 * g], acc[nt][mt][4 * g + 1]), pk2(acc[nt][mt][4 * g + 2], acc[nt][mt][4 * g + 3])};
          bf16_t* base = (seg == 2 ? aiT : bvT) + ((size_t)((b * 4 + (c >> 7)) * 128 + (c & 127))) * SEQ;
          *(u32x2*)(base + (seg == 2 ? s : swz32(s))) = o;
        }
    }
  }
};

#undef aq
#undef alf
#undef aiT
#undef ag
#undef bq
#undef bk
#undef bvT
struct EpiOddIn {
  static constexpr bool kFull = false, kSwap = false;
  DI bool swap_tile(int nt_) const { return (nt_ >> 2) == 2; }
  char* r1; float* lf; const float *qg, *kg, *bf;
#define fq  ((bf16_t*)(r1))
#define fk  ((bf16_t*)(r1 + 64 * MiB))
#define fvT ((bf16_t*)(r1 + 128 * MiB))
#define fg  ((bf16_t*)(r1 + 192 * MiB))
  DI void operator()(int tok0, int feat0, f32x16 (&acc)[2][2], int r, int hh) const {
    const int seg = feat0 >> 10, c0 = feat0 & 1023;
#pragma unroll
    for (int mt = 0; mt < 2; ++mt) {
      const int tok = tok0 + mt * 32 + r, b = tok >> 14, s = tok & (SEQ - 1);
      if (seg < 2) {
        float ssq = 0.f;
#pragma unroll
        for (int nt = 0; nt < 2; ++nt)
#pragma unroll
          for (int i = 0; i < 16; ++i) ssq += acc[nt][mt][i] * acc[nt][mt][i];
        ssq = xsum32(ssq);
        float rs = rsqrtf(ssq * (1.f / 64.f) + 1e-6f);
        if (seg == 0) rs *= 0.125f * LOG2E;
        const float* gg = seg == 0 ? qg : kg;
        bf16_t* dstb = (seg == 0 ? fq : fk) + (size_t)tok * 1024 + c0;
#pragma unroll
        for (int nt = 0; nt < 2; ++nt)
#pragma unroll
          for (int g = 0; g < 4; ++g) {
            const int d = nt * 32 + 8 * g + 4 * hh;
            f32x4 gv = *(const f32x4*)(gg + d);
            u32x2 o = {pk2(acc[nt][mt][4 * g] * rs * gv[0], acc[nt][mt][4 * g + 1] * rs * gv[1]), pk2(acc[nt][mt][4 * g + 2] * rs * gv[2], acc[nt][mt][4 * g + 3] * rs * gv[3])};
            *(u32x2*)(dstb + d) = o;
            __builtin_amdgcn_sched_barrier(0);
          }
      } else if (seg == 2) {
        const int head = c0 >> 6;
#pragma unroll
        for (int nt = 0; nt < 2; ++nt)
#pragma unroll
          for (int g = 0; g < 4; ++g) {
            const int d = nt * 32 + 8 * g + 4 * hh;
            bf16_t* dst = fvT + ((size_t)((b * 16 + head) * 64 + d)) * SEQ + swz32(s);
            dst[0] = f2bf(acc[nt][mt][4 * g]); dst[SEQ] = f2bf(acc[nt][mt][4 * g + 1]); dst[2 * SEQ] = f2bf(acc[nt][mt][4 * g + 2]); dst[3 * SEQ] = f2bf(acc[nt][mt][4 * g + 3]);
          }
      } else if (seg == 3) {
#pragma unroll
        for (int nt = 0; nt < 2; ++nt)
#pragma unroll
          for (int g = 0; g < 4; ++g) {
            const int c = c0 + nt * 32 + 8 * g + 4 * hh;
            u32x2 o = {pk2(sigmoidf_(acc[nt][mt][4 * g]), sigmoidf_(acc[nt][mt][4 * g + 1])), pk2(sigmoidf_(acc[nt][mt][4 * g + 2]), sigmoidf_(acc[nt][mt][4 * g + 3]))};
            *(u32x2*)(fg + (size_t)tok * 1024 + c) = o;
            __builtin_amdgcn_sched_barrier(0);
          }
      } else if (feat0 == 4096) {
#pragma unroll
        for (int g = 0; g < 2; ++g)
#pragma unroll
          for (int j = 0; j < 4; ++j) {
            const int hd = 8 * g + 4 * hh + j;
            const float xv = acc[0][mt][4 * g + j] + bf[hd];
            const float ls = fminf(xv, 0.f) - log1pf(expf(-fabsf(xv)));
            lf[((size_t)(b * 16 + hd)) * SEQ + s] = ls;
          }
      }
    }
  }
  DI void swapped(int tok0, int feat0, f32x16 (&acc)[2][2], int r, int hh) const {
    const int head = (feat0 & 1023) >> 6;
#pragma unroll
    for (int nt = 0; nt < 2; ++nt) {
      const int d = nt * 32 + r;
#pragma unroll
      for (int mt = 0; mt < 2; ++mt)
#pragma unroll
        for (int g = 0; g < 4; ++g) {
          const int tok = tok0 + mt * 32 + 8 * g + 4 * hh, b = tok >> 14, s = tok & (SEQ - 1);
          u32x2 o = {pk2(acc[nt][mt][4 * g], acc[nt][mt][4 * g + 1]), pk2(acc[nt][mt][4 * g + 2], acc[nt][mt][4 * g + 3])};
          *(u32x2*)(fvT + ((size_t)((b * 16 + head) * 64 + d)) * SEQ + swz32(s)) = o;
        }
    }
  }
};

#undef fq
#undef fk
#undef fvT
#undef fg
struct EpiRes {
  static constexpr bool kFull = false;
  const float* xin; float* y;
  DI void operator()(int tok0, int feat0, f32x16 (&acc)[2][2], int r, int hh) const {
#pragma unroll
    for (int mt = 0; mt < 2; ++mt) {
      const size_t rowo = (size_t)(tok0 + mt * 32 + r) * 1024;
#pragma unroll
      for (int nt = 0; nt < 2; ++nt)
#pragma unroll
        for (int g = 0; g < 4; ++g) {
          const int c = feat0 + nt * 32 + 8 * g + 4 * hh;
          f32x4 xv = *(const f32x4*)(xin + rowo + c);
          f32x4 o = {ALPHA * xv[0] + acc[nt][mt][4 * g], ALPHA * xv[1] + acc[nt][mt][4 * g + 1], ALPHA * xv[2] + acc[nt][mt][4 * g + 2], ALPHA * xv[3] + acc[nt][mt][4 * g + 3]};
          *(f32x4*)(y + rowo + c) = o;
          if (g & 1) __builtin_amdgcn_sched_barrier(0);
        }
    }
  }
};

struct EpiResLN {
  static constexpr bool kFull = true, kSwap = false;
  DI bool swap_tile(int) const { return false; }
  const float* xin; float* xout; bf16_t* xb; const float *g, *b; float* xchg; unsigned* cnt; unsigned target;
  DI void full(const int mt_, const int nt_, f32x16 (&acc)[2][2][2], const int tw, const int fw, const int r, const int hh, char* lds, const int tid) const {
    float* part = (float*)(lds + G_STAGE);
    const size_t rbase = (size_t)(mt_ * 256 + tw * 64 + r) * 1024 + nt_ * 256 + fw * 128 + 4 * hh;
    f32x4 xa[4], xc[4], xe[4];
#define RL_LOAD(XV, G) { constexpr int mt__ = (G) >> 2, half__ = ((G) >> 1) & 1, nt__ = (G) & 1; \
    _Pragma("unroll") for (int gq = 0; gq < 4; ++gq) XV[gq] = *(const f32x4*)(xin + rbase + (size_t)mt__ * 32 * 1024 + half__ * 64 + nt__ * 32 + 8 * gq); }
#define RL_FOLD(XV, G, SM, SQ) { constexpr int mt__ = (G) >> 2, half__ = ((G) >> 1) & 1, nt__ = (G) & 1; \
    _Pragma("unroll") for (int gq = 0; gq < 4; ++gq) _Pragma("unroll") for (int jj = 0; jj < 4; ++jj) { \
      const float y = ALPHA * XV[gq][jj] + acc[half__][nt__][mt__][4 * gq + jj]; acc[half__][nt__][mt__][4 * gq + jj] = y; SM += y; SQ += y * y; } }
#define SB __builtin_amdgcn_sched_barrier(0)
    float sm0 = 0.f, sq0 = 0.f, sm1 = 0.f, sq1 = 0.f;
    RL_LOAD(xa, 0); RL_LOAD(xc, 1); RL_LOAD(xe, 2); SB;
    RL_FOLD(xa, 0, sm0, sq0); SB; RL_LOAD(xa, 3); SB;
    RL_FOLD(xc, 1, sm0, sq0); SB; RL_LOAD(xc, 4); SB;
    RL_FOLD(xe, 2, sm0, sq0); SB; RL_LOAD(xe, 5); SB;
    RL_FOLD(xa, 3, sm0, sq0); SB; RL_LOAD(xa, 6); SB;
    RL_FOLD(xc, 4, sm1, sq1); SB; RL_LOAD(xc, 7); SB;
    RL_FOLD(xe, 5, sm1, sq1); SB;
    RL_FOLD(xa, 6, sm1, sq1); SB;
    RL_FOLD(xc, 7, sm1, sq1);
#undef SB
#undef RL_LOAD
#undef RL_FOLD
    sm0 += __shfl_xor(sm0, 32, 64); sq0 += __shfl_xor(sq0, 32, 64); sm1 += __shfl_xor(sm1, 32, 64); sq1 += __shfl_xor(sq1, 32, 64);
    if (hh == 0) {
      float* pp = part + ((fw * 256) + tw * 64 + r) * 2; pp[0] = sm0; pp[1] = sq0;
      pp[64] = sm1; pp[65] = sq1;
    }
    __syncthreads();
    if (tid < 256) {
      f32x2 a = *(const f32x2*)(part + tid * 2), c = *(const f32x2*)(part + (256 + tid) * 2);
      const unsigned long long pk = ((unsigned long long)__float_as_uint(a[1] + c[1]) << 32) | (unsigned long long)__float_as_uint(a[0] + c[0]);
      __hip_atomic_store((GAS unsigned long long*)(xchg + ((size_t)(mt_ * 4 + nt_) * 256 + tid) * 2), pk, __ATOMIC_RELAXED, __HIP_MEMORY_SCOPE_AGENT);
    }
    asm volatile("s_waitcnt vmcnt(0)" ::: "memory");
    __syncthreads();
    if (tid == 0) {
      __hip_atomic_fetch_add((GAS unsigned*)(cnt + mt_), 1u, __ATOMIC_RELAXED, __HIP_MEMORY_SCOPE_AGENT);
      while (__hip_atomic_load((GAS unsigned*)(cnt + mt_), __ATOMIC_RELAXED, __HIP_MEMORY_SCOPE_AGENT) < target) __builtin_amdgcn_s_sleep(1);
    }
    __syncthreads();
#pragma unroll
    for (int mt = 0; mt < 2; ++mt) {
      const int tl = tw * 64 + mt * 32 + r;
      float S = 0.f, Q = 0.f;
#pragma unroll
      for (int k = 0; k < 4; ++k) {
        const unsigned long long pk = __hip_atomic_load((GAS unsigned long long*)(xchg + ((size_t)(mt_ * 4 + k) * 256 + tl) * 2), __ATOMIC_RELAXED, __HIP_MEMORY_SCOPE_AGENT);
        S += __uint_as_float((unsigned)pk);
        Q += __uint_as_float((unsigned)(pk >> 32));
      }
      const float mean = S * (1.f / 1024.f);
      const float rstd = rsqrtf(fmaxf(Q * (1.f / 1024.f) - mean * mean, 0.f) + 1e-5f);
      const int c0 = nt_ * 256 + fw * 128 + 4 * hh;
      const size_t rowo = (size_t)(mt_ * 256 + tl) * 1024 + c0;
#pragma unroll
      for (int half = 0; half < 2; ++half)
#pragma unroll
        for (int nt = 0; nt < 2; ++nt) {
#pragma unroll
          for (int gq = 0; gq < 4; ++gq) {
            const int co = half * 64 + nt * 32 + 8 * gq;
            f32x4 gv = *(const f32x4*)(g + c0 + co), bv = *(const f32x4*)(b + c0 + co), o;
#pragma unroll
            for (int jj = 0; jj < 4; ++jj) o[jj] = (acc[half][nt][mt][4 * gq + jj] - mean) * rstd * gv[jj] + bv[jj];
            *(f32x4*)(xout + rowo + co) = o;
            u32x2 ob = {pk2(o[0], o[1]), pk2(o[2], o[3])};
            *(u32x2*)(xb + rowo + co) = ob;
          }
          __builtin_amdgcn_sched_barrier(0);
        }
    }
    __syncthreads();
  }
};

struct EpiW1 {
  static constexpr bool kFull = false, kSwap = false;
  DI bool swap_tile(int) const { return false; }
  DI void swapped(int, int, f32x16 (&)[2][2], int, int) const {}
  bf16_t* act;
  DI void operator()(int tok0, int feat0, f32x16 (&acc)[2][2], int r, int hh) const {
    const int u0 = (feat0 >> 6) * 32;
#pragma unroll
    for (int mt = 0; mt < 2; ++mt) {
      bf16_t* dst = act + (size_t)(tok0 + mt * 32 + r) * DFF + u0 + 4 * hh;
#pragma unroll
      for (int g = 0; g < 4; ++g) {
        u32x2 o = {pk2(siluf_(acc[0][mt][4 * g]) * acc[1][mt][4 * g], siluf_(acc[0][mt][4 * g + 1]) * acc[1][mt][4 * g + 1]),
                   pk2(siluf_(acc[0][mt][4 * g + 2]) * acc[1][mt][4 * g + 2], siluf_(acc[0][mt][4 * g + 3]) * acc[1][mt][4 * g + 3])};
        *(u32x2*)(dst + 8 * g) = o;
      }
    }
  }
};

DI float wave_sum(float v) {
#pragma unroll
  for (int o = 32; o >= 1; o >>= 1) v += __shfl_xor(v, o, 64);
  return v;
}
DI void ln_phase(float* x, bf16_t* xb, const float* __restrict__ g, const float* __restrict__ bta) {
  const int tid = tid_l(); const int lane = tid & 63, wave = tid >> 6;
  for (int row = blockIdx.x * 8 + wave; row < NTOK; row += gridDim.x * 8) {
    float* xr = x + (size_t)row * 1024;
    f32x4 v[4];
    float s = 0.f;
#pragma unroll
    for (int i = 0; i < 4; ++i) { v[i] = *(const f32x4*)(xr + (i * 64 + lane) * 4); s += v[i][0] + v[i][1] + v[i][2] + v[i][3]; }
    const float mean = wave_sum(s) * (1.f / 1024.f);
    float q = 0.f;
#pragma unroll
    for (int i = 0; i < 4; ++i)
#pragma unroll
      for (int j = 0; j < 4; ++j) { const float d = v[i][j] - mean; q += d * d; }
    const float rstd = rsqrtf(wave_sum(q) * (1.f / 1024.f) + 1e-5f);
#pragma unroll
    for (int i = 0; i < 4; ++i) {
      const int c = (i * 64 + lane) * 4;
      f32x4 gv = *(const f32x4*)(g + c), bv = *(const f32x4*)(bta + c), o;
#pragma unroll
      for (int j = 0; j < 4; ++j) o[j] = (v[i][j] - mean) * rstd * gv[j] + bv[j];
      *(f32x4*)(xr + c) = o;
      u32x2 ob = {pk2(o[0], o[1]), pk2(o[2], o[3])};
      *(u32x2*)(xb + (size_t)row * 1024 + c) = ob;
    }
  }
}

DI void cumsum_phase(const float* __restrict__ lf, float* __restrict__ c2, char* lds) {
  float* wt = (float*)lds;
  const int tid = tid_l(), lane = tid & 63, wave = tid >> 6;
  for (int row = blockIdx.x; row < 32; row += gridDim.x) {
    const float* src = lf + (size_t)row * SEQ + tid * 32;
    float v[32];
#pragma unroll
    for (int i = 0; i < 8; ++i) { f32x4 t = *(const f32x4*)(src + 4 * i); v[4 * i] = t[0]; v[4 * i + 1] = t[1]; v[4 * i + 2] = t[2]; v[4 * i + 3] = t[3]; }
    float run = 0.f;
#pragma unroll
    for (int i = 0; i < 32; ++i) { run += v[i]; v[i] = run; }
    float inc = run;
#pragma unroll
    for (int o = 1; o < 64; o <<= 1) { const float t = __shfl_up(inc, o, 64); if (lane >= o) inc += t; }
    if (lane == 63) wt[wave] = inc;
    __syncthreads();
    float pre = inc - run;
    for (int w = 0; w < wave; ++w) pre += wt[w];
    float* dst = c2 + (size_t)row * SEQ + tid * 32;
#pragma unroll
    for (int i = 0; i < 8; ++i) { f32x4 o = {(pre + v[4 * i]) * LOG2E, (pre + v[4 * i + 1]) * LOG2E, (pre + v[4 * i + 2]) * LOG2E, (pre + v[4 * i + 3]) * LOG2E}; *(f32x4*)(dst + 4 * i) = o; }
    __syncthreads();
  }
}

template <int DVT, bool FOX>
DI void attn_step(const char* kb, const bf16x8 (&qf)[4], f32x16 (&o)[DVT], float& m, float& l, const bool diag, const int j, const int tq, const int r, const int hh) {
  constexpr int VB = DVT * 32 * LROW;
  const char* vb = kb + 64 * LROW; const char* cb = vb + VB;
  f32x16 st[2];
  bf16x8 kf[8];
#pragma unroll
  for (int ks = 0; ks < 4; ++ks)
#pragma unroll
    for (int kt = 0; kt < 2; ++kt) kf[ks * 2 + kt] = *(const bf16x8*)(kb + (kt * 32 + r) * LROW + ks * 32 + hh * 16);
  if (FOX) {
#pragma unroll
    for (int kt = 0; kt < 2; ++kt)
#pragma unroll
      for (int g = 0; g < 4; ++g) {
        f32x4 cs = *(const f32x4*)(cb + (kt * 32 + 8 * g + 4 * hh) * 4);
        st[kt][4 * g] = cs[0]; st[kt][4 * g + 1] = cs[1]; st[kt][4 * g + 2] = cs[2]; st[kt][4 * g + 3] = cs[3];
      }
  } else {
#pragma unroll
    for (int kt = 0; kt < 2; ++kt)
#pragma unroll
      for (int i = 0; i < 16; ++i) st[kt][i] = 0.f;
  }
  __builtin_amdgcn_sched_barrier(0);
#pragma unroll
  for (int ks = 0; ks < 4; ++ks)
#pragma unroll
    for (int kt = 0; kt < 2; ++kt) st[kt] = MFMA32(kf[ks * 2 + kt], qf[ks], st[kt]);
  bf16x8 va[DVT], vn[DVT];
#pragma unroll
  for (int d = 0; d < DVT; ++d) va[d] = *(const bf16x8*)(vb + (d * 32 + r) * LROW + (8 * hh) * 2);
  __builtin_amdgcn_sched_barrier(0);
  {
    const f32x2 mm = {m, m};
#pragma unroll
    for (int kt = 0; kt < 2; ++kt)
#pragma unroll
      for (int i = 0; i < 8; ++i) { f32x2 z = {st[kt][2 * i], st[kt][2 * i + 1]}; z = z - mm; st[kt][2 * i] = z[0]; st[kt][2 * i + 1] = z[1]; }
  }
  if (FOX) {
    if (diag) {
#pragma unroll
      for (int kt = 0; kt < 2; ++kt)
#pragma unroll
        for (int i = 0; i < 16; ++i) {
          const int key = j * 64 + kt * 32 + (i & 3) + 8 * (i >> 2) + 4 * hh;
          if (key > tq) st[kt][i] = -INFINITY;
        }
    }
  }
  float mx;
  {
    float a0 = fmaxf(fmaxf(st[0][0], st[0][1]), st[0][2]), a1 = fmaxf(fmaxf(st[1][0], st[1][1]), st[1][2]);
#pragma unroll
    for (int i = 3; i < 15; i += 2) { a0 = fmaxf(fmaxf(a0, st[0][i]), st[0][i + 1]); a1 = fmaxf(fmaxf(a1, st[1][i]), st[1][i + 1]); }
    mx = fmaxf(fmaxf(a0, a1), fmaxf(st[0][15], st[1][15]));
  }
  mx = xmax32(mx);
  if (__any(diag || mx > 8.f)) {
    const float d = (diag || mx > 0.f) ? mx : 0.f;
    const float alpha = diag ? 0.f : __builtin_amdgcn_exp2f(-d);
    m += d;
    l *= alpha;
#pragma unroll
    for (int dd = 0; dd < DVT; ++dd)
#pragma unroll
      for (int i = 0; i < 16; ++i) o[dd][i] *= alpha;
    const f32x2 d2 = {d, d};
#pragma unroll
    for (int kt = 0; kt < 2; ++kt)
#pragma unroll
      for (int i = 0; i < 8; ++i) { f32x2 z = {st[kt][2 * i], st[kt][2 * i + 1]}; z = z - d2; st[kt][2 * i] = z[0]; st[kt][2 * i + 1] = z[1]; }
  }
  f32x2 ls2 = {0.f, 0.f};
#pragma unroll
  for (int kt = 0; kt < 2; ++kt)
#pragma unroll
    for (int i = 0; i < 8; ++i) {
      f32x2 pv = {__builtin_amdgcn_exp2f(st[kt][2 * i]), __builtin_amdgcn_exp2f(st[kt][2 * i + 1])};
      st[kt][2 * i] = pv[0]; st[kt][2 * i + 1] = pv[1];
      ls2 = ls2 + pv;
    }
  l += ls2[0] + ls2[1];
  __builtin_amdgcn_sched_barrier(0);
#define A_PVGROUP(GK, VC, VN) { constexpr int kt_ = (GK) >> 1, s2_ = (GK) & 1; \
    if ((GK) < 3) { constexpr int kt1_ = ((GK) + 1) >> 1, s21_ = ((GK) + 1) & 1; \
      _Pragma("unroll") for (int d = 0; d < DVT; ++d) VN[d] = *(const bf16x8*)(vb + (d * 32 + r) * LROW + (kt1_ * 32 + 16 * s21_ + 8 * hh) * 2); } \
    u32x4 pw_ = {pk2(st[kt_][8 * s2_], st[kt_][8 * s2_ + 1]), pk2(st[kt_][8 * s2_ + 2], st[kt_][8 * s2_ + 3]), pk2(st[kt_][8 * s2_ + 4], st[kt_][8 * s2_ + 5]), pk2(st[kt_][8 * s2_ + 6], st[kt_][8 * s2_ + 7])}; \
    const bf16x8 pf_ = __builtin_bit_cast(bf16x8, pw_); \
    __builtin_amdgcn_sched_barrier(0); \
    _Pragma("unroll") for (int d = 0; d < DVT; ++d) o[d] = MFMA32(VC[d], pf_, o[d]); \
    __builtin_amdgcn_sched_barrier(0); }
  A_PVGROUP(0, va, vn); A_PVGROUP(1, vn, va); A_PVGROUP(2, va, vn); A_PVGROUP(3, vn, va);
#undef A_PVGROUP
}

template <int DVT, bool FOX>
DI void attn_pass(const bf16_t* __restrict__ qrow, const bf16_t* __restrict__ kbase, const int ldk, const bf16_t* __restrict__ vtbase,
                  const float* __restrict__ cbase, const int j_hi, const int my_last, const int j_lo_diag, const int tq, const float prune_c,
                  f32x16 (&o)[DVT], float& l_out, char* lds) {
  constexpr int VB = DVT * 32 * LROW;
  constexpr int STAGE = 64 * LROW + VB + 256;
  const int tid = tid_l(), lane = tid & 63;
  const int r = lane & 31, hh = lane >> 5;
  const int lrow = tid >> 3, lch = tid & 7;
  bf16x8 qf[4];
#pragma unroll
  for (int ks = 0; ks < 4; ++ks) qf[ks] = *(const bf16x8*)(qrow + ks * 16 + hh * 8);
#pragma unroll
  for (int d = 0; d < DVT; ++d)
#pragma unroll
    for (int i = 0; i < 16; ++i) o[d][i] = 0.f;
  float m = 0.f, l = 0.f;
  u32x4 kr0, kr1, vr0[DVT / 2], vr1[DVT / 2]; f32x4 cr0 = {0.f, 0.f, 0.f, 0.f}, cr1 = {0.f, 0.f, 0.f, 0.f};
  const bf16_t* kp = kbase + (size_t)lrow * ldk + lch * 8;
  const bf16_t* vp = vtbase + (size_t)lrow * SEQ + lch * 8;
#define A_GLOAD(KR, VR, CR, JT) { const int s1_ = (JT) * 64; KR = *(const u32x4*)(kp + (size_t)s1_ * ldk); \
    _Pragma("unroll") for (int i_ = 0; i_ < DVT / 2; ++i_) VR[i_] = *(const u32x4*)(vp + (size_t)(64 * i_) * SEQ + s1_); \
    if (FOX) { if (tid < 16) { f32x4 t_ = *(const f32x4*)(cbase + s1_ + tid * 4); CR[0] = -t_[0]; CR[1] = -t_[1]; CR[2] = -t_[2]; CR[3] = -t_[3]; } } }
#define A_LSTORE(KR, VR, CR, STG) { char* kb_ = lds + (STG) * STAGE; char* vb_ = kb_ + 64 * LROW; char* cb_ = vb_ + VB; \
    *(u32x4*)(kb_ + lrow * LROW + lch * 16) = KR; \
    _Pragma("unroll") for (int i_ = 0; i_ < DVT / 2; ++i_) *(u32x4*)(vb_ + (lrow + 64 * i_) * LROW + lch * 16) = VR[i_]; \
    if (FOX) { if (tid < 16) *(f32x4*)(cb_ + tid * 16) = CR; } }
#define A_PRUNE(STG) (FOX && j < j_lo_diag && (prune_c + *(const float*)(lds + (STG) * STAGE + 64 * LROW + VB + 63 * 4) < -160.f))
  int j = j_hi;
  A_GLOAD(kr0, vr0, cr0, j);
  if (j >= 1) A_GLOAD(kr1, vr1, cr1, j - 1);
  A_LSTORE(kr0, vr0, cr0, 0);
  __syncthreads();
  for (;;) {
    if (A_PRUNE(0)) break;
    if (j >= 2) A_GLOAD(kr0, vr0, cr0, j - 2);
    if (j <= my_last) attn_step<DVT, FOX>(lds, qf, o, m, l, j == my_last, j, tq, r, hh);
    if (j == 0) break;
    A_LSTORE(kr1, vr1, cr1, 1);
    __syncthreads();
    --j;
    if (A_PRUNE(1)) break;
    if (j >= 2) A_GLOAD(kr1, vr1, cr1, j - 2);
    if (j <= my_last) attn_step<DVT, FOX>(lds + STAGE, qf, o, m, l, j == my_last, j, tq, r, hh);
    if (j == 0) break;
    A_LSTORE(kr0, vr0, cr0, 0);
    __syncthreads();
    --j;
  }
  __syncthreads();
#undef A_GLOAD
#undef A_LSTORE
#undef A_PRUNE
  l_out = xsum32(l);
}

DI void fox_phase(const Params& p, const int j_odd, char* lds) {
  char* ws = (char*)launder(p.ws);
  const bf16_t* fq = (const bf16_t*)(ws + OFF_R1);
  const bf16_t* fk = (const bf16_t*)(ws + OFF_R1 + 64 * MiB);
  const bf16_t* fvT = (const bf16_t*)(ws + OFF_R1 + 128 * MiB);
  const bf16_t* fg = (const bf16_t*)(ws + OFF_R1 + 192 * MiB);
  const float* c2 = (const float*)(ws + OFF_C2);
  bf16_t* ab = (bf16_t*)(ws + OFF_AB);
  const float b2 = ((const float*)(ws + OFF_MISC))[1032 + j_odd];
  const int tid = tid_l(); const int lane = tid & 63, wave = __builtin_amdgcn_readfirstlane(tid >> 6), r = lane & 31, hh = lane >> 5;
  for (int rnd = 0; rnd < 4; ++rnd) {
    const int bh = rnd * 8 + (blockIdx.x & 7), pp = blockIdx.x >> 3, b = bh >> 4, h = bh & 15;
    for (int half = 0; half < 2; ++half) {
      const int qb = half == 0 ? 63 - pp : pp;
      const int t0 = qb * 256, tq0 = t0 + wave * 32, tq = tq0 + r;
      const int nkv = (t0 + 256) >> 6, my_last = (tq0 + 31) >> 6;
      const float prune_c = b2 + c2[(size_t)bh * SEQ + t0];
      f32x16 o[2]; float l;
      attn_pass<2, true>(fq + (size_t)(b * SEQ + tq) * 1024 + h * 64, fk + (size_t)(b * SEQ) * 1024 + h * 64, 1024,
                         fvT + (size_t)(bh * 64) * SEQ, c2 + (size_t)bh * SEQ, nkv - 1, my_last, t0 >> 6, tq, prune_c, o, l, lds);
      const float inv = 1.f / l;
      const size_t rowo = (size_t)(b * SEQ + tq) * 1024 + h * 64;
#pragma unroll
      for (int d = 0; d < 2; ++d)
#pragma unroll
        for (int g = 0; g < 4; ++g) {
          const int c = d * 32 + 8 * g + 4 * hh;
          u32x2 gv = *(const u32x2*)(fg + rowo + c);
          const float g0 = __uint_as_float(gv[0] << 16), g1 = __uint_as_float(gv[0] & 0xffff0000u), g2 = __uint_as_float(gv[1] << 16), g3 = __uint_as_float(gv[1] & 0xffff0000u);
          u32x2 ov = {pk2(o[d][4 * g] * inv * g0, o[d][4 * g + 1] * inv * g1), pk2(o[d][4 * g + 2] * inv * g2, o[d][4 * g + 3] * inv * g3)};
          *(u32x2*)(ab + rowo + c) = ov;
        }
    }
  }
}

DI void diff_phase(const Params& p, const int j_even, char* lds) {
  char* ws = (char*)launder(p.ws);
  const bf16_t* bq = (const bf16_t*)(ws + OFF_R1 + 160 * MiB);
  const bf16_t* bk = (const bf16_t*)(ws + OFF_R1 + 192 * MiB);
  const bf16_t* bvT = (const bf16_t*)(ws + OFF_R1 + 224 * MiB);
  bf16_t* ab = (bf16_t*)(ws + OFF_AB);
  const float* misc = (const float*)(ws + OFF_MISC);
  const float lam = misc[1024 + j_even];
  const float lam_init = 0.8f - 0.6f * expf(-0.3f * (float)(2 * j_even));
  const float* dg = ((const float*)p.diff_g) + j_even * 128;
  const int tid = tid_l(); const int lane = tid & 63, wave = __builtin_amdgcn_readfirstlane(tid >> 6), r = lane & 31, hh = lane >> 5;
  {
    const int bh = blockIdx.x & 7, pp = blockIdx.x >> 3, b = bh >> 2, h = bh & 3;
    for (int half = 0; half < 2; ++half) {
      const int qb = half == 0 ? 63 - pp : pp;
      const int t0 = qb * 256, tq0 = t0 + wave * 32, tq = tq0 + r;
      const int nkv = (t0 + 256) >> 6, my_last = tq0 >> 6;
      f32x16 o1[4], o2[4]; float l1, l2;
      attn_pass<4, false>(bq + (size_t)(b * SEQ + tq) * 512 + h * 128, bk + (size_t)(b * SEQ) * 512 + h * 128, 512,
                          bvT + (size_t)(bh * 128) * SEQ, nullptr, nkv - 1, my_last, 0, tq, 0.f, o1, l1, lds);
      const float i1 = 1.f / l1;
      unsigned* o1s = (unsigned*)(lds + DIFF_STASH_OFF) + tid;
#pragma unroll
      for (int d = 0; d < 4; ++d)
#pragma unroll
        for (int i = 0; i < 8; ++i) o1s[(d * 8 + i) * 512] = pk2(o1[d][2 * i] * i1, o1[d][2 * i + 1] * i1);
      attn_pass<4, false>(bq + (size_t)(b * SEQ + tq) * 512 + h * 128 + 64, bk + (size_t)(b * SEQ) * 512 + h * 128 + 64, 512,
                          bvT + (size_t)(bh * 128) * SEQ, nullptr, nkv - 1, my_last, 0, tq, 0.f, o2, l2, lds);
      const float i2 = lam / l2;
      float ssq = 0.f;
#pragma unroll
      for (int d = 0; d < 4; ++d)
#pragma unroll
        for (int i = 0; i < 8; ++i) {
          const unsigned pw = o1s[(d * 8 + i) * 512];
          const float va = __uint_as_float(pw << 16) - i2 * o2[d][2 * i], vb = __uint_as_float(pw & 0xffff0000u) - i2 * o2[d][2 * i + 1];
          o2[d][2 * i] = va; o2[d][2 * i + 1] = vb; ssq += va * va + vb * vb; }
      ssq = xsum32(ssq);
      const float rs = rsqrtf(ssq * (1.f / 128.f) + 1e-6f) * (1.f - lam_init);
      const size_t rowo = (size_t)(b * SEQ + tq) * 1024 + 512 + h * 128;
#pragma unroll
      for (int d = 0; d < 4; ++d)
#pragma unroll
        for (int g = 0; g < 4; ++g) {
          const int c = d * 32 + 8 * g + 4 * hh;
          f32x4 gv = *(const f32x4*)(dg + c);
          u32x2 ov = {pk2(o2[d][4 * g] * rs * gv[0], o2[d][4 * g + 1] * rs * gv[1]), pk2(o2[d][4 * g + 2] * rs * gv[2], o2[d][4 * g + 3] * rs * gv[3])};
          *(u32x2*)(ab + rowo + c) = ov;
        }
    }
  }
}

DI void hgrn_stageA(const Params& p, char* lds) {
  char* ws = (char*)launder(p.ws);
  const float* alf = (const float*)(ws + OFF_R1 + 32 * MiB);
  const bf16_t* aiT = (const bf16_t*)(ws + OFF_R1 + 96 * MiB);
  bf16_t* UT = (bf16_t*)(ws + OFF_UT);
  float* dbuf = (float*)(ws + OFF_DB);
  float* lfT = (float*)lds;
  float* part = (float*)(lds + 32768);
  char* KT = lds + 34816;
  char* IT = KT + 18432;
  const int tid = tid_l(), lane = tid & 63, wave = tid >> 6, r = lane & 31, hh = lane >> 5;
  f32x4 lfr[4]; u32x4 itr[2];
#define HA_FETCH(TASK) { const int bh_ = (TASK) >> 8, c_ = (TASK) & 255, tok0_ = (bh_ >> 2) * SEQ + c_ * 64, h_ = bh_ & 3; \
    _Pragma("unroll") for (int i = 0; i < 4; ++i) { const int idx = tid + 512 * i, row = idx >> 5, c4 = idx & 31; \
      lfr[i] = *(const f32x4*)(alf + (size_t)(tok0_ + row) * 512 + h_ * 128 + c4 * 4); } \
    _Pragma("unroll") for (int i = 0; i < 2; ++i) { const int idx = tid + 512 * i, row = idx >> 3, ch = idx & 7; \
      itr[i] = *(const u32x4*)(aiT + (size_t)(bh_ * 128 + row) * SEQ + c_ * 64 + ch * 8); } }
  if (blockIdx.x < 2048) HA_FETCH(blockIdx.x);
  for (int task = blockIdx.x; task < 2048; task += gridDim.x) {
    const int bh = task >> 8, c = task & 255;
#pragma unroll
    for (int i = 0; i < 4; ++i) { const int idx = tid + 512 * i, row = idx >> 5, c4 = idx & 31; *(f32x4*)(lfT + row * 128 + c4 * 4) = lfr[i]; }
#pragma unroll
    for (int i = 0; i < 2; ++i) { const int idx = tid + 512 * i, row = idx >> 3, ch = idx & 7; *(u32x4*)(IT + row * LROW + ch * 16) = itr[i]; }
    if (task + (int)gridDim.x < 2048) HA_FETCH(task + (int)gridDim.x);
    (void)bh; (void)c;
    __syncthreads();
    const int k = tid & 127, seg = tid >> 7;
    float lv[16], bv[16];
    float run = 0.f;
#pragma unroll
    for (int i = 0; i < 16; ++i) { lv[i] = lfT[(seg * 16 + i) * 128 + k]; run += lv[i]; bv[i] = run; }
    part[seg * 128 + k] = run;
    __syncthreads();
    float pre = 0.f, tot = 0.f;
#pragma unroll
    for (int s2 = 0; s2 < 4; ++s2) { const float pv = part[s2 * 128 + k]; if (s2 < seg) pre += pv; tot += pv; }
    {
      float kv[16];
#pragma unroll
      for (int i = 0; i < 16; ++i) kv[i] = (1.f - __expf(lv[i])) * __expf(tot - (pre + bv[i]));
      u32x4 w0 = {pk2(kv[0], kv[1]), pk2(kv[2], kv[3]), pk2(kv[4], kv[5]), pk2(kv[6], kv[7])};
      u32x4 w1 = {pk2(kv[8], kv[9]), pk2(kv[10], kv[11]), pk2(kv[12], kv[13]), pk2(kv[14], kv[15])};
      *(u32x4*)(KT + k * LROW + seg * 32) = w0;
      *(u32x4*)(KT + k * LROW + seg * 32 + 16) = w1;
    }
    if (seg == 0) dbuf[(size_t)task * 128 + k] = __expf(tot);
    __syncthreads();
    {
      const int ktile = wave & 3, vhalf = wave >> 2;
      f32x16 acc[2];
#pragma unroll
      for (int vt = 0; vt < 2; ++vt)
#pragma unroll
        for (int i = 0; i < 16; ++i) acc[vt][i] = 0.f;
#pragma unroll
      for (int ks = 0; ks < 4; ++ks) {
        bf16x8 a = *(const bf16x8*)(KT + (ktile * 32 + r) * LROW + ks * 32 + hh * 16);
#pragma unroll
        for (int vt = 0; vt < 2; ++vt) {
          bf16x8 bb = *(const bf16x8*)(IT + (vhalf * 64 + vt * 32 + r) * LROW + ks * 32 + hh * 16);
          acc[vt] = MFMA32(a, bb, acc[vt]);
        }
      }
#pragma unroll
      for (int vt = 0; vt < 2; ++vt) {
        bf16_t* dst = UT + ((size_t)task * 128 + vhalf * 64 + vt * 32 + r) * 128 + ktile * 32 + 4 * hh;
#pragma unroll
        for (int g = 0; g < 4; ++g) { u32x2 ov = {pk2(acc[vt][4 * g], acc[vt][4 * g + 1]), pk2(acc[vt][4 * g + 2], acc[vt][4 * g + 3])}; *(u32x2*)(dst + 8 * g) = ov; }
      }
    }
    __syncthreads();
  }
}

#undef HA_FETCH
DI void hgrn_scan(const Params& p) {
  char* ws = (char*)launder(p.ws);
  bf16_t* UT = (bf16_t*)(ws + OFF_UT);
  const float* dbuf = (const float*)(ws + OFF_DB);
  const int gid = blockIdx.x * 512 + tid_l();
  if (gid >= 8 * 16384) return;
  const int bh = gid >> 14, e = gid & 16383;
  bf16_t* up = UT + (size_t)bh * 256 * 16384 + e;
  const float* dp = dbuf + (size_t)bh * 256 * 128 + (e & 127);
  float st = 0.f;
  for (int c0 = 0; c0 < 256; c0 += 32) {
    bf16_t u[32]; float dv[32];
#pragma unroll
    for (int i = 0; i < 32; ++i) { u[i] = up[(size_t)(c0 + i) * 16384]; dv[i] = dp[(size_t)(c0 + i) * 128]; }
#pragma unroll
    for (int i = 0; i < 32; ++i) {
      up[(size_t)(c0 + i) * 16384] = f2bf(st);
      st = dv[i] * st + bf2f(u[i]);
    }
  }
}

constexpr int QROW = 272;
DI void hgrn_stageC(const Params& p, const int j_even, char* lds) {
  char* ws = (char*)launder(p.ws);
  const bf16_t* aq = (const bf16_t*)(ws + OFF_R1);
  const float* alf = (const float*)(ws + OFF_R1 + 32 * MiB);
  const bf16_t* aiT = (const bf16_t*)(ws + OFF_R1 + 96 * MiB);
  const bf16_t* ag = (const bf16_t*)(ws + OFF_R1 + 128 * MiB);
  const bf16_t* UT = (const bf16_t*)(ws + OFF_UT);
  bf16_t* ab = (bf16_t*)(ws + OFF_AB);
  const float* hg = ((const float*)p.hgrn_g) + j_even * 128;
  float* lfT = (float*)lds;
  char* ST = lds;
  char* Q1 = lds + 34816;
  char* Q2 = Q1 + 64 * QROW;
  char* K2 = Q2 + 64 * QROW;
  char* IT = K2 + 64 * QROW;
  float* part = (float*)(IT + 128 * LROW);
  const int tid = tid_l(), lane = tid & 63, wave = tid >> 6, r = lane & 31, hh = lane >> 5;
  f32x4 lfr[4]; u32x4 itr[2]; bf16_t qr[16];
#define HC_FETCH(TASK) { const int bh_ = (TASK) >> 8, c_ = (TASK) & 255, tok0_ = (bh_ >> 2) * SEQ + c_ * 64, h_ = bh_ & 3; \
    _Pragma("unroll") for (int i = 0; i < 4; ++i) { const int idx = tid + 512 * i, row = idx >> 5, c4 = idx & 31; \
      lfr[i] = *(const f32x4*)(alf + (size_t)(tok0_ + row) * 512 + h_ * 128 + c4 * 4); } \
    _Pragma("unroll") for (int i = 0; i < 2; ++i) { const int idx = tid + 512 * i, row = idx >> 3, ch = idx & 7; \
      itr[i] = *(const u32x4*)(aiT + (size_t)(bh_ * 128 + row) * SEQ + c_ * 64 + ch * 8); } \
    _Pragma("unroll") for (int i = 0; i < 16; ++i) qr[i] = aq[(size_t)(tok0_ + (tid >> 7) * 16 + i) * 512 + h_ * 128 + (tid & 127)]; }
  if (blockIdx.x < 2048) HC_FETCH(blockIdx.x);
  for (int task = blockIdx.x; task < 2048; task += gridDim.x) {
    const int bh = task >> 8, c = task & 255, b = bh >> 2, h = bh & 3;
    const int tok0 = b * SEQ + c * 64;
#pragma unroll
    for (int i = 0; i < 4; ++i) { const int idx = tid + 512 * i, row = idx >> 5, c4 = idx & 31; *(f32x4*)(lfT + row * 128 + c4 * 4) = lfr[i]; }
#pragma unroll
    for (int i = 0; i < 2; ++i) { const int idx = tid + 512 * i, row = idx >> 3, ch = idx & 7; *(u32x4*)(IT + row * LROW + ch * 16) = itr[i]; }
    float qcur[16];
#pragma unroll
    for (int i = 0; i < 16; ++i) qcur[i] = bf2f(qr[i]);
    u32x4 sreg[4];
#pragma unroll
    for (int i = 0; i < 4; ++i) sreg[i] = *(const u32x4*)(UT + (size_t)task * 16384 + (size_t)(tid + 512 * i) * 8);
    if (task + (int)gridDim.x < 2048) HC_FETCH(task + (int)gridDim.x);
    __syncthreads();
    const int k = tid & 127, seg = tid >> 7;
    float lv[16], bv[16];
    float run = 0.f;
#pragma unroll
    for (int i = 0; i < 16; ++i) { lv[i] = lfT[(seg * 16 + i) * 128 + k]; run += lv[i]; bv[i] = run; }
    part[seg * 128 + k] = run;
    __syncthreads();
    {
      const float p0 = part[k], p1 = part[128 + k], p2 = part[256 + k];
      const float pre = (seg > 0 ? p0 : 0.f) + (seg > 1 ? p1 : 0.f) + (seg > 2 ? p2 : 0.f);
      const float bmid = p0 + p1;
#pragma unroll
      for (int i = 0; i < 16; ++i) {
        const int t = seg * 16 + i;
        const float bt = pre + bv[i];
        const float qv = qcur[i];
        const float kk = 1.f - __expf(lv[i]);
        *(bf16_t*)(Q1 + t * QROW + k * 2) = f2bf(qv * __expf(bt));
        *(bf16_t*)(Q2 + t * QROW + k * 2) = f2bf(qv * __expf(fminf(bt - bmid, 80.f)));
        *(bf16_t*)(K2 + t * QROW + k * 2) = f2bf(kk * __expf(fminf(bmid - bt, 80.f)));
      }
    }
#pragma unroll
    for (int i = 0; i < 4; ++i) { const int idx = tid + 512 * i, row = idx >> 4, ch = idx & 15; *(u32x4*)(ST + row * QROW + ch * 16) = sreg[i]; }
    __syncthreads();
    {
      const int vt = wave & 3, tt = wave >> 2;
      const int t = tt * 32 + r;
      f32x16 sc[2];
#pragma unroll
      for (int st = 0; st < 2; ++st)
#pragma unroll
        for (int i = 0; i < 16; ++i) sc[st][i] = 0.f;
#pragma unroll
      for (int ks = 0; ks < 8; ++ks) {
        bf16x8 qb = *(const bf16x8*)(Q2 + t * QROW + ks * 32 + hh * 16);
#pragma unroll
        for (int st = 0; st < 2; ++st) {
          if (st <= tt) {
            bf16x8 a = *(const bf16x8*)(K2 + (st * 32 + r) * QROW + ks * 32 + hh * 16);
            sc[st] = MFMA32(a, qb, sc[st]);
          }
        }
      }
      f32x16 acc;
#pragma unroll
      for (int i = 0; i < 16; ++i) acc[i] = 0.f;
#pragma unroll
      for (int st = 0; st < 2; ++st) {
        if (st <= tt) {
#pragma unroll
          for (int i = 0; i < 16; ++i) { const int s = st * 32 + (i & 3) + 8 * (i >> 2) + 4 * hh; if (s > t) sc[st][i] = 0.f; }
#pragma unroll
          for (int s2 = 0; s2 < 2; ++s2) {
            u32x4 pw = {pk2(sc[st][8 * s2], sc[st][8 * s2 + 1]), pk2(sc[st][8 * s2 + 2], sc[st][8 * s2 + 3]), pk2(sc[st][8 * s2 + 4], sc[st][8 * s2 + 5]), pk2(sc[st][8 * s2 + 6], sc[st][8 * s2 + 7])};
            const bf16x8 pf = __builtin_bit_cast(bf16x8, pw);
            const char* ip = IT + (vt * 32 + r) * LROW + (st * 32 + 16 * s2 + 4 * hh) * 2;
            u32x2 lo = *(const u32x2*)ip, hi = *(const u32x2*)(ip + 16);
            u32x4 aw = {lo[0], lo[1], hi[0], hi[1]};
            acc = MFMA32(__builtin_bit_cast(bf16x8, aw), pf, acc);
          }
        }
      }
#pragma unroll
      for (int ks = 0; ks < 8; ++ks) {
        bf16x8 a = *(const bf16x8*)(ST + (vt * 32 + r) * QROW + ks * 32 + hh * 16);
        bf16x8 qb = *(const bf16x8*)(Q1 + t * QROW + ks * 32 + hh * 16);
        acc = MFMA32(a, qb, acc);
      }
      float ssq = 0.f;
#pragma unroll
      for (int i = 0; i < 16; ++i) ssq += acc[i] * acc[i];
      ssq = xsum32(ssq);
      if (hh == 0) part[vt * 64 + t] = ssq;
      __syncthreads();
      const float tot = part[t] + part[64 + t] + part[128 + t] + part[192 + t];
      const float rs = rsqrtf(tot * (1.f / 128.f) + 1e-6f);
      const size_t go = (size_t)(tok0 + t) * 512 + h * 128 + vt * 32 + 4 * hh;
      const size_t oo = (size_t)(tok0 + t) * 1024 + h * 128 + vt * 32 + 4 * hh;
#pragma unroll
      for (int g = 0; g < 4; ++g) {
        f32x4 gn = *(const f32x4*)(hg + vt * 32 + 4 * hh + 8 * g);
        u32x2 gv = *(const u32x2*)(ag + go + 8 * g);
        const float g0 = __uint_as_float(gv[0] << 16), g1 = __uint_as_float(gv[0] & 0xffff0000u), g2 = __uint_as_float(gv[1] << 16), g3 = __uint_as_float(gv[1] & 0xffff0000u);
        u32x2 ov = {pk2(acc[4 * g] * rs * gn[0] * g0, acc[4 * g + 1] * rs * gn[1] * g1), pk2(acc[4 * g + 2] * rs * gn[2] * g2, acc[4 * g + 3] * rs * gn[3] * g3)};
        *(u32x2*)(ab + oo + 8 * g) = ov;
      }
    }
    __syncthreads();
  }
}

#undef HC_FETCH
DI void grid_barrier(unsigned* ctr, const unsigned target) {
  asm volatile("s_waitcnt vmcnt(0)" ::: "memory");
  __syncthreads();
  if (threadIdx.x == 0) {
    __builtin_amdgcn_fence(__ATOMIC_RELEASE, "agent");
    asm volatile("s_waitcnt vmcnt(0)" ::: "memory");
    __hip_atomic_fetch_add((GAS unsigned*)ctr, 1u, __ATOMIC_RELAXED, __HIP_MEMORY_SCOPE_AGENT);
    while (__hip_atomic_load((GAS unsigned*)ctr, __ATOMIC_RELAXED, __HIP_MEMORY_SCOPE_AGENT) < target) __builtin_amdgcn_s_sleep(1);
    __builtin_amdgcn_fence(__ATOMIC_ACQUIRE, "agent");
    asm volatile("s_waitcnt vmcnt(0)" ::: "memory");
  }
  __syncthreads();
}
typedef const __attribute__((address_space(4))) Params* kparams_t;
#if defined(__HIP_DEVICE_COMPILE__)
DI kparams_t launder_k(kparams_t q) { asm volatile("" : "+s"(q)); return q; }
#endif
#if defined(__HIP_DEVICE_COMPILE__)
#define KPARAMS (*launder_k((kparams_t)__builtin_amdgcn_kernarg_segment_ptr()))
#else
#define KPARAMS p_arg
#endif
__global__ void __launch_bounds__(512) fwd_mega(Params p_arg) {
  extern __shared__ __attribute__((aligned(16))) char lds[];
  int ph = 0;
  const int p_lo = p_arg.lo, p_hi = p_arg.hi;
#define PHASE(id, ...) { if (ph >= p_lo && ph < p_hi) { const Params p = KPARAMS; char* ws = (char*)launder(p.ws); float* outp = (float*)launder((GAS char*)p.out); bf16_t* ab = (bf16_t*)(ws + OFF_AB); (void)outp; (void)ab; \
    if (ONLY < 0 || ONLY == id) { __VA_ARGS__; } if ((DUPMASK >> id) & 1) { __syncthreads(); __VA_ARGS__; } if (ph + 1 < p_hi) { if (ph == p_lo) cg::this_grid().sync(); else grid_barrier((unsigned*)(ws + OFF_CNT) + 256, (unsigned)(ph - p_lo) * gridDim.x); } } ++ph; }
  PHASE(0, phase0(p, lds));
  for (int l = 0; l < 4; ++l) {
    const int j = l >> 1;
    if ((l & 1) == 0) {
      PHASE(1,
        EpiEvenIn e;
        e.r1 = ws + OFF_R1; e.lb = (const float*)(ws + OFF_MISC) + j * 512;
        gemm_phase(ab, 1024, (const bf16_t*)(ws + OFF_WEI) + (size_t)j * EVEN_IN * D, EVEN_IN, D, e, lds));
      PHASE(2, hgrn_stageA(p, lds));
      PHASE(3, hgrn_scan(p));
      PHASE(4, hgrn_stageC(p, j, lds); diff_phase(p, j, lds));
      PHASE(6,
        EpiResLN er; er.xin = (l == 0) ? (const float*)launder((GAS char*)p.x_in) : outp; er.xout = outp; er.xb = ab;
        er.g = ((const float*)p.ln1g) + l * D; er.b = ((const float*)p.ln1b) + l * D;
        er.xchg = (float*)(ws + OFF_XCHG); er.cnt = (unsigned*)(ws + OFF_CNT); er.target = 4u * (unsigned)(2 * l + 1);
        gemm_phase(ab, 1024, (const bf16_t*)(ws + OFF_WEO) + (size_t)j * D * D, D, D, er, lds));
    } else {
      PHASE(7,
        EpiOddIn e;
        e.r1 = ws + OFF_R1;
        e.lf = (float*)(ws + OFF_LF); e.qg = ((const float*)p.fox_qg) + j * 64; e.kg = ((const float*)p.fox_kg) + j * 64; e.bf = ((const float*)p.fox_bf) + j * 16;
        gemm_phase(ab, 1024, (const bf16_t*)(ws + OFF_WFI) + (size_t)j * ODD_PAD * D, ODD_PAD, D, e, lds));
      PHASE(8, cumsum_phase((const float*)(ws + OFF_LF), (float*)(ws + OFF_C2), lds));
      PHASE(9, fox_phase(p, j, lds));
      PHASE(6,
        EpiResLN er; er.xin = outp; er.xout = outp; er.xb = ab;
        er.g = ((const float*)p.ln1g) + l * D; er.b = ((const float*)p.ln1b) + l * D;
        er.xchg = (float*)(ws + OFF_XCHG); er.cnt = (unsigned*)(ws + OFF_CNT); er.target = 4u * (unsigned)(2 * l + 1);
        gemm_phase(ab, 1024, (const bf16_t*)(ws + OFF_WFO) + (size_t)j * D * D, D, D, er, lds));
    }
    PHASE(11,
      EpiW1 e1; e1.act = (bf16_t*)(ws + OFF_R1);
      gemm_phase(ab, 1024, (const bf16_t*)(ws + OFF_W1) + (size_t)l * 2 * DFF * D, 2 * DFF, D, e1, lds));
    PHASE(6,
      EpiResLN e2; e2.xin = outp; e2.xout = outp; e2.xb = ab;
      e2.g = ((const float*)p.ln2g) + l * D; e2.b = ((const float*)p.ln2b) + l * D;
      e2.xchg = (float*)(ws + OFF_XCHG); e2.cnt = (unsigned*)(ws + OFF_CNT); e2.target = 4u * (unsigned)(2 * l + 2);
      gemm_phase((const bf16_t*)(ws + OFF_R1), DFF, (const bf16_t*)(ws + OFF_W2) + (size_t)l * D * DFF, D, DFF, e2, lds));
  }
#undef PHASE
}
constexpr int N_PHASES = 1 + 2 * 7 + 2 * 6;

extern "C" void kernel_launch(void* const* d_in, const int* in_sizes, int n_in, void* d_out, int out_size, void* d_ws, size_t ws_size, hipStream_t stream) {
  static bool attr = false;
  if (!attr) { hipFuncSetAttribute((const void*)fwd_mega, hipFuncAttributeMaxDynamicSharedMemorySize, LDS_BYTES); attr = true; }
  Params p{};
  p.x_in = (const GAS float*)d_in[0];
  p.even_w_in = (const GAS float*)d_in[1]; p.even_w_out = (const GAS float*)d_in[2]; p.lb_logits = (const GAS float*)d_in[3];
  p.lq1 = (const GAS float*)d_in[4]; p.lk1 = (const GAS float*)d_in[5]; p.lq2 = (const GAS float*)d_in[6]; p.lk2 = (const GAS float*)d_in[7];
  p.hgrn_g = (const GAS float*)d_in[8]; p.diff_g = (const GAS float*)d_in[9];
  p.fox_w_in = (const GAS float*)d_in[10]; p.fox_w_out = (const GAS float*)d_in[11]; p.fox_bf = (const GAS float*)d_in[12];
  p.fox_qg = (const GAS float*)d_in[13]; p.fox_kg = (const GAS float*)d_in[14];
  p.w1 = (const GAS float*)d_in[15]; p.w2 = (const GAS float*)d_in[16];
  p.ln1g = (const GAS float*)d_in[17]; p.ln1b = (const GAS float*)d_in[18]; p.ln2g = (const GAS float*)d_in[19]; p.ln2b = (const GAS float*)d_in[20];
  p.out = (GAS float*)d_out; p.ws = (GAS char*)d_ws;
#if COOP
  p.lo = 0; p.hi = N_PHASES;
  void* args[] = {&p};
  hipError_t e = hipLaunchCooperativeKernel((const void*)fwd_mega, dim3(256), dim3(512), args, LDS_BYTES, stream);
  if (e != hipSuccess) fprintf(stderr, "cooperative launch failed: %s\n", hipGetErrorString(e));
#else
  for (int ph = 0; ph < N_PHASES; ++ph) {
    p.lo = ph; p.hi = ph + 1;
    hipLaunchKernelGGL(fwd_mega, dim3(256), dim3(512), LDS_BYTES, stream, p);
  }
#endif
}
```

```cpp
#include <hip/hip_runtime.h>
#include <hip/hip_cooperative_groups.h>
#include <cstdio>
#include <cstdint>
namespace cg = cooperative_groups;

#ifndef COOP
#define COOP 1
#endif
#ifndef ONLY
#define ONLY -1
#endif
#ifndef DUPMASK
#define DUPMASK 0
#endif

typedef unsigned short bf16_t;
typedef short bf16x8 __attribute__((ext_vector_type(8)));
typedef float f32x16 __attribute__((ext_vector_type(16)));
typedef float f32x4 __attribute__((ext_vector_type(4)));
typedef float f32x2 __attribute__((ext_vector_type(2)));
typedef unsigned u32x4 __attribute__((ext_vector_type(4)));
typedef unsigned u32x2 __attribute__((ext_vector_type(2)));
typedef __bf16 bf16x2v __attribute__((ext_vector_type(2)));

#define DI __device__ __forceinline__
#define MFMA32(a, b, c) __builtin_amdgcn_mfma_f32_32x32x16_bf16((a), (b), (c), 0, 0, 0)

constexpr int D = 1024, SEQ = 16384, NTOK = 32768, DFF = 2816;
constexpr int EVEN_IN = 3584, ODD_IN = 4112, ODD_PAD = 4352;
constexpr float ALPHA = 1.6817928305074290f;
constexpr float LOG2E = 1.4426950408889634f;
constexpr size_t MiB = 1u << 20;

constexpr size_t OFF_WEI = 0;
constexpr size_t OFF_WEO = OFF_WEI + (size_t)2 * EVEN_IN * D * 2;
constexpr size_t OFF_WFI = OFF_WEO + (size_t)2 * D * D * 2;
constexpr size_t OFF_WFO = OFF_WFI + (size_t)2 * ODD_PAD * D * 2;
constexpr size_t OFF_W1  = OFF_WFO + (size_t)2 * D * D * 2;
constexpr size_t OFF_W2  = OFF_W1 + (size_t)4 * 2 * DFF * D * 2;
constexpr size_t W_END   = OFF_W2 + (size_t)4 * D * DFF * 2;
static_assert(W_END <= 105 * MiB, "weights region");
constexpr size_t OFF_R1 = 105 * MiB;
constexpr size_t OFF_AB = 361 * MiB;
constexpr size_t OFF_UT = 425 * MiB;
constexpr size_t OFF_DB = 489 * MiB;
constexpr size_t OFF_LF = 490 * MiB;
constexpr size_t OFF_C2 = 492 * MiB;
constexpr size_t OFF_MISC = 494 * MiB;
constexpr size_t OFF_CNT = OFF_MISC + 80 * 1024;
constexpr size_t OFF_XCHG = OFF_MISC + 128 * 1024;

#define GAS __attribute__((address_space(1)))
struct Params {
  const GAS float* x_in;
  const GAS float *even_w_in, *even_w_out, *lb_logits, *lq1, *lk1, *lq2, *lk2, *hgrn_g, *diff_g;
  const GAS float *fox_w_in, *fox_w_out, *fox_bf, *fox_qg, *fox_kg;
  const GAS float *w1, *w2, *ln1g, *ln1b, *ln2g, *ln2b;
  GAS float* out;
  GAS char* ws;
  int lo, hi;
};

DI unsigned pk2(float lo, float hi) { f32x2 v = {lo, hi}; bf16x2v b = __builtin_convertvector(v, bf16x2v); return __builtin_bit_cast(unsigned, b); }
DI bf16_t f2bf(float x) { return (bf16_t)(pk2(x, 0.f) & 0xffffu); }
DI float bf2f(bf16_t v) { return __uint_as_float(((unsigned)v) << 16); }
DI float sigmoidf_(float x) { return __builtin_amdgcn_rcpf(1.f + __builtin_amdgcn_exp2f(-LOG2E * x)); }
DI float siluf_(float x) { return x * __builtin_amdgcn_rcpf(1.f + __builtin_amdgcn_exp2f(-LOG2E * x)); }
DI GAS char* launder(GAS char* q) { asm volatile("" : "+s"(q)); return q; }
DI int tid_l() { int t = threadIdx.x; asm volatile("" : "+v"(t)); return t; }
DI int swz32(int s) { return (s & ~12) | ((s & 4) << 1) | ((s & 8) >> 1); }
DI float xsum32(float v) { const u32x2 r_ = __builtin_amdgcn_permlane32_swap(__float_as_uint(v), __float_as_uint(v), false, false); return __uint_as_float(r_[0]) + __uint_as_float(r_[1]); }
DI float xmax32(float v) { const u32x2 r_ = __builtin_amdgcn_permlane32_swap(__float_as_uint(v), __float_as_uint(v), false, false); return fmaxf(__uint_as_float(r_[0]), __uint_as_float(r_[1])); }

DI int perm32(int rho) { return (((rho >> 2) & 1) << 4) + (rho & 3) + ((rho >> 3) << 2); }
DI void convert_w(const float* __restrict__ w, bf16_t* __restrict__ wt, int K, int N, int Npad, int mode, float* tl) {
  const int tid = tid_l();
  const int nkt = K >> 6, nnt = Npad >> 6;
  for (int tile = blockIdx.x; tile < nkt * nnt; tile += gridDim.x) {
    const int k0 = (tile / nnt) << 6, n0 = (tile % nnt) << 6;
#pragma unroll
    for (int i = 0; i < 2; ++i) {
      const int kk = (tid >> 4) + 32 * i, n4 = (tid & 15) << 2;
      const int np = n0 + n4;
      int src = np;
      if (mode == 1) { const int grp = np >> 6, j = np & 63; src = (j < 32) ? grp * 32 + perm32(j) : DFF + grp * 32 + perm32(j - 32); }
      f32x4 v = {0.f, 0.f, 0.f, 0.f};
      if (src < N) v = *(const f32x4*)(w + (size_t)(k0 + kk) * N + src);
      tl[kk * 65 + n4 + 0] = v[0]; tl[kk * 65 + n4 + 1] = v[1]; tl[kk * 65 + n4 + 2] = v[2]; tl[kk * 65 + n4 + 3] = v[3];
    }
    __syncthreads();
    {
      const int n = tid >> 3, kc = (tid & 7) << 3;
      float f[8];
#pragma unroll
      for (int j = 0; j < 8; ++j) f[j] = tl[(kc + j) * 65 + n];
      u32x4 o = {pk2(f[0], f[1]), pk2(f[2], f[3]), pk2(f[4], f[5]), pk2(f[6], f[7])};
      *(u32x4*)(wt + (size_t)(n0 + n) * K + k0 + kc) = o;
    }
    __syncthreads();
  }
}

DI void phase0(const Params& p, char* lds) {
  float* tl = (float*)lds;
  char* ws = (char*)launder(p.ws);
  for (int j = 0; j < 2; ++j) {
    convert_w(((const float*)p.even_w_in) + (size_t)j * D * EVEN_IN, (bf16_t*)(ws + OFF_WEI) + (size_t)j * EVEN_IN * D, D, EVEN_IN, EVEN_IN, 0, tl);
    convert_w(((const float*)p.even_w_out) + (size_t)j * D * D, (bf16_t*)(ws + OFF_WEO) + (size_t)j * D * D, D, D, D, 0, tl);
    convert_w(((const float*)p.fox_w_in) + (size_t)j * D * ODD_IN, (bf16_t*)(ws + OFF_WFI) + (size_t)j * ODD_PAD * D, D, ODD_IN, ODD_PAD, 0, tl);
    convert_w(((const float*)p.fox_w_out) + (size_t)j * D * D, (bf16_t*)(ws + OFF_WFO) + (size_t)j * D * D, D, D, D, 0, tl);
  }
  for (int l = 0; l < 4; ++l) {
    convert_w(((const float*)p.w1) + (size_t)l * D * 2 * DFF, (bf16_t*)(ws + OFF_W1) + (size_t)l * 2 * DFF * D, D, 2 * DFF, 2 * DFF, 1, tl);
    convert_w(((const float*)p.w2) + (size_t)l * DFF * D, (bf16_t*)(ws + OFF_W2) + (size_t)l * D * DFF, DFF, D, D, 0, tl);
  }
  {
    bf16_t* ab = (bf16_t*)(ws + OFF_AB);
    const size_t n8 = (size_t)NTOK * D / 8;
    for (size_t i = (size_t)blockIdx.x * 512 + tid_l(); i < n8; i += (size_t)gridDim.x * 512) {
      f32x4 a = *(const f32x4*)(((const float*)p.x_in) + i * 8), b = *(const f32x4*)(((const float*)p.x_in) + i * 8 + 4);
      u32x4 o = {pk2(a[0], a[1]), pk2(a[2], a[3]), pk2(b[0], b[1]), pk2(b[2], b[3])};
      *(u32x4*)(ab + i * 8) = o;
    }
  }
  if (blockIdx.x == 0) { const int t_ = tid_l(); if (t_ < 128) ((unsigned*)(ws + OFF_CNT))[t_] = 0u; if (t_ == 128) ((unsigned*)(ws + OFF_CNT))[256] = 0u; }
  if (blockIdx.x == 0) {
    float* misc = (float*)(ws + OFF_MISC);
    const int tid = tid_l();
    {
      const float l0 = ((const float*)p.lb_logits)[tid], l1 = ((const float*)p.lb_logits)[512 + tid];
      const float mx = fmaxf(l0, l1);
      const float e0 = expf(l0 - mx), e1 = expf(l1 - mx);
      const float s0 = e0 / (e0 + e1), s1 = e1 / (e0 + e1);
      misc[tid] = s0 - s0;
      misc[512 + tid] = (s0 + s1) - s0;
    }
    if (tid < 2) {
      float d1 = 0.f, d2 = 0.f;
      for (int i = 0; i < 64; ++i) { d1 += ((const float*)p.lq1)[tid * 64 + i] * ((const float*)p.lk1)[tid * 64 + i]; d2 += ((const float*)p.lq2)[tid * 64 + i] * ((const float*)p.lk2)[tid * 64 + i]; }
      const float lam_init = 0.8f - 0.6f * expf(-0.3f * (float)(2 * tid));
      misc[1024 + tid] = expf(d1) - expf(d2) + lam_init;
      float mq = 0.f, mk = 0.f;
      for (int i = 0; i < 64; ++i) { mq = fmaxf(mq, fabsf(((const float*)p.fox_qg)[tid * 64 + i])); mk = fmaxf(mk, fabsf(((const float*)p.fox_kg)[tid * 64 + i])); }
      const float B = 0.125f * LOG2E * 64.f * mq * mk * 1.02f;
      misc[1032 + tid] = 2.f * B + 8.f;
    }
  }
}

constexpr int LROW = 144;
constexpr int G_XB = 256 * LROW, G_WB = 256 * LROW, G_STAGE = G_XB + G_WB;
constexpr int DIFF_STASH_OFF = 2 * (64 * LROW + 128 * LROW + 256);
constexpr int LDS_BYTES = 2 * G_STAGE;
static_assert(LDS_BYTES >= DIFF_STASH_OFF + 512 * 32 * 4, "lds");

template <class Epi>
DI void gemm_phase(const bf16_t* __restrict__ X, const int ldx, const bf16_t* __restrict__ Wt, const int N, const int K, const Epi& epi, char* lds) {
  const int tid = tid_l(), lane = tid & 63, wave = tid >> 6;
  const int r = lane & 31, hh = lane >> 5;
  const int tw = wave & 3, fw = wave >> 2;
  const int nNt = N >> 8;
  const int ntiles = nNt * (NTOK / 256);
  const int nk = K >> 6;
  const int lrow = tid >> 3, lch = tid & 7;
  const int xcd = blockIdx.x & 7, slot = blockIdx.x >> 3, nchunks = 4 * nNt;
  (void)ntiles;
  u32x4 xr0[4], wr0[4];
  for (int chunk = xcd; chunk < nchunks; chunk += 8) {
    const int L = chunk * 32 + slot, band = L / (4 * nNt), rem = L % (4 * nNt);
    const int mt_ = band * 4 + (rem & 3), nt_ = rem >> 2;
    const char* Xt = (const char*)(X + (size_t)(mt_ * 256) * ldx);
    const char* Wtb = (const char*)(Wt + (size_t)(nt_ * 256) * K);
    const unsigned xoff = (unsigned)(lrow * ldx + lch * 8) * 2u, woff = (unsigned)(lrow * K + lch * 8) * 2u;
    const bool has_next = !Epi::kFull && (chunk + 8 < nchunks);
    const int Ln = (has_next ? chunk + 8 : chunk) * 32 + slot, band_n = Ln / (4 * nNt), rem_n = Ln % (4 * nNt);
    const char* Xt_n = (const char*)(X + (size_t)((band_n * 4 + (rem_n & 3)) * 256) * ldx);
    const char* Wtb_n = (const char*)(Wt + (size_t)((rem_n >> 2) * 256) * K);
    f32x16 acc[2][2][2];
#define G_GLOAD(XR, WR, KT) { _Pragma("unroll") for (int i_ = 0; i_ < 4; ++i_) XR[i_] = *(const u32x4*)(Xt + ((size_t)(64 * i_) * ldx + (KT) * 64) * 2 + xoff); \
    _Pragma("unroll") for (int i_ = 0; i_ < 4; ++i_) WR[i_] = *(const u32x4*)(Wtb + ((size_t)(64 * i_) * K + (KT) * 64) * 2 + woff); }
#define G_LSTORE(XR, WR, STG) { char* xs_ = lds + (STG) * G_STAGE; char* ws_ = xs_ + G_XB; \
    _Pragma("unroll") for (int i_ = 0; i_ < 4; ++i_) *(u32x4*)(xs_ + (lrow + 64 * i_) * LROW + lch * 16) = XR[i_]; \
    _Pragma("unroll") for (int i_ = 0; i_ < 4; ++i_) *(u32x4*)(ws_ + (lrow + 64 * i_) * LROW + lch * 16) = WR[i_]; }
#define G_PART(Q, STG, KT, DOLOAD) { char* xs_ = lds + (STG) * G_STAGE; char* ws_ = xs_ + G_XB; \
    if ((Q) < 2) { _Pragma("unroll") for (int i_ = 2 * (Q); i_ < 2 * (Q) + 2; ++i_) { *(u32x4*)(xs_ + (lrow + 64 * i_) * LROW + lch * 16) = xr0[i_]; \
        if (DOLOAD) xr0[i_] = *(const u32x4*)(xb_ + ((size_t)(64 * i_) * ldx + (KT) * 64) * 2 + xoff); } } \
    else { _Pragma("unroll") for (int i_ = 2 * ((Q) - 2); i_ < 2 * ((Q) - 2) + 2; ++i_) { *(u32x4*)(ws_ + (lrow + 64 * i_) * LROW + lch * 16) = wr0[i_]; \
        if (DOLOAD) wr0[i_] = *(const u32x4*)(wb_ + ((size_t)(64 * i_) * K + (KT) * 64) * 2 + woff); } } \
    __builtin_amdgcn_sched_barrier(0); }
#define G_LDX(XF, KS) { _Pragma("unroll") for (int m = 0; m < 2; ++m) XF[m] = *(const bf16x8*)(xs + (tw * 64 + m * 32 + r) * LROW + (KS) * 32 + hh * 16); }
#define G_LDW(WF, N0, KS) { _Pragma("unroll") for (int n = 0; n < 2; ++n) WF[n] = *(const bf16x8*)(wsm + (fw * 128 + ((N0) + n) * 32 + r) * LROW + (KS) * 32 + hh * 16); }
#define G_MFMA4S(XF, WF, H) { _Pragma("unroll") for (int n = 0; n < 2; ++n) _Pragma("unroll") for (int m = 0; m < 2; ++m) acc[H][n][m] = MFMA32(XF[m], WF[n], acc[H][n][m]); }
#define G_MFMA4(XF, WF, H) { _Pragma("unroll") for (int n = 0; n < 2; ++n) _Pragma("unroll") for (int m = 0; m < 2; ++m) acc[H][n][m] = MFMA32(WF[n], XF[m], acc[H][n][m]); }
#define G_STEP(MM, KS, XC, XN) { G_LDW(wc, 2, KS); if ((KS) < 3) { G_LDX(XN, (KS) + 1); } __builtin_amdgcn_sched_barrier(0); \
    MM(XC, w01, 0); __builtin_amdgcn_sched_barrier(0); if ((KS) < 3) { G_LDW(w01, 0, (KS) + 1); } MM(XC, wc, 1); __builtin_amdgcn_sched_barrier(0); }
#define G_COMPUTE_ST(MM, STG, DOSTORE, NSTG, KTL, DOLOAD) { const char* xs = lds + (STG) * G_STAGE; const char* wsm = xs + G_XB; \
    bf16x8 xfa[2], xfb[2], w01[2], wc[2]; \
    G_LDX(xfa, 0); G_LDW(w01, 0, 0); \
    G_STEP(MM, 0, xfa, xfb); if (DOSTORE) { G_PART(0, NSTG, KTL, DOLOAD); G_PART(1, NSTG, KTL, DOLOAD); } \
    G_STEP(MM, 1, xfb, xfa); if (DOSTORE) G_PART(2, NSTG, KTL, DOLOAD); \
    G_STEP(MM, 2, xfa, xfb); if (DOSTORE) G_PART(3, NSTG, KTL, DOLOAD); \
    G_STEP(MM, 3, xfb, xfa); }
#define G_COMPUTE(MM, STG) { const char* xs = lds + (STG) * G_STAGE; const char* wsm = xs + G_XB; \
    bf16x8 xfa[2], xfb[2], w01[2], wc[2]; \
    G_LDX(xfa, 0); G_LDW(w01, 0, 0); \
    G_STEP(MM, 0, xfa, xfb); G_STEP(MM, 1, xfb, xfa); G_STEP(MM, 2, xfa, xfb); G_STEP(MM, 3, xfb, xfa); }
    asm volatile("" ::: "memory");
    if (Epi::kFull || chunk == xcd) {
      G_GLOAD(xr0, wr0, 0);
      G_LSTORE(xr0, wr0, 0);
      __syncthreads();
      G_GLOAD(xr0, wr0, 1);
    }
#pragma unroll
    for (int c = 0; c < 2; ++c)
#pragma unroll
      for (int a = 0; a < 2; ++a)
#pragma unroll
        for (int b = 0; b < 2; ++b)
#pragma unroll
          for (int i = 0; i < 16; ++i) acc[c][a][b][i] = 0.f;
#define G_KLOOP(MM) for (int kt = 0; kt < nk; kt += 2) { \
        \
        \
      { const bool in_ = (kt + 2 < nk); const char* xb_ = in_ ? Xt : Xt_n; const char* wb_ = in_ ? Wtb : Wtb_n; \
        const int k2_ = in_ ? kt + 2 : (has_next ? 0 : nk - 1); G_COMPUTE_ST(MM, 0, true, 1, k2_, true); } \
      __syncthreads(); \
      { const bool in_ = (kt + 3 < nk); const char* xb_ = in_ ? Xt : Xt_n; const char* wb_ = in_ ? Wtb : Wtb_n; \
        const int k3_ = in_ ? kt + 3 : (has_next ? 1 : nk - 1); G_COMPUTE_ST(MM, 1, true, 0, k3_, true); } \
      __syncthreads(); \
    }
    const bool sw = Epi::kSwap && epi.swap_tile(nt_);
#define G_EPI_IDS const int t2 = tid_l(); const int r2 = t2 & 31, hh2 = (t2 >> 5) & 1, tw2 = (t2 >> 6) & 3, fw2 = t2 >> 8;
    if (sw) {
      G_KLOOP(G_MFMA4S)
      if constexpr (Epi::kSwap) {
        G_EPI_IDS
        epi.swapped(mt_ * 256 + tw2 * 64, nt_ * 256 + fw2 * 128, acc[0], r2, hh2);
        __builtin_amdgcn_sched_barrier(0);
        epi.swapped(mt_ * 256 + tw2 * 64, nt_ * 256 + fw2 * 128 + 64, acc[1], r2, hh2);
      }
    } else {
      G_KLOOP(G_MFMA4)
      G_EPI_IDS
      if constexpr (Epi::kFull) {
        epi.full(mt_, nt_, acc, tw2, fw2, r2, hh2, lds, t2);
      } else {
        epi(mt_ * 256 + tw2 * 64, nt_ * 256 + fw2 * 128, acc[0], r2, hh2);
        __builtin_amdgcn_sched_barrier(0);
        epi(mt_ * 256 + tw2 * 64, nt_ * 256 + fw2 * 128 + 64, acc[1], r2, hh2);
      }
    }
#undef G_EPI_IDS
#undef G_KLOOP
#undef G_GLOAD
#undef G_LSTORE
#undef G_COMPUTE
#undef G_PART
#undef G_COMPUTE_ST
#undef G_LDX
#undef G_LDW
#undef G_MFMA4
#undef G_MFMA4S
#undef G_STEP
    __builtin_amdgcn_sched_barrier(0);
  }
}

struct EpiEvenIn {
  static constexpr bool kFull = false, kSwap = false;
  DI bool swap_tile(int nt_) const { const int seg = nt_ >> 1; return seg == 2 || seg == 6; }
  char* r1; const float* lb;
#define aq  ((bf16_t*)(r1))
#define alf ((float*)(r1 + 32 * MiB))
#define aiT ((bf16_t*)(r1 + 96 * MiB))
#define ag  ((bf16_t*)(r1 + 128 * MiB))
#define bq  ((bf16_t*)(r1 + 160 * MiB))
#define bk  ((bf16_t*)(r1 + 192 * MiB))
#define bvT ((bf16_t*)(r1 + 224 * MiB))
  DI void operator()(int tok0, int feat0, f32x16 (&acc)[2][2], int r, int hh) const {
    const int seg = feat0 >> 9, c0 = feat0 & 511;
#pragma unroll
    for (int mt = 0; mt < 2; ++mt) {
      const int tok = tok0 + mt * 32 + r, b = tok >> 14, s = tok & (SEQ - 1);
#pragma unroll
      for (int nt = 0; nt < 2; ++nt)
#pragma unroll
        for (int g = 0; g < 4; ++g) {
          const int c = c0 + nt * 32 + 8 * g + 4 * hh;
          const float v0 = acc[nt][mt][4 * g], v1 = acc[nt][mt][4 * g + 1], v2 = acc[nt][mt][4 * g + 2], v3 = acc[nt][mt][4 * g + 3];
          if (seg == 0) { u32x2 o = {pk2(siluf_(v0), siluf_(v1)), pk2(siluf_(v2), siluf_(v3))}; *(u32x2*)(aq + (size_t)tok * 512 + c) = o; }
          else if (seg == 1) {
            f32x4 lbv = *(const f32x4*)(lb + c);
            f32x4 o;
            o[0] = __logf(lbv[0] + (1.f - lbv[0]) * sigmoidf_(v0)); o[1] = __logf(lbv[1] + (1.f - lbv[1]) * sigmoidf_(v1));
            o[2] = __logf(lbv[2] + (1.f - lbv[2]) * sigmoidf_(v2)); o[3] = __logf(lbv[3] + (1.f - lbv[3]) * sigmoidf_(v3));
            *(f32x4*)(alf + (size_t)tok * 512 + c) = o;
          }
          else if (seg == 3) { u32x2 o = {pk2(siluf_(v0), siluf_(v1)), pk2(siluf_(v2), siluf_(v3))}; *(u32x2*)(ag + (size_t)tok * 512 + c) = o; }
          else if (seg == 4) { const float sc = 0.125f * LOG2E; u32x2 o = {pk2(v0 * sc, v1 * sc), pk2(v2 * sc, v3 * sc)}; *(u32x2*)(bq + (size_t)tok * 512 + c) = o; }
          else if (seg == 5) { u32x2 o = {pk2(v0, v1), pk2(v2, v3)}; *(u32x2*)(bk + (size_t)tok * 512 + c) = o; }
          else if (seg == 2) {
            bf16_t* dst = aiT + ((size_t)((b * 4 + (c >> 7)) * 128 + (c & 127))) * SEQ + s;
            dst[0] = f2bf(v0); dst[SEQ] = f2bf(v1); dst[2 * SEQ] = f2bf(v2); dst[3 * SEQ] = f2bf(v3);
          }
          else if (seg == 6) {
            bf16_t* dst = bvT + ((size_t)((b * 4 + (c >> 7)) * 128 + (c & 127))) * SEQ + swz32(s);
            dst[0] = f2bf(v0); dst[SEQ] = f2bf(v1); dst[2 * SEQ] = f2bf(v2); dst[3 * SEQ] = f2bf(v3);
          }
          __builtin_amdgcn_sched_barrier(0);
        }
    }
  }
  DI void swapped(int tok0, int feat0, f32x16 (&acc)[2][2], int r, int hh) const {
    const int seg = feat0 >> 9, c0 = feat0 & 511;
#pragma unroll
    for (int nt = 0; nt < 2; ++nt) {
      const int c = c0 + nt * 32 + r;
#pragma unroll
      for (int mt = 0; mt < 2; ++mt)
#pragma unroll
        for (int g = 0; g < 4; ++g) {
          const int tok = tok0 + mt * 32 + 8 * g + 4 * hh, b = tok >> 14, s = tok & (SEQ - 1);
          u32x2 o = {pk2(acc[nt][mt][4 * g], acc[nt][mt][4 * g + 1]), pk2(acc[nt][mt][4 * g + 2], acc[nt][mt][4 * g + 3])};
          bf16_t* base = (seg == 2 ? aiT : bvT) + ((size_t)((b * 4 + (c >> 7)) * 128 + (c & 127))) * SEQ;
          *(u32x2*)(base + (seg == 2 ? s : swz32(s))) = o;
        }
    }
  }
};

#undef aq
#undef alf
#undef aiT
#undef ag
#undef bq
#undef bk
#undef bvT
struct EpiOddIn {
  static constexpr bool kFull = false, kSwap = false;
  DI bool swap_tile(int nt_) const { return (nt_ >> 2) == 2; }
  char* r1; float* lf; const float *qg, *kg, *bf;
#define fq  ((bf16_t*)(r1))
#define fk  ((bf16_t*)(r1 + 64 * MiB))
#define fvT ((bf16_t*)(r1 + 128 * MiB))
#define fg  ((bf16_t*)(r1 + 192 * MiB))
  DI void operator()(int tok0, int feat0, f32x16 (&acc)[2][2], int r, int hh) const {
    const int seg = feat0 >> 10, c0 = feat0 & 1023;
#pragma unroll
    for (int mt = 0; mt < 2; ++mt) {
      const int tok = tok0 + mt * 32 + r, b = tok >> 14, s = tok & (SEQ - 1);
      if (seg < 2) {
        float ssq = 0.f;
#pragma unroll
        for (int nt = 0; nt < 2; ++nt)
#pragma unroll
          for (int i = 0; i < 16; ++i) ssq += acc[nt][mt][i] * acc[nt][mt][i];
        ssq = xsum32(ssq);
        float rs = rsqrtf(ssq * (1.f / 64.f) + 1e-6f);
        if (seg == 0) rs *= 0.125f * LOG2E;
        const float* gg = seg == 0 ? qg : kg;
        bf16_t* dstb = (seg == 0 ? fq : fk) + (size_t)tok * 1024 + c0;
#pragma unroll
        for (int nt = 0; nt < 2; ++nt)
#pragma unroll
          for (int g = 0; g < 4; ++g) {
            const int d = nt * 32 + 8 * g + 4 * hh;
            f32x4 gv = *(const f32x4*)(gg + d);
            u32x2 o = {pk2(acc[nt][mt][4 * g] * rs * gv[0], acc[nt][mt][4 * g + 1] * rs * gv[1]), pk2(acc[nt][mt][4 * g + 2] * rs * gv[2], acc[nt][mt][4 * g + 3] * rs * gv[3])};
            *(u32x2*)(dstb + d) = o;
            __builtin_amdgcn_sched_barrier(0);
          }
      } else if (seg == 2) {
        const int head = c0 >> 6;
#pragma unroll
        for (int nt = 0; nt < 2; ++nt)
#pragma unroll
          for (int g = 0; g < 4; ++g) {
            const int d = nt * 32 + 8 * g + 4 * hh;
            bf16_t* dst = fvT + ((size_t)((b * 16 + head) * 64 + d)) * SEQ + swz32(s);
            dst[0] = f2bf(acc[nt][mt][4 * g]); dst[SEQ] = f2bf(acc[nt][mt][4 * g + 1]); dst[2 * SEQ] = f2bf(acc[nt][mt][4 * g + 2]); dst[3 * SEQ] = f2bf(acc[nt][mt][4 * g + 3]);
          }
      } else if (seg == 3) {
#pragma unroll
        for (int nt = 0; nt < 2; ++nt)
#pragma unroll
          for (int g = 0; g < 4; ++g) {
            const int c = c0 + nt * 32 + 8 * g + 4 * hh;
            u32x2 o = {pk2(sigmoidf_(acc[nt][mt][4 * g]), sigmoidf_(acc[nt][mt][4 * g + 1])), pk2(sigmoidf_(acc[nt][mt][4 * g + 2]), sigmoidf_(acc[nt][mt][4 * g + 3]))};
            *(u32x2*)(fg + (size_t)tok * 1024 + c) = o;
            __builtin_amdgcn_sched_barrier(0);
          }
      } else if (feat0 == 4096) {
#pragma unroll
        for (int g = 0; g < 2; ++g)
#pragma unroll
          for (int j = 0; j < 4; ++j) {
            const int hd = 8 * g + 4 * hh + j;
            const float xv = acc[0][mt][4 * g + j] + bf[hd];
            const float ls = fminf(xv, 0.f) - log1pf(expf(-fabsf(xv)));
            lf[((size_t)(b * 16 + hd)) * SEQ + s] = ls;
          }
      }
    }
  }
  DI void swapped(int tok0, int feat0, f32x16 (&acc)[2][2], int r, int hh) const {
    const int head = (feat0 & 1023) >> 6;
#pragma unroll
    for (int nt = 0; nt < 2; ++nt) {
      const int d = nt * 32 + r;
#pragma unroll
      for (int mt = 0; mt < 2; ++mt)
#pragma unroll
        for (int g = 0; g < 4; ++g) {
          const int tok = tok0 + mt * 32 + 8 * g + 4 * hh, b = tok >> 14, s = tok & (SEQ - 1);
          u32x2 o = {pk2(acc[nt][mt][4 * g], acc[nt][mt][4 * g + 1]), pk2(acc[nt][mt][4 * g + 2], acc[nt][mt][4 * g + 3])};
          *(u32x2*)(fvT + ((size_t)((b * 16 + head) * 64 + d)) * SEQ + swz32(s)) = o;
        }
    }
  }
};

#undef fq
#undef fk
#undef fvT
#undef fg
struct EpiRes {
  static constexpr bool kFull = false;
  const float* xin; float* y;
  DI void operator()(int tok0, int feat0, f32x16 (&acc)[2][2], int r, int hh) const {
#pragma unroll
    for (int mt = 0; mt < 2; ++mt) {
      const size_t rowo = (size_t)(tok0 + mt * 32 + r) * 1024;
#pragma unroll
      for (int nt = 0; nt < 2; ++nt)
#pragma unroll
        for (int g = 0; g < 4; ++g) {
          const int c = feat0 + nt * 32 + 8 * g + 4 * hh;
          f32x4 xv = *(const f32x4*)(xin + rowo + c);
          f32x4 o = {ALPHA * xv[0] + acc[nt][mt][4 * g], ALPHA * xv[1] + acc[nt][mt][4 * g + 1], ALPHA * xv[2] + acc[nt][mt][4 * g + 2], ALPHA * xv[3] + acc[nt][mt][4 * g + 3]};
          *(f32x4*)(y + rowo + c) = o;
          if (g & 1) __builtin_amdgcn_sched_barrier(0);
        }
    }
  }
};

struct EpiResLN {
  static constexpr bool kFull = true, kSwap = false;
  DI bool swap_tile(int) const { return false; }
  const float* xin; float* xout; bf16_t* xb; const float *g, *b; float* xchg; unsigned* cnt; unsigned target;
  DI void full(const int mt_, const int nt_, f32x16 (&acc)[2][2][2], const int tw, const int fw, const int r, const int hh, char* lds, const int tid) const {
    float* part = (float*)(lds + G_STAGE);
    const size_t rbase = (size_t)(mt_ * 256 + tw * 64 + r) * 1024 + nt_ * 256 + fw * 128 + 4 * hh;
    f32x4 xa[4], xc[4], xe[4];
#define RL_LOAD(XV, G) { constexpr int mt__ = (G) >> 2, half__ = ((G) >> 1) & 1, nt__ = (G) & 1; \
    _Pragma("unroll") for (int gq = 0; gq < 4; ++gq) XV[gq] = *(const f32x4*)(xin + rbase + (size_t)mt__ * 32 * 1024 + half__ * 64 + nt__ * 32 + 8 * gq); }
#define RL_FOLD(XV, G, SM, SQ) { constexpr int mt__ = (G) >> 2, half__ = ((G) >> 1) & 1, nt__ = (G) & 1; \
    _Pragma("unroll") for (int gq = 0; gq < 4; ++gq) _Pragma("unroll") for (int jj = 0; jj < 4; ++jj) { \
      const float y = ALPHA * XV[gq][jj] + acc[half__][nt__][mt__][4 * gq + jj]; acc[half__][nt__][mt__][4 * gq + jj] = y; SM += y; SQ += y * y; } }
#define SB __builtin_amdgcn_sched_barrier(0)
    float sm0 = 0.f, sq0 = 0.f, sm1 = 0.f, sq1 = 0.f;
    RL_LOAD(xa, 0); RL_LOAD(xc, 1); RL_LOAD(xe, 2); SB;
    RL_FOLD(xa, 0, sm0, sq0); SB; RL_LOAD(xa, 3); SB;
    RL_FOLD(xc, 1, sm0, sq0); SB; RL_LOAD(xc, 4); SB;
    RL_FOLD(xe, 2, sm0, sq0); SB; RL_LOAD(xe, 5); SB;
    RL_FOLD(xa, 3, sm0, sq0); SB; RL_LOAD(xa, 6); SB;
    RL_FOLD(xc, 4, sm1, sq1); SB; RL_LOAD(xc, 7); SB;
    RL_FOLD(xe, 5, sm1, sq1); SB;
    RL_FOLD(xa, 6, sm1, sq1); SB;
    RL_FOLD(xc, 7, sm1, sq1);
#undef SB
#undef RL_LOAD
#undef RL_FOLD
    sm0 += __shfl_xor(sm0, 32, 64); sq0 += __shfl_xor(sq0, 32, 64); sm1 += __shfl_xor(sm1, 32, 64); sq1 += __shfl_xor(sq1, 32, 64);
    if (hh == 0) {
      float* pp = part + ((fw * 256) + tw * 64 + r) * 2; pp[0] = sm0; pp[1] = sq0;
      pp[64] = sm1; pp[65] = sq1;
    }
    __syncthreads();
    if (tid < 256) {
      f32x2 a = *(const f32x2*)(part + tid * 2), c = *(const f32x2*)(part + (256 + tid) * 2);
      const unsigned long long pk = ((unsigned long long)__float_as_uint(a[1] + c[1]) << 32) | (unsigned long long)__float_as_uint(a[0] + c[0]);
      __hip_atomic_store((GAS unsigned long long*)(xchg + ((size_t)(mt_ * 4 + nt_) * 256 + tid) * 2), pk, __ATOMIC_RELAXED, __HIP_MEMORY_SCOPE_AGENT);
    }
    asm volatile("s_waitcnt vmcnt(0)" ::: "memory");
    __syncthreads();
    if (tid == 0) {
      __hip_atomic_fetch_add((GAS unsigned*)(cnt + mt_), 1u, __ATOMIC_RELAXED, __HIP_MEMORY_SCOPE_AGENT);
      while (__hip_atomic_load((GAS unsigned*)(cnt + mt_), __ATOMIC_RELAXED, __HIP_MEMORY_SCOPE_AGENT) < target) __builtin_amdgcn_s_sleep(1);
    }
    __syncthreads();
#pragma unroll
    for (int mt = 0; mt < 2; ++mt) {
      const int tl = tw * 64 + mt * 32 + r;
      float S = 0.f, Q = 0.f;
#pragma unroll
      for (int k = 0; k < 4; ++k) {
        const unsigned long long pk = __hip_atomic_load((GAS unsigned long long*)(xchg + ((size_t)(mt_ * 4 + k) * 256 + tl) * 2), __ATOMIC_RELAXED, __HIP_MEMORY_SCOPE_AGENT);
        S += __uint_as_float((unsigned)pk);
        Q += __uint_as_float((unsigned)(pk >> 32));
      }
      const float mean = S * (1.f / 1024.f);
      const float rstd = rsqrtf(fmaxf(Q * (1.f / 1024.f) - mean * mean, 0.f) + 1e-5f);
      const int c0 = nt_ * 256 + fw * 128 + 4 * hh;
      const size_t rowo = (size_t)(mt_ * 256 + tl) * 1024 + c0;
#pragma unroll
      for (int half = 0; half < 2; ++half)
#pragma unroll
        for (int nt = 0; nt < 2; ++nt) {
#pragma unroll
          for (int gq = 0; gq < 4; ++gq) {
            const int co = half * 64 + nt * 32 + 8 * gq;
            f32x4 gv = *(const f32x4*)(g + c0 + co), bv = *(const f32x4*)(b + c0 + co), o;
#pragma unroll
            for (int jj = 0; jj < 4; ++jj) o[jj] = (acc[half][nt][mt][4 * gq + jj] - mean) * rstd * gv[jj] + bv[jj];
            *(f32x4*)(xout + rowo + co) = o;
            u32x2 ob = {pk2(o[0], o[1]), pk2(o[2], o[3])};
            *(u32x2*)(xb + rowo + co) = ob;
          }
          __builtin_amdgcn_sched_barrier(0);
        }
    }
    __syncthreads();
  }
};

struct EpiW1 {
  static constexpr bool kFull = false, kSwap = false;
  DI bool swap_tile(int) const { return false; }
  DI void swapped(int, int, f32x16 (&)[2][2], int, int) const {}
  bf16_t* act;
  DI void operator()(int tok0, int feat0, f32x16 (&acc)[2][2], int r, int hh) const {
    const int u0 = (feat0 >> 6) * 32;
#pragma unroll
    for (int mt = 0; mt < 2; ++mt) {
      bf16_t* dst = act + (size_t)(tok0 + mt * 32 + r) * DFF + u0 + 16 * hh;
#pragma unroll
      for (int gp = 0; gp < 2; ++gp) {
        u32x4 o;
#pragma unroll
        for (int q = 0; q < 4; ++q) { const int i = 8 * gp + 2 * q; o[q] = pk2(siluf_(acc[0][mt][i]) * acc[1][mt][i], siluf_(acc[0][mt][i + 1]) * acc[1][mt][i + 1]); }
        *(u32x4*)(dst + 8 * gp) = o;
      }
    }
  }
};

DI float wave_sum(float v) {
#pragma unroll
  for (int o = 32; o >= 1; o >>= 1) v += __shfl_xor(v, o, 64);
  return v;
}
DI void ln_phase(float* x, bf16_t* xb, const float* __restrict__ g, const float* __restrict__ bta) {
  const int tid = tid_l(); const int lane = tid & 63, wave = tid >> 6;
  for (int row = blockIdx.x * 8 + wave; row < NTOK; row += gridDim.x * 8) {
    float* xr = x + (size_t)row * 1024;
    f32x4 v[4];
    float s = 0.f;
#pragma unroll
    for (int i = 0; i < 4; ++i) { v[i] = *(const f32x4*)(xr + (i * 64 + lane) * 4); s += v[i][0] + v[i][1] + v[i][2] + v[i][3]; }
    const float mean = wave_sum(s) * (1.f / 1024.f);
    float q = 0.f;
#pragma unroll
    for (int i = 0; i < 4; ++i)
#pragma unroll
      for (int j = 0; j < 4; ++j) { const float d = v[i][j] - mean; q += d * d; }
    const float rstd = rsqrtf(wave_sum(q) * (1.f / 1024.f) + 1e-5f);
#pragma unroll
    for (int i = 0; i < 4; ++i) {
      const int c = (i * 64 + lane) * 4;
      f32x4 gv = *(const f32x4*)(g + c), bv = *(const f32x4*)(bta + c), o;
#pragma unroll
      for (int j = 0; j < 4; ++j) o[j] = (v[i][j] - mean) * rstd * gv[j] + bv[j];
      *(f32x4*)(xr + c) = o;
      u32x2 ob = {pk2(o[0], o[1]), pk2(o[2], o[3])};
      *(u32x2*)(xb + (size_t)row * 1024 + c) = ob;
    }
  }
}

DI void cumsum_phase(const float* __restrict__ lf, float* __restrict__ c2, char* lds) {
  float* wt = (float*)lds;
  const int tid = tid_l(), lane = tid & 63, wave = tid >> 6;
  for (int row = blockIdx.x; row < 32; row += gridDim.x) {
    const float* src = lf + (size_t)row * SEQ + tid * 32;
    float v[32];
#pragma unroll
    for (int i = 0; i < 8; ++i) { f32x4 t = *(const f32x4*)(src + 4 * i); v[4 * i] = t[0]; v[4 * i + 1] = t[1]; v[4 * i + 2] = t[2]; v[4 * i + 3] = t[3]; }
    float run = 0.f;
#pragma unroll
    for (int i = 0; i < 32; ++i) { run += v[i]; v[i] = run; }
    float inc = run;
#pragma unroll
    for (int o = 1; o < 64; o <<= 1) { const float t = __shfl_up(inc, o, 64); if (lane >= o) inc += t; }
    if (lane == 63) wt[wave] = inc;
    __syncthreads();
    float pre = inc - run;
    for (int w = 0; w < wave; ++w) pre += wt[w];
    float* dst = c2 + (size_t)row * SEQ + tid * 32;
#pragma unroll
    for (int i = 0; i < 8; ++i) { f32x4 o = {(pre + v[4 * i]) * LOG2E, (pre + v[4 * i + 1]) * LOG2E, (pre + v[4 * i + 2]) * LOG2E, (pre + v[4 * i + 3]) * LOG2E}; *(f32x4*)(dst + 4 * i) = o; }
    __syncthreads();
  }
}

template <int DVT, bool FOX>
DI void attn_step(const char* kb, const bf16x8 (&qf)[4], f32x16 (&o)[DVT], float& m, float& l, const bool diag, const int j, const int tq, const int r, const int hh) {
  constexpr int VB = DVT * 32 * LROW;
  const char* vb = kb + 64 * LROW; const char* cb = vb + VB;
  f32x16 st[2];
  bf16x8 kf[8];
#pragma unroll
  for (int ks = 0; ks < 4; ++ks)
#pragma unroll
    for (int kt = 0; kt < 2; ++kt) kf[ks * 2 + kt] = *(const bf16x8*)(kb + (kt * 32 + r) * LROW + ks * 32 + hh * 16);
  if (FOX) {
#pragma unroll
    for (int kt = 0; kt < 2; ++kt)
#pragma unroll
      for (int g = 0; g < 4; ++g) {
        f32x4 cs = *(const f32x4*)(cb + (kt * 32 + 8 * g + 4 * hh) * 4);
        st[kt][4 * g] = cs[0]; st[kt][4 * g + 1] = cs[1]; st[kt][4 * g + 2] = cs[2]; st[kt][4 * g + 3] = cs[3];
      }
  } else {
#pragma unroll
    for (int kt = 0; kt < 2; ++kt)
#pragma unroll
      for (int i = 0; i < 16; ++i) st[kt][i] = 0.f;
  }
  __builtin_amdgcn_sched_barrier(0);
#pragma unroll
  for (int ks = 0; ks < 4; ++ks)
#pragma unroll
    for (int kt = 0; kt < 2; ++kt) st[kt] = MFMA32(kf[ks * 2 + kt], qf[ks], st[kt]);
  bf16x8 va[DVT], vn[DVT];
#pragma unroll
  for (int d = 0; d < DVT; ++d) va[d] = *(const bf16x8*)(vb + (d * 32 + r) * LROW + (8 * hh) * 2);
  __builtin_amdgcn_sched_barrier(0);
  {
    const f32x2 mm = {m, m};
#pragma unroll
    for (int kt = 0; kt < 2; ++kt)
#pragma unroll
      for (int i = 0; i < 8; ++i) { f32x2 z = {st[kt][2 * i], st[kt][2 * i + 1]}; z = z - mm; st[kt][2 * i] = z[0]; st[kt][2 * i + 1] = z[1]; }
  }
  if (FOX) {
    if (diag) {
#pragma unroll
      for (int kt = 0; kt < 2; ++kt)
#pragma unroll
        for (int i = 0; i < 16; ++i) {
          const int key = j * 64 + kt * 32 + (i & 3) + 8 * (i >> 2) + 4 * hh;
          if (key > tq) st[kt][i] = -INFINITY;
        }
    }
  }
  float mx;
  {
    float a0 = fmaxf(fmaxf(st[0][0], st[0][1]), st[0][2]), a1 = fmaxf(fmaxf(st[1][0], st[1][1]), st[1][2]);
#pragma unroll
    for (int i = 3; i < 15; i += 2) { a0 = fmaxf(fmaxf(a0, st[0][i]), st[0][i + 1]); a1 = fmaxf(fmaxf(a1, st[1][i]), st[1][i + 1]); }
    mx = fmaxf(fmaxf(a0, a1), fmaxf(st[0][15], st[1][15]));
  }
  mx = xmax32(mx);
  if (__any(diag || mx > 8.f)) {
    const float d = (diag || mx > 0.f) ? mx : 0.f;
    const float alpha = diag ? 0.f : __builtin_amdgcn_exp2f(-d);
    m += d;
    l *= alpha;
#pragma unroll
    for (int dd = 0; dd < DVT; ++dd)
#pragma unroll
      for (int i = 0; i < 16; ++i) o[dd][i] *= alpha;
    const f32x2 d2 = {d, d};
#pragma unroll
    for (int kt = 0; kt < 2; ++kt)
#pragma unroll
      for (int i = 0; i < 8; ++i) { f32x2 z = {st[kt][2 * i], st[kt][2 * i + 1]}; z = z - d2; st[kt][2 * i] = z[0]; st[kt][2 * i + 1] = z[1]; }
  }
  f32x2 ls2 = {0.f, 0.f};
#pragma unroll
  for (int kt = 0; kt < 2; ++kt)
#pragma unroll
    for (int i = 0; i < 8; ++i) {
      f32x2 pv = {__builtin_amdgcn_exp2f(st[kt][2 * i]), __builtin_amdgcn_exp2f(st[kt][2 * i + 1])};
      st[kt][2 * i] = pv[0]; st[kt][2 * i + 1] = pv[1];
      ls2 = ls2 + pv;
    }
  l += ls2[0] + ls2[1];
  __builtin_amdgcn_sched_barrier(0);
#define A_PVGROUP(GK, VC, VN) { constexpr int kt_ = (GK) >> 1, s2_ = (GK) & 1; \
    if ((GK) < 3) { constexpr int kt1_ = ((GK) + 1) >> 1, s21_ = ((GK) + 1) & 1; \
      _Pragma("unroll") for (int d = 0; d < DVT; ++d) VN[d] = *(const bf16x8*)(vb + (d * 32 + r) * LROW + (kt1_ * 32 + 16 * s21_ + 8 * hh) * 2); } \
    u32x4 pw_ = {pk2(st[kt_][8 * s2_], st[kt_][8 * s2_ + 1]), pk2(st[kt_][8 * s2_ + 2], st[kt_][8 * s2_ + 3]), pk2(st[kt_][8 * s2_ + 4], st[kt_][8 * s2_ + 5]), pk2(st[kt_][8 * s2_ + 6], st[kt_][8 * s2_ + 7])}; \
    const bf16x8 pf_ = __builtin_bit_cast(bf16x8, pw_); \
    __builtin_amdgcn_sched_barrier(0); \
    _Pragma("unroll") for (int d = 0; d < DVT; ++d) o[d] = MFMA32(VC[d], pf_, o[d]); \
    __builtin_amdgcn_sched_barrier(0); }
  A_PVGROUP(0, va, vn); A_PVGROUP(1, vn, va); A_PVGROUP(2, va, vn); A_PVGROUP(3, vn, va);
#undef A_PVGROUP
}

template <int DVT, bool FOX>
DI void attn_pass(const bf16_t* __restrict__ qrow, const bf16_t* __restrict__ kbase, const int ldk, const bf16_t* __restrict__ vtbase,
                  const float* __restrict__ cbase, const int j_hi, const int my_last, const int j_lo_diag, const int tq, const float prune_c,
                  f32x16 (&o)[DVT], float& l_out, char* lds) {
  constexpr int VB = DVT * 32 * LROW;
  constexpr int STAGE = 64 * LROW + VB + 256;
  const int tid = tid_l(), lane = tid & 63;
  const int r = lane & 31, hh = lane >> 5;
  const int lrow = tid >> 3, lch = tid & 7;
  bf16x8 qf[4];
#pragma unroll
  for (int ks = 0; ks < 4; ++ks) qf[ks] = *(const bf16x8*)(qrow + ks * 16 + hh * 8);
#pragma unroll
  for (int d = 0; d < DVT; ++d)
#pragma unroll
    for (int i = 0; i < 16; ++i) o[d][i] = 0.f;
  float m = 0.f, l = 0.f;
  u32x4 kr0, kr1, vr0[DVT / 2], vr1[DVT / 2]; f32x4 cr0 = {0.f, 0.f, 0.f, 0.f}, cr1 = {0.f, 0.f, 0.f, 0.f};
  const bf16_t* kp = kbase + (size_t)lrow * ldk + lch * 8;
  const bf16_t* vp = vtbase + (size_t)lrow * SEQ + lch * 8;
#define A_GLOAD(KR, VR, CR, JT) { const int s1_ = (JT) * 64; KR = *(const u32x4*)(kp + (size_t)s1_ * ldk); \
    _Pragma("unroll") for (int i_ = 0; i_ < DVT / 2; ++i_) VR[i_] = *(const u32x4*)(vp + (size_t)(64 * i_) * SEQ + s1_); \
    if (FOX) { if (tid < 16) { f32x4 t_ = *(const f32x4*)(cbase + s1_ + tid * 4); CR[0] = -t_[0]; CR[1] = -t_[1]; CR[2] = -t_[2]; CR[3] = -t_[3]; } } }
#define A_LSTORE(KR, VR, CR, STG) { char* kb_ = lds + (STG) * STAGE; char* vb_ = kb_ + 64 * LROW; char* cb_ = vb_ + VB; \
    *(u32x4*)(kb_ + lrow * LROW + lch * 16) = KR; \
    _Pragma("unroll") for (int i_ = 0; i_ < DVT / 2; ++i_) *(u32x4*)(vb_ + (lrow + 64 * i_) * LROW + lch * 16) = VR[i_]; \
    if (FOX) { if (tid < 16) *(f32x4*)(cb_ + tid * 16) = CR; } }
#define A_PRUNE(STG) (FOX && j < j_lo_diag && (prune_c + *(const float*)(lds + (STG) * STAGE + 64 * LROW + VB + 63 * 4) < -160.f))
  int j = j_hi;
  A_GLOAD(kr0, vr0, cr0, j);
  if (j >= 1) A_GLOAD(kr1, vr1, cr1, j - 1);
  A_LSTORE(kr0, vr0, cr0, 0);
  __syncthreads();
  for (;;) {
    if (A_PRUNE(0)) break;
    if (j >= 2) A_GLOAD(kr0, vr0, cr0, j - 2);
    if (j <= my_last) attn_step<DVT, FOX>(lds, qf, o, m, l, j == my_last, j, tq, r, hh);
    if (j == 0) break;
    A_LSTORE(kr1, vr1, cr1, 1);
    __syncthreads();
    --j;
    if (A_PRUNE(1)) break;
    if (j >= 2) A_GLOAD(kr1, vr1, cr1, j - 2);
    if (j <= my_last) attn_step<DVT, FOX>(lds + STAGE, qf, o, m, l, j == my_last, j, tq, r, hh);
    if (j == 0) break;
    A_LSTORE(kr0, vr0, cr0, 0);
    __syncthreads();
    --j;
  }
  __syncthreads();
#undef A_GLOAD
#undef A_LSTORE
#undef A_PRUNE
  l_out = xsum32(l);
}

DI void fox_phase(const Params& p, const int j_odd, char* lds) {
  char* ws = (char*)launder(p.ws);
  const bf16_t* fq = (const bf16_t*)(ws + OFF_R1);
  const bf16_t* fk = (const bf16_t*)(ws + OFF_R1 + 64 * MiB);
  const bf16_t* fvT = (const bf16_t*)(ws + OFF_R1 + 128 * MiB);
  const bf16_t* fg = (const bf16_t*)(ws + OFF_R1 + 192 * MiB);
  const float* c2 = (const float*)(ws + OFF_C2);
  bf16_t* ab = (bf16_t*)(ws + OFF_AB);
  const float b2 = ((const float*)(ws + OFF_MISC))[1032 + j_odd];
  const int tid = tid_l(); const int lane = tid & 63, wave = __builtin_amdgcn_readfirstlane(tid >> 6), r = lane & 31, hh = lane >> 5;
  for (int rnd = 0; rnd < 4; ++rnd) {
    const int bh = rnd * 8 + (blockIdx.x & 7), pp = blockIdx.x >> 3, b = bh >> 4, h = bh & 15;
    for (int half = 0; half < 2; ++half) {
      const int qb = half == 0 ? 63 - pp : pp;
      const int t0 = qb * 256, tq0 = t0 + wave * 32, tq = tq0 + r;
      const int nkv = (t0 + 256) >> 6, my_last = (tq0 + 31) >> 6;
      const float prune_c = b2 + c2[(size_t)bh * SEQ + t0];
      f32x16 o[2]; float l;
      attn_pass<2, true>(fq + (size_t)(b * SEQ + tq) * 1024 + h * 64, fk + (size_t)(b * SEQ) * 1024 + h * 64, 1024,
                         fvT + (size_t)(bh * 64) * SEQ, c2 + (size_t)bh * SEQ, nkv - 1, my_last, t0 >> 6, tq, prune_c, o, l, lds);
      const float inv = 1.f / l;
      const size_t rowo = (size_t)(b * SEQ + tq) * 1024 + h * 64;
#pragma unroll
      for (int d = 0; d < 2; ++d)
#pragma unroll
        for (int g = 0; g < 4; ++g) {
          const int c = d * 32 + 8 * g + 4 * hh;
          u32x2 gv = *(const u32x2*)(fg + rowo + c);
          const float g0 = __uint_as_float(gv[0] << 16), g1 = __uint_as_float(gv[0] & 0xffff0000u), g2 = __uint_as_float(gv[1] << 16), g3 = __uint_as_float(gv[1] & 0xffff0000u);
          u32x2 ov = {pk2(o[d][4 * g] * inv * g0, o[d][4 * g + 1] * inv * g1), pk2(o[d][4 * g + 2] * inv * g2, o[d][4 * g + 3] * inv * g3)};
          *(u32x2*)(ab + rowo + c) = ov;
        }
    }
  }
}

DI void diff_phase(const Params& p, const int j_even, char* lds) {
  char* ws = (char*)launder(p.ws);
  const bf16_t* bq = (const bf16_t*)(ws + OFF_R1 + 160 * MiB);
  const bf16_t* bk = (const bf16_t*)(ws + OFF_R1 + 192 * MiB);
  const bf16_t* bvT = (const bf16_t*)(ws + OFF_R1 + 224 * MiB);
  bf16_t* ab = (bf16_t*)(ws + OFF_AB);
  const float* misc = (const float*)(ws + OFF_MISC);
  const float lam = misc[1024 + j_even];
  const float lam_init = 0.8f - 0.6f * expf(-0.3f * (float)(2 * j_even));
  const float* dg = ((const float*)p.diff_g) + j_even * 128;
  const int tid = tid_l(); const int lane = tid & 63, wave = __builtin_amdgcn_readfirstlane(tid >> 6), r = lane & 31, hh = lane >> 5;
  {
    const int bh = blockIdx.x & 7, pp = blockIdx.x >> 3, b = bh >> 2, h = bh & 3;
    for (int half = 0; half < 2; ++half) {
      const int qb = half == 0 ? 63 - pp : pp;
      const int t0 = qb * 256, tq0 = t0 + wave * 32, tq = tq0 + r;
      const int nkv = (t0 + 256) >> 6, my_last = tq0 >> 6;
      f32x16 o1[4], o2[4]; float l1, l2;
      attn_pass<4, false>(bq + (size_t)(b * SEQ + tq) * 512 + h * 128, bk + (size_t)(b * SEQ) * 512 + h * 128, 512,
                          bvT + (size_t)(bh * 128) * SEQ, nullptr, nkv - 1, my_last, 0, tq, 0.f, o1, l1, lds);
      const float i1 = 1.f / l1;
      unsigned* o1s = (unsigned*)(lds + DIFF_STASH_OFF) + tid;
#pragma unroll
      for (int d = 0; d < 4; ++d)
#pragma unroll
        for (int i = 0; i < 8; ++i) o1s[(d * 8 + i) * 512] = pk2(o1[d][2 * i] * i1, o1[d][2 * i + 1] * i1);
      attn_pass<4, false>(bq + (size_t)(b * SEQ + tq) * 512 + h * 128 + 64, bk + (size_t)(b * SEQ) * 512 + h * 128 + 64, 512,
                          bvT + (size_t)(bh * 128) * SEQ, nullptr, nkv - 1, my_last, 0, tq, 0.f, o2, l2, lds);
      const float i2 = lam / l2;
      float ssq = 0.f;
#pragma unroll
      for (int d = 0; d < 4; ++d)
#pragma unroll
        for (int i = 0; i < 8; ++i) {
          const unsigned pw = o1s[(d * 8 + i) * 512];
          const float va = __uint_as_float(pw << 16) - i2 * o2[d][2 * i], vb = __uint_as_float(pw & 0xffff0000u) - i2 * o2[d][2 * i + 1];
          o2[d][2 * i] = va; o2[d][2 * i + 1] = vb; ssq += va * va + vb * vb; }
      ssq = xsum32(ssq);
      const float rs = rsqrtf(ssq * (1.f / 128.f) + 1e-6f) * (1.f - lam_init);
      const size_t rowo = (size_t)(b * SEQ + tq) * 1024 + 512 + h * 128;
#pragma unroll
      for (int d = 0; d < 4; ++d)
#pragma unroll
        for (int g = 0; g < 4; ++g) {
          const int c = d * 32 + 8 * g + 4 * hh;
          f32x4 gv = *(const f32x4*)(dg + c);
          u32x2 ov = {pk2(o2[d][4 * g] * rs * gv[0], o2[d][4 * g + 1] * rs * gv[1]), pk2(o2[d][4 * g + 2] * rs * gv[2], o2[d][4 * g + 3] * rs * gv[3])};
          *(u32x2*)(ab + rowo + c) = ov;
        }
    }
  }
}

DI void hgrn_stageA(const Params& p, char* lds) {
  char* ws = (char*)launder(p.ws);
  const float* alf = (const float*)(ws + OFF_R1 + 32 * MiB);
  const bf16_t* aiT = (const bf16_t*)(ws + OFF_R1 + 96 * MiB);
  bf16_t* UT = (bf16_t*)(ws + OFF_UT);
  float* dbuf = (float*)(ws + OFF_DB);
  float* lfT = (float*)lds;
  float* part = (float*)(lds + 32768);
  char* KT = lds + 34816;
  char* IT = KT + 18432;
  const int tid = tid_l(), lane = tid & 63, wave = tid >> 6, r = lane & 31, hh = lane >> 5;
  f32x4 lfr[4]; u32x4 itr[2];
#define HA_FETCH(TASK) { const int bh_ = (TASK) >> 8, c_ = (TASK) & 255, tok0_ = (bh_ >> 2) * SEQ + c_ * 64, h_ = bh_ & 3; \
    _Pragma("unroll") for (int i = 0; i < 4; ++i) { const int idx = tid + 512 * i, row = idx >> 5, c4 = idx & 31; \
      lfr[i] = *(const f32x4*)(alf + (size_t)(tok0_ + row) * 512 + h_ * 128 + c4 * 4); } \
    _Pragma("unroll") for (int i = 0; i < 2; ++i) { const int idx = tid + 512 * i, row = idx >> 3, ch = idx & 7; \
      itr[i] = *(const u32x4*)(aiT + (size_t)(bh_ * 128 + row) * SEQ + c_ * 64 + ch * 8); } }
  if (blockIdx.x < 2048) HA_FETCH(blockIdx.x);
  for (int task = blockIdx.x; task < 2048; task += gridDim.x) {
    const int bh = task >> 8, c = task & 255;
#pragma unroll
    for (int i = 0; i < 4; ++i) { const int idx = tid + 512 * i, row = idx >> 5, c4 = idx & 31; *(f32x4*)(lfT + row * 128 + c4 * 4) = lfr[i]; }
#pragma unroll
    for (int i = 0; i < 2; ++i) { const int idx = tid + 512 * i, row = idx >> 3, ch = idx & 7; *(u32x4*)(IT + row * LROW + ch * 16) = itr[i]; }
    if (task + (int)gridDim.x < 2048) HA_FETCH(task + (int)gridDim.x);
    (void)bh; (void)c;
    __syncthreads();
    const int k = tid & 127, seg = tid >> 7;
    float lv[16], bv[16];
    float run = 0.f;
#pragma unroll
    for (int i = 0; i < 16; ++i) { lv[i] = lfT[(seg * 16 + i) * 128 + k]; run += lv[i]; bv[i] = run; }
    part[seg * 128 + k] = run;
    __syncthreads();
    float pre = 0.f, tot = 0.f;
#pragma unroll
    for (int s2 = 0; s2 < 4; ++s2) { const float pv = part[s2 * 128 + k]; if (s2 < seg) pre += pv; tot += pv; }
    {
      float kv[16];
#pragma unroll
      for (int i = 0; i < 16; ++i) kv[i] = (1.f - __expf(lv[i])) * __expf(tot - (pre + bv[i]));
      u32x4 w0 = {pk2(kv[0], kv[1]), pk2(kv[2], kv[3]), pk2(kv[4], kv[5]), pk2(kv[6], kv[7])};
      u32x4 w1 = {pk2(kv[8], kv[9]), pk2(kv[10], kv[11]), pk2(kv[12], kv[13]), pk2(kv[14], kv[15])};
      *(u32x4*)(KT + k * LROW + seg * 32) = w0;
      *(u32x4*)(KT + k * LROW + seg * 32 + 16) = w1;
    }
    if (seg == 0) dbuf[(size_t)task * 128 + k] = __expf(tot);
    __syncthreads();
    {
      const int ktile = wave & 3, vhalf = wave >> 2;
      f32x16 acc[2];
#pragma unroll
      for (int vt = 0; vt < 2; ++vt)
#pragma unroll
        for (int i = 0; i < 16; ++i) acc[vt][i] = 0.f;
#pragma unroll
      for (int ks = 0; ks < 4; ++ks) {
        bf16x8 a = *(const bf16x8*)(KT + (ktile * 32 + r) * LROW + ks * 32 + hh * 16);
#pragma unroll
        for (int vt = 0; vt < 2; ++vt) {
          bf16x8 bb = *(const bf16x8*)(IT + (vhalf * 64 + vt * 32 + r) * LROW + ks * 32 + hh * 16);
          acc[vt] = MFMA32(a, bb, acc[vt]);
        }
      }
#pragma unroll
      for (int vt = 0; vt < 2; ++vt) {
        bf16_t* dst = UT + ((size_t)task * 128 + vhalf * 64 + vt * 32 + r) * 128 + ktile * 32 + 4 * hh;
#pragma unroll
        for (int g = 0; g < 4; ++g) { u32x2 ov = {pk2(acc[vt][4 * g], acc[vt][4 * g + 1]), pk2(acc[vt][4 * g + 2], acc[vt][4 * g + 3])}; *(u32x2*)(dst + 8 * g) = ov; }
      }
    }
    __syncthreads();
  }
}

#undef HA_FETCH
DI void hgrn_scan(const Params& p) {
  char* ws = (char*)launder(p.ws);
  bf16_t* UT = (bf16_t*)(ws + OFF_UT);
  const float* dbuf = (const float*)(ws + OFF_DB);
  const int gid = blockIdx.x * 512 + tid_l();
  if (gid >= 8 * 16384) return;
  const int bh = gid >> 14, e = gid & 16383;
  bf16_t* up = UT + (size_t)bh * 256 * 16384 + e;
  const float* dp = dbuf + (size_t)bh * 256 * 128 + (e & 127);
  float st = 0.f;
  for (int c0 = 0; c0 < 256; c0 += 32) {
    bf16_t u[32]; float dv[32];
#pragma unroll
    for (int i = 0; i < 32; ++i) { u[i] = up[(size_t)(c0 + i) * 16384]; dv[i] = dp[(size_t)(c0 + i) * 128]; }
#pragma unroll
    for (int i = 0; i < 32; ++i) {
      up[(size_t)(c0 + i) * 16384] = f2bf(st);
      st = dv[i] * st + bf2f(u[i]);
    }
  }
}

constexpr int QROW = 272;
DI void hgrn_stageC(const Params& p, const int j_even, char* lds) {
  char* ws = (char*)launder(p.ws);
  const bf16_t* aq = (const bf16_t*)(ws + OFF_R1);
  const float* alf = (const float*)(ws + OFF_R1 + 32 * MiB);
  const bf16_t* aiT = (const bf16_t*)(ws + OFF_R1 + 96 * MiB);
  const bf16_t* ag = (const bf16_t*)(ws + OFF_R1 + 128 * MiB);
  const bf16_t* UT = (const bf16_t*)(ws + OFF_UT);
  bf16_t* ab = (bf16_t*)(ws + OFF_AB);
  const float* hg = ((const float*)p.hgrn_g) + j_even * 128;
  float* lfT = (float*)lds;
  char* ST = lds;
  char* Q1 = lds + 34816;
  char* Q2 = Q1 + 64 * QROW;
  char* K2 = Q2 + 64 * QROW;
  char* IT = K2 + 64 * QROW;
  float* part = (float*)(IT + 128 * LROW);
  const int tid = tid_l(), lane = tid & 63, wave = tid >> 6, r = lane & 31, hh = lane >> 5;
  f32x4 lfr[4]; u32x4 itr[2]; bf16_t qr[16];
#define HC_FETCH(TASK) { const int bh_ = (TASK) >> 8, c_ = (TASK) & 255, tok0_ = (bh_ >> 2) * SEQ + c_ * 64, h_ = bh_ & 3; \
    _Pragma("unroll") for (int i = 0; i < 4; ++i) { const int idx = tid + 512 * i, row = idx >> 5, c4 = idx & 31; \
      lfr[i] = *(const f32x4*)(alf + (size_t)(tok0_ + row) * 512 + h_ * 128 + c4 * 4); } \
    _Pragma("unroll") for (int i = 0; i < 2; ++i) { const int idx = tid + 512 * i, row = idx >> 3, ch = idx & 7; \
      itr[i] = *(const u32x4*)(aiT + (size_t)(bh_ * 128 + row) * SEQ + c_ * 64 + ch * 8); } \
    _Pragma("unroll") for (int i = 0; i < 16; ++i) qr[i] = aq[(size_t)(tok0_ + (tid >> 7) * 16 + i) * 512 + h_ * 128 + (tid & 127)]; }
  if (blockIdx.x < 2048) HC_FETCH(blockIdx.x);
  for (int task = blockIdx.x; task < 2048; task += gridDim.x) {
    const int bh = task >> 8, c = task & 255, b = bh >> 2, h = bh & 3;
    const int tok0 = b * SEQ + c * 64;
#pragma unroll
    for (int i = 0; i < 4; ++i) { const int idx = tid + 512 * i, row = idx >> 5, c4 = idx & 31; *(f32x4*)(lfT + row * 128 + c4 * 4) = lfr[i]; }
#pragma unroll
    for (int i = 0; i < 2; ++i) { const int idx = tid + 512 * i, row = idx >> 3, ch = idx & 7; *(u32x4*)(IT + row * LROW + ch * 16) = itr[i]; }
    float qcur[16];
#pragma unroll
    for (int i = 0; i < 16; ++i) qcur[i] = bf2f(qr[i]);
    u32x4 sreg[4];
#pragma unroll
    for (int i = 0; i < 4; ++i) sreg[i] = *(const u32x4*)(UT + (size_t)task * 16384 + (size_t)(tid + 512 * i) * 8);
    if (task + (int)gridDim.x < 2048) HC_FETCH(task + (int)gridDim.x);
    __syncthreads();
    const int k = tid & 127, seg = tid >> 7;
    float lv[16], bv[16];
    float run = 0.f;
#pragma unroll
    for (int i = 0; i < 16; ++i) { lv[i] = lfT[(seg * 16 + i) * 128 + k]; run += lv[i]; bv[i] = run; }
    part[seg * 128 + k] = run;
    __syncthreads();
    {
      const float p0 = part[k], p1 = part[128 + k], p2 = part[256 + k];
      const float pre = (seg > 0 ? p0 : 0.f) + (seg > 1 ? p1 : 0.f) + (seg > 2 ? p2 : 0.f);
      const float bmid = p0 + p1;
#pragma unroll
      for (int i = 0; i < 16; ++i) {
        const int t = seg * 16 + i;
        const float bt = pre + bv[i];
        const float qv = qcur[i];
        const float kk = 1.f - __expf(lv[i]);
        *(bf16_t*)(Q1 + t * QROW + k * 2) = f2bf(qv * __expf(bt));
        *(bf16_t*)(Q2 + t * QROW + k * 2) = f2bf(qv * __expf(fminf(bt - bmid, 80.f)));
        *(bf16_t*)(K2 + t * QROW + k * 2) = f2bf(kk * __expf(fminf(bmid - bt, 80.f)));
      }
    }
#pragma unroll
    for (int i = 0; i < 4; ++i) { const int idx = tid + 512 * i, row = idx >> 4, ch = idx & 15; *(u32x4*)(ST + row * QROW + ch * 16) = sreg[i]; }
    __syncthreads();
    {
      const int vt = wave & 3, tt = wave >> 2;
      const int t = tt * 32 + r;
      f32x16 sc[2];
#pragma unroll
      for (int st = 0; st < 2; ++st)
#pragma unroll
        for (int i = 0; i < 16; ++i) sc[st][i] = 0.f;
#pragma unroll
      for (int ks = 0; ks < 8; ++ks) {
        bf16x8 qb = *(const bf16x8*)(Q2 + t * QROW + ks * 32 + hh * 16);
#pragma unroll
        for (int st = 0; st < 2; ++st) {
          if (st <= tt) {
            bf16x8 a = *(const bf16x8*)(K2 + (st * 32 + r) * QROW + ks * 32 + hh * 16);
            sc[st] = MFMA32(a, qb, sc[st]);
          }
        }
      }
      f32x16 acc;
#pragma unroll
      for (int i = 0; i < 16; ++i) acc[i] = 0.f;
#pragma unroll
      for (int st = 0; st < 2; ++st) {
        if (st <= tt) {
#pragma unroll
          for (int i = 0; i < 16; ++i) { const int s = st * 32 + (i & 3) + 8 * (i >> 2) + 4 * hh; if (s > t) sc[st][i] = 0.f; }
#pragma unroll
          for (int s2 = 0; s2 < 2; ++s2) {
            u32x4 pw = {pk2(sc[st][8 * s2], sc[st][8 * s2 + 1]), pk2(sc[st][8 * s2 + 2], sc[st][8 * s2 + 3]), pk2(sc[st][8 * s2 + 4], sc[st][8 * s2 + 5]), pk2(sc[st][8 * s2 + 6], sc[st][8 * s2 + 7])};
            const bf16x8 pf = __builtin_bit_cast(bf16x8, pw);
            const char* ip = IT + (vt * 32 + r) * LROW + (st * 32 + 16 * s2 + 4 * hh) * 2;
            u32x2 lo = *(const u32x2*)ip, hi = *(const u32x2*)(ip + 16);
            u32x4 aw = {lo[0], lo[1], hi[0], hi[1]};
            acc = MFMA32(__builtin_bit_cast(bf16x8, aw), pf, acc);
          }
        }
      }
#pragma unroll
      for (int ks = 0; ks < 8; ++ks) {
        bf16x8 a = *(const bf16x8*)(ST + (vt * 32 + r) * QROW + ks * 32 + hh * 16);
        bf16x8 qb = *(const bf16x8*)(Q1 + t * QROW + ks * 32 + hh * 16);
        acc = MFMA32(a, qb, acc);
      }
      float ssq = 0.f;
#pragma unroll
      for (int i = 0; i < 16; ++i) ssq += acc[i] * acc[i];
      ssq = xsum32(ssq);
      if (hh == 0) part[vt * 64 + t] = ssq;
      __syncthreads();
      const float tot = part[t] + part[64 + t] + part[128 + t] + part[192 + t];
      const float rs = rsqrtf(tot * (1.f / 128.f) + 1e-6f);
      const size_t go = (size_t)(tok0 + t) * 512 + h * 128 + vt * 32 + 4 * hh;
      const size_t oo = (size_t)(tok0 + t) * 1024 + h * 128 + vt * 32 + 4 * hh;
#pragma unroll
      for (int g = 0; g < 4; ++g) {
        f32x4 gn = *(const f32x4*)(hg + vt * 32 + 4 * hh + 8 * g);
        u32x2 gv = *(const u32x2*)(ag + go + 8 * g);
        const float g0 = __uint_as_float(gv[0] << 16), g1 = __uint_as_float(gv[0] & 0xffff0000u), g2 = __uint_as_float(gv[1] << 16), g3 = __uint_as_float(gv[1] & 0xffff0000u);
        u32x2 ov = {pk2(acc[4 * g] * rs * gn[0] * g0, acc[4 * g + 1] * rs * gn[1] * g1), pk2(acc[4 * g + 2] * rs * gn[2] * g2, acc[4 * g + 3] * rs * gn[3] * g3)};
        *(u32x2*)(ab + oo + 8 * g) = ov;
      }
    }
    __syncthreads();
  }
}

#undef HC_FETCH
DI void grid_barrier(unsigned* ctr, const unsigned target) {
  asm volatile("s_waitcnt vmcnt(0)" ::: "memory");
  __syncthreads();
  if (threadIdx.x == 0) {
    __builtin_amdgcn_fence(__ATOMIC_RELEASE, "agent");
    asm volatile("s_waitcnt vmcnt(0)" ::: "memory");
    __hip_atomic_fetch_add((GAS unsigned*)ctr, 1u, __ATOMIC_RELAXED, __HIP_MEMORY_SCOPE_AGENT);
    while (__hip_atomic_load((GAS unsigned*)ctr, __ATOMIC_RELAXED, __HIP_MEMORY_SCOPE_AGENT) < target) __builtin_amdgcn_s_sleep(1);
    __builtin_amdgcn_fence(__ATOMIC_ACQUIRE, "agent");
    asm volatile("s_waitcnt vmcnt(0)" ::: "memory");
  }
  __syncthreads();
}
typedef const __attribute__((address_space(4))) Params* kparams_t;
#if defined(__HIP_DEVICE_COMPILE__)
DI kparams_t launder_k(kparams_t q) { asm volatile("" : "+s"(q)); return q; }
#endif
#if defined(__HIP_DEVICE_COMPILE__)
#define KPARAMS (*launder_k((kparams_t)__builtin_amdgcn_kernarg_segment_ptr()))
#else
#define KPARAMS p_arg
#endif
__global__ void __launch_bounds__(512) fwd_mega(Params p_arg) {
  extern __shared__ __attribute__((aligned(16))) char lds[];
  int ph = 0;
  const int p_lo = p_arg.lo, p_hi = p_arg.hi;
#define PHASE(id, ...) { if (ph >= p_lo && ph < p_hi) { const Params p = KPARAMS; char* ws = (char*)launder(p.ws); float* outp = (float*)launder((GAS char*)p.out); bf16_t* ab = (bf16_t*)(ws + OFF_AB); (void)outp; (void)ab; \
    if (ONLY < 0 || ONLY == id) { __VA_ARGS__; } if ((DUPMASK >> id) & 1) { __syncthreads(); __VA_ARGS__; } if (ph + 1 < p_hi) { if (ph == p_lo) cg::this_grid().sync(); else grid_barrier((unsigned*)(ws + OFF_CNT) + 256, (unsigned)(ph - p_lo) * gridDim.x); } } ++ph; }
  PHASE(0, phase0(p, lds));
  for (int l = 0; l < 4; ++l) {
    const int j = l >> 1;
    if ((l & 1) == 0) {
      PHASE(1,
        EpiEvenIn e;
        e.r1 = ws + OFF_R1; e.lb = (const float*)(ws + OFF_MISC) + j * 512;
        gemm_phase(ab, 1024, (const bf16_t*)(ws + OFF_WEI) + (size_t)j * EVEN_IN * D, EVEN_IN, D, e, lds));
      PHASE(2, hgrn_stageA(p, lds));
      PHASE(3, hgrn_scan(p));
      PHASE(4, hgrn_stageC(p, j, lds); diff_phase(p, j, lds));
      PHASE(6,
        EpiResLN er; er.xin = (l == 0) ? (const float*)launder((GAS char*)p.x_in) : outp; er.xout = outp; er.xb = ab;
        er.g = ((const float*)p.ln1g) + l * D; er.b = ((const float*)p.ln1b) + l * D;
        er.xchg = (float*)(ws + OFF_XCHG); er.cnt = (unsigned*)(ws + OFF_CNT); er.target = 4u * (unsigned)(2 * l + 1);
        gemm_phase(ab, 1024, (const bf16_t*)(ws + OFF_WEO) + (size_t)j * D * D, D, D, er, lds));
    } else {
      PHASE(7,
        EpiOddIn e;
        e.r1 = ws + OFF_R1;
        e.lf = (float*)(ws + OFF_LF); e.qg = ((const float*)p.fox_qg) + j * 64; e.kg = ((const float*)p.fox_kg) + j * 64; e.bf = ((const float*)p.fox_bf) + j * 16;
        gemm_phase(ab, 1024, (const bf16_t*)(ws + OFF_WFI) + (size_t)j * ODD_PAD * D, ODD_PAD, D, e, lds));
      PHASE(8, cumsum_phase((const float*)(ws + OFF_LF), (float*)(ws + OFF_C2), lds));
      PHASE(9, fox_phase(p, j, lds));
      PHASE(6,
        EpiResLN er; er.xin = outp; er.xout = outp; er.xb = ab;
        er.g = ((const float*)p.ln1g) + l * D; er.b = ((const float*)p.ln1b) + l * D;
        er.xchg = (float*)(ws + OFF_XCHG); er.cnt = (unsigned*)(ws + OFF_CNT); er.target = 4u * (unsigned)(2 * l + 1);
        gemm_phase(ab, 1024, (const bf16_t*)(ws + OFF_WFO) + (size_t)j * D * D, D, D, er, lds));
    }
    PHASE(11,
      EpiW1 e1; e1.act = (bf16_t*)(ws + OFF_R1);
      gemm_phase(ab, 1024, (const bf16_t*)(ws + OFF_W1) + (size_t)l * 2 * DFF * D, 2 * DFF, D, e1, lds));
    PHASE(6,
      EpiResLN e2; e2.xin = outp; e2.xout = outp; e2.xb = ab;
      e2.g = ((const float*)p.ln2g) + l * D; e2.b = ((const float*)p.ln2b) + l * D;
      e2.xchg = (float*)(ws + OFF_XCHG); e2.cnt = (unsigned*)(ws + OFF_CNT); e2.target = 4u * (unsigned)(2 * l + 2);
      gemm_phase((const bf16_t*)(ws + OFF_R1), DFF, (const bf16_t*)(ws + OFF_W2) + (size_t)l * D * DFF, D, DFF, e2, lds));
  }
#undef PHASE
}
constexpr int N_PHASES = 1 + 2 * 7 + 2 * 6;

extern "C" void kernel_launch(void* const* d_in, const int* in_sizes, int n_in, void* d_out, int out_size, void* d_ws, size_t ws_size, hipStream_t stream) {
  static bool attr = false;
  if (!attr) { hipFuncSetAttribute((const void*)fwd_mega, hipFuncAttributeMaxDynamicSharedMemorySize, LDS_BYTES); attr = true; }
  Params p{};
  p.x_in = (const GAS float*)d_in[0];
  p.even_w_in = (const GAS float*)d_in[1]; p.even_w_out = (const GAS float*)d_in[2]; p.lb_logits = (const GAS float*)d_in[3];
  p.lq1 = (const GAS float*)d_in[4]; p.lk1 = (const GAS float*)d_in[5]; p.lq2 = (const GAS float*)d_in[6]; p.lk2 = (const GAS float*)d_in[7];
  p.hgrn_g = (const GAS float*)d_in[8]; p.diff_g = (const GAS float*)d_in[9];
  p.fox_w_in = (const GAS float*)d_in[10]; p.fox_w_out = (const GAS float*)d_in[11]; p.fox_bf = (const GAS float*)d_in[12];
  p.fox_qg = (const GAS float*)d_in[13]; p.fox_kg = (const GAS float*)d_in[14];
  p.w1 = (const GAS float*)d_in[15]; p.w2 = (const GAS float*)d_in[16];
  p.ln1g = (const GAS float*)d_in[17]; p.ln1b = (const GAS float*)d_in[18]; p.ln2g = (const GAS float*)d_in[19]; p.ln2b = (const GAS float*)d_in[20];
  p.out = (GAS float*)d_out; p.ws = (GAS char*)d_ws;
#if COOP
  p.lo = 0; p.hi = N_PHASES;
  void* args[] = {&p};
  hipError_t e = hipLaunchCooperativeKernel((const void*)fwd_mega, dim3(256), dim3(512), args, LDS_BYTES, stream);
  if (e != hipSuccess) fprintf(stderr, "cooperative launch failed: %s\n", hipGetErrorString(e));
#else
  for (int ph = 0; ph < N_PHASES; ++ph) {
    p.lo = ph; p.hi = ph + 1;
    hipLaunchKernelGGL(fwd_mega, dim3(256), dim3(512), LDS_BYTES, stream, p);
  }
#endif
}
```

```cpp
#include <hip/hip_runtime.h>
#include <hip/hip_cooperative_groups.h>
#include <cstdio>
#include <cstdint>
namespace cg = cooperative_groups;

#ifndef COOP
#define COOP 1
#endif
#ifndef ONLY
#define ONLY -1
#endif
#ifndef DUPMASK
#define DUPMASK 0
#endif

typedef unsigned short bf16_t;
typedef short bf16x8 __attribute__((ext_vector_type(8)));
typedef float f32x16 __attribute__((ext_vector_type(16)));
typedef float f32x4 __attribute__((ext_vector_type(4)));
typedef float f32x2 __attribute__((ext_vector_type(2)));
typedef unsigned u32x4 __attribute__((ext_vector_type(4)));
typedef unsigned u32x2 __attribute__((ext_vector_type(2)));
typedef __bf16 bf16x2v __attribute__((ext_vector_type(2)));

#define DI __device__ __forceinline__
#define MFMA32(a, b, c) __builtin_amdgcn_mfma_f32_32x32x16_bf16((a), (b), (c), 0, 0, 0)

constexpr int D = 1024, SEQ = 16384, NTOK = 32768, DFF = 2816;
constexpr int EVEN_IN = 3584, ODD_IN = 4112, ODD_PAD = 4352;
constexpr float ALPHA = 1.6817928305074290f;
constexpr float LOG2E = 1.4426950408889634f;
constexpr size_t MiB = 1u << 20;

constexpr size_t OFF_WEI = 0;
constexpr size_t OFF_WEO = OFF_WEI + (size_t)2 * EVEN_IN * D * 2;
constexpr size_t OFF_WFI = OFF_WEO + (size_t)2 * D * D * 2;
constexpr size_t OFF_WFO = OFF_WFI + (size_t)2 * ODD_PAD * D * 2;
constexpr size_t OFF_W1  = OFF_WFO + (size_t)2 * D * D * 2;
constexpr size_t OFF_W2  = OFF_W1 + (size_t)4 * 2 * DFF * D * 2;
constexpr size_t W_END   = OFF_W2 + (size_t)4 * D * DFF * 2;
static_assert(W_END <= 105 * MiB, "weights region");
constexpr size_t OFF_R1 = 105 * MiB;
constexpr size_t OFF_AB = 361 * MiB;
constexpr size_t OFF_UT = 425 * MiB;
constexpr size_t OFF_DB = 489 * MiB;
constexpr size_t OFF_LF = 490 * MiB;
constexpr size_t OFF_C2 = 492 * MiB;
constexpr size_t OFF_MISC = 494 * MiB;
constexpr size_t OFF_CNT = OFF_MISC + 80 * 1024;
constexpr size_t OFF_XCHG = OFF_MISC + 128 * 1024;

#define GAS __attribute__((address_space(1)))
struct Params {
  const GAS float* x_in;
  const GAS float *even_w_in, *even_w_out, *lb_logits, *lq1, *lk1, *lq2, *lk2, *hgrn_g, *diff_g;
  const GAS float *fox_w_in, *fox_w_out, *fox_bf, *fox_qg, *fox_kg;
  const GAS float *w1, *w2, *ln1g, *ln1b, *ln2g, *ln2b;
  GAS float* out;
  GAS char* ws;
  int lo, hi;
};

DI unsigned pk2(float lo, float hi) { f32x2 v = {lo, hi}; bf16x2v b = __builtin_convertvector(v, bf16x2v); return __builtin_bit_cast(unsigned, b); }
DI bf16_t f2bf(float x) { return (bf16_t)(pk2(x, 0.f) & 0xffffu); }
DI float bf2f(bf16_t v) { return __uint_as_float(((unsigned)v) << 16); }
DI float sigmoidf_(float x) { return __builtin_amdgcn_rcpf(1.f + __builtin_amdgcn_exp2f(-LOG2E * x)); }
DI float siluf_(float x) { return x * __builtin_amdgcn_rcpf(1.f + __builtin_amdgcn_exp2f(-LOG2E * x)); }
DI GAS char* launder(GAS char* q) { asm volatile("" : "+s"(q)); return q; }
DI int tid_l() { int t = threadIdx.x; asm volatile("" : "+v"(t)); return t; }
DI int swz32(int s) { return (s & ~12) | ((s & 4) << 1) | ((s & 8) >> 1); }
DI float xsum32(float v) { const u32x2 r_ = __builtin_amdgcn_permlane32_swap(__float_as_uint(v), __float_as_uint(v), false, false); return __uint_as_float(r_[0]) + __uint_as_float(r_[1]); }
DI float xmax32(float v) { const u32x2 r_ = __builtin_amdgcn_permlane32_swap(__float_as_uint(v), __float_as_uint(v), false, false); return fmaxf(__uint_as_float(r_[0]), __uint_as_float(r_[1])); }

DI int perm32(int rho) { return (((rho >> 2) & 1) << 4) + (rho & 3) + ((rho >> 3) << 2); }
DI void convert_w(const float* __restrict__ w, bf16_t* __restrict__ wt, int K, int N, int Npad, int mode, float* tl) {
  const int tid = tid_l();
  const int nkt = K >> 6, nnt = Npad >> 6;
  for (int tile = blockIdx.x; tile < nkt * nnt; tile += gridDim.x) {
    const int k0 = (tile / nnt) << 6, n0 = (tile % nnt) << 6;
#pragma unroll
    for (int i = 0; i < 2; ++i) {
      const int kk = (tid >> 4) + 32 * i, n4 = (tid & 15) << 2;
      const int np = n0 + n4;
      int src = np;
      if (mode == 1) { const int grp = np >> 6, j = np & 63; src = (j < 32) ? grp * 32 + perm32(j) : DFF + grp * 32 + perm32(j - 32); }
      else if (mode == 2) src = (np & ~31) + perm32(np & 31);
      f32x4 v = {0.f, 0.f, 0.f, 0.f};
      if (src < N) v = *(const f32x4*)(w + (size_t)(k0 + kk) * N + src);
      tl[kk * 65 + n4 + 0] = v[0]; tl[kk * 65 + n4 + 1] = v[1]; tl[kk * 65 + n4 + 2] = v[2]; tl[kk * 65 + n4 + 3] = v[3];
    }
    __syncthreads();
    {
      const int n = tid >> 3, kc = (tid & 7) << 3;
      float f[8];
#pragma unroll
      for (int j = 0; j < 8; ++j) f[j] = tl[(kc + j) * 65 + n];
      u32x4 o = {pk2(f[0], f[1]), pk2(f[2], f[3]), pk2(f[4], f[5]), pk2(f[6], f[7])};
      *(u32x4*)(wt + (size_t)(n0 + n) * K + k0 + kc) = o;
    }
    __syncthreads();
  }
}

DI void phase0(const Params& p, char* lds) {
  float* tl = (float*)lds;
  char* ws = (char*)launder(p.ws);
  for (int j = 0; j < 2; ++j) {
    convert_w(((const float*)p.even_w_in) + (size_t)j * D * EVEN_IN, (bf16_t*)(ws + OFF_WEI) + (size_t)j * EVEN_IN * D, D, EVEN_IN, EVEN_IN, 2, tl);
    convert_w(((const float*)p.even_w_out) + (size_t)j * D * D, (bf16_t*)(ws + OFF_WEO) + (size_t)j * D * D, D, D, D, 0, tl);
    convert_w(((const float*)p.fox_w_in) + (size_t)j * D * ODD_IN, (bf16_t*)(ws + OFF_WFI) + (size_t)j * ODD_PAD * D, D, ODD_IN, ODD_PAD, 2, tl);
    convert_w(((const float*)p.fox_w_out) + (size_t)j * D * D, (bf16_t*)(ws + OFF_WFO) + (size_t)j * D * D, D, D, D, 0, tl);
  }
  for (int l = 0; l < 4; ++l) {
    convert_w(((const float*)p.w1) + (size_t)l * D * 2 * DFF, (bf16_t*)(ws + OFF_W1) + (size_t)l * 2 * DFF * D, D, 2 * DFF, 2 * DFF, 1, tl);
    convert_w(((const float*)p.w2) + (size_t)l * DFF * D, (bf16_t*)(ws + OFF_W2) + (size_t)l * D * DFF, DFF, D, D, 0, tl);
  }
  {
    bf16_t* ab = (bf16_t*)(ws + OFF_AB);
    const size_t n8 = (size_t)NTOK * D / 8;
    for (size_t i = (size_t)blockIdx.x * 512 + tid_l(); i < n8; i += (size_t)gridDim.x * 512) {
      f32x4 a = *(const f32x4*)(((const float*)p.x_in) + i * 8), b = *(const f32x4*)(((const float*)p.x_in) + i * 8 + 4);
      u32x4 o = {pk2(a[0], a[1]), pk2(a[2], a[3]), pk2(b[0], b[1]), pk2(b[2], b[3])};
      *(u32x4*)(ab + i * 8) = o;
    }
  }
  if (blockIdx.x == 0) { const int t_ = tid_l(); if (t_ < 128) ((unsigned*)(ws + OFF_CNT))[t_] = 0u; if (t_ == 128) ((unsigned*)(ws + OFF_CNT))[256] = 0u; }
  if (blockIdx.x == 0) {
    float* misc = (float*)(ws + OFF_MISC);
    const int tid = tid_l();
    {
      const float l0 = ((const float*)p.lb_logits)[tid], l1 = ((const float*)p.lb_logits)[512 + tid];
      const float mx = fmaxf(l0, l1);
      const float e0 = expf(l0 - mx), e1 = expf(l1 - mx);
      const float s0 = e0 / (e0 + e1), s1 = e1 / (e0 + e1);
      misc[tid] = s0 - s0;
      misc[512 + tid] = (s0 + s1) - s0;
    }
    if (tid < 2) {
      float d1 = 0.f, d2 = 0.f;
      for (int i = 0; i < 64; ++i) { d1 += ((const float*)p.lq1)[tid * 64 + i] * ((const float*)p.lk1)[tid * 64 + i]; d2 += ((const float*)p.lq2)[tid * 64 + i] * ((const float*)p.lk2)[tid * 64 + i]; }
      const float lam_init = 0.8f - 0.6f * expf(-0.3f * (float)(2 * tid));
      misc[1024 + tid] = expf(d1) - expf(d2) + lam_init;
      float mq = 0.f, mk = 0.f;
      for (int i = 0; i < 64; ++i) { mq = fmaxf(mq, fabsf(((const float*)p.fox_qg)[tid * 64 + i])); mk = fmaxf(mk, fabsf(((const float*)p.fox_kg)[tid * 64 + i])); }
      const float B = 0.125f * LOG2E * 64.f * mq * mk * 1.02f;
      misc[1032 + tid] = 2.f * B + 8.f;
    }
  }
}

constexpr int LROW = 144;
constexpr int G_XB = 256 * LROW, G_WB = 256 * LROW, G_STAGE = G_XB + G_WB;
constexpr int DIFF_STASH_OFF = 2 * (64 * LROW + 128 * LROW + 256);
constexpr int LDS_BYTES = 2 * G_STAGE;
static_assert(LDS_BYTES >= DIFF_STASH_OFF + 512 * 32 * 4, "lds");

template <class Epi>
DI void gemm_phase(const bf16_t* __restrict__ X, const int ldx, const bf16_t* __restrict__ Wt, const int N, const int K, const Epi& epi, char* lds) {
  const int tid = tid_l(), lane = tid & 63, wave = tid >> 6;
  const int r = lane & 31, hh = lane >> 5;
  const int tw = wave & 3, fw = wave >> 2;
  const int nNt = N >> 8;
  const int ntiles = nNt * (NTOK / 256);
  const int nk = K >> 6;
  const int lrow = tid >> 3, lch = tid & 7;
  const int xcd = blockIdx.x & 7, slot = blockIdx.x >> 3, nchunks = 4 * nNt;
  (void)ntiles;
  u32x4 xr0[4], wr0[4];
  for (int chunk = xcd; chunk < nchunks; chunk += 8) {
    const int L = chunk * 32 + slot, band = L / (4 * nNt), rem = L % (4 * nNt);
    const int mt_ = band * 4 + (rem & 3), nt_ = rem >> 2;
    const char* Xt = (const char*)(X + (size_t)(mt_ * 256) * ldx);
    const char* Wtb = (const char*)(Wt + (size_t)(nt_ * 256) * K);
    const unsigned xoff = (unsigned)(lrow * ldx + lch * 8) * 2u, woff = (unsigned)(lrow * K + lch * 8) * 2u;
    const bool has_next = !Epi::kFull && (chunk + 8 < nchunks);
    const int Ln = (has_next ? chunk + 8 : chunk) * 32 + slot, band_n = Ln / (4 * nNt), rem_n = Ln % (4 * nNt);
    const char* Xt_n = (const char*)(X + (size_t)((band_n * 4 + (rem_n & 3)) * 256) * ldx);
    const char* Wtb_n = (const char*)(Wt + (size_t)((rem_n >> 2) * 256) * K);
    f32x16 acc[2][2][2];
#define G_GLOAD(XR, WR, KT) { _Pragma("unroll") for (int i_ = 0; i_ < 4; ++i_) XR[i_] = *(const u32x4*)(Xt + ((size_t)(64 * i_) * ldx + (KT) * 64) * 2 + xoff); \
    _Pragma("unroll") for (int i_ = 0; i_ < 4; ++i_) WR[i_] = *(const u32x4*)(Wtb + ((size_t)(64 * i_) * K + (KT) * 64) * 2 + woff); }
#define G_LSTORE(XR, WR, STG) { char* xs_ = lds + (STG) * G_STAGE; char* ws_ = xs_ + G_XB; \
    _Pragma("unroll") for (int i_ = 0; i_ < 4; ++i_) *(u32x4*)(xs_ + (lrow + 64 * i_) * LROW + lch * 16) = XR[i_]; \
    _Pragma("unroll") for (int i_ = 0; i_ < 4; ++i_) *(u32x4*)(ws_ + (lrow + 64 * i_) * LROW + lch * 16) = WR[i_]; }
#define G_PART(Q, STG, KT, DOLOAD) { char* xs_ = lds + (STG) * G_STAGE; char* ws_ = xs_ + G_XB; \
    if ((Q) < 2) { _Pragma("unroll") for (int i_ = 2 * (Q); i_ < 2 * (Q) + 2; ++i_) { *(u32x4*)(xs_ + (lrow + 64 * i_) * LROW + lch * 16) = xr0[i_]; \
        if (DOLOAD) xr0[i_] = *(const u32x4*)(xb_ + ((size_t)(64 * i_) * ldx + (KT) * 64) * 2 + xoff); } } \
    else { _Pragma("unroll") for (int i_ = 2 * ((Q) - 2); i_ < 2 * ((Q) - 2) + 2; ++i_) { *(u32x4*)(ws_ + (lrow + 64 * i_) * LROW + lch * 16) = wr0[i_]; \
        if (DOLOAD) wr0[i_] = *(const u32x4*)(wb_ + ((size_t)(64 * i_) * K + (KT) * 64) * 2 + woff); } } \
    __builtin_amdgcn_sched_barrier(0); }
#define G_LDX(XF, KS) { _Pragma("unroll") for (int m = 0; m < 2; ++m) XF[m] = *(const bf16x8*)(xs + (tw * 64 + m * 32 + r) * LROW + (KS) * 32 + hh * 16); }
#define G_LDW(WF, N0, KS) { _Pragma("unroll") for (int n = 0; n < 2; ++n) WF[n] = *(const bf16x8*)(wsm + (fw * 128 + ((N0) + n) * 32 + r) * LROW + (KS) * 32 + hh * 16); }
#define G_MFMA4S(XF, WF, H) { _Pragma("unroll") for (int n = 0; n < 2; ++n) _Pragma("unroll") for (int m = 0; m < 2; ++m) acc[H][n][m] = MFMA32(XF[m], WF[n], acc[H][n][m]); }
#define G_MFMA4(XF, WF, H) { _Pragma("unroll") for (int n = 0; n < 2; ++n) _Pragma("unroll") for (int m = 0; m < 2; ++m) acc[H][n][m] = MFMA32(WF[n], XF[m], acc[H][n][m]); }
#define G_STEP(MM, KS, XC, XN) { G_LDW(wc, 2, KS); if ((KS) < 3) { G_LDX(XN, (KS) + 1); } __builtin_amdgcn_sched_barrier(0); \
    MM(XC, w01, 0); __builtin_amdgcn_sched_barrier(0); if ((KS) < 3) { G_LDW(w01, 0, (KS) + 1); } MM(XC, wc, 1); __builtin_amdgcn_sched_barrier(0); }
#define G_COMPUTE_ST(MM, STG, DOSTORE, NSTG, KTL, DOLOAD) { const char* xs = lds + (STG) * G_STAGE; const char* wsm = xs + G_XB; \
    bf16x8 xfa[2], xfb[2], w01[2], wc[2]; \
    G_LDX(xfa, 0); G_LDW(w01, 0, 0); \
    G_STEP(MM, 0, xfa, xfb); if (DOSTORE) { G_PART(0, NSTG, KTL, DOLOAD); G_PART(1, NSTG, KTL, DOLOAD); } \
    G_STEP(MM, 1, xfb, xfa); if (DOSTORE) G_PART(2, NSTG, KTL, DOLOAD); \
    G_STEP(MM, 2, xfa, xfb); if (DOSTORE) G_PART(3, NSTG, KTL, DOLOAD); \
    G_STEP(MM, 3, xfb, xfa); }
#define G_COMPUTE(MM, STG) { const char* xs = lds + (STG) * G_STAGE; const char* wsm = xs + G_XB; \
    bf16x8 xfa[2], xfb[2], w01[2], wc[2]; \
    G_LDX(xfa, 0); G_LDW(w01, 0, 0); \
    G_STEP(MM, 0, xfa, xfb); G_STEP(MM, 1, xfb, xfa); G_STEP(MM, 2, xfa, xfb); G_STEP(MM, 3, xfb, xfa); }
    asm volatile("" ::: "memory");
    if (Epi::kFull || chunk == xcd) {
      G_GLOAD(xr0, wr0, 0);
      G_LSTORE(xr0, wr0, 0);
      __syncthreads();
      G_GLOAD(xr0, wr0, 1);
    }
#pragma unroll
    for (int c = 0; c < 2; ++c)
#pragma unroll
      for (int a = 0; a < 2; ++a)
#pragma unroll
        for (int b = 0; b < 2; ++b)
#pragma unroll
          for (int i = 0; i < 16; ++i) acc[c][a][b][i] = 0.f;
#define G_KLOOP(MM) for (int kt = 0; kt < nk; kt += 2) { \
        \
        \
      { const bool in_ = (kt + 2 < nk); const char* xb_ = in_ ? Xt : Xt_n; const char* wb_ = in_ ? Wtb : Wtb_n; \
        const int k2_ = in_ ? kt + 2 : (has_next ? 0 : nk - 1); G_COMPUTE_ST(MM, 0, true, 1, k2_, true); } \
      __syncthreads(); \
      { const bool in_ = (kt + 3 < nk); const char* xb_ = in_ ? Xt : Xt_n; const char* wb_ = in_ ? Wtb : Wtb_n; \
        const int k3_ = in_ ? kt + 3 : (has_next ? 1 : nk - 1); G_COMPUTE_ST(MM, 1, true, 0, k3_, true); } \
      __syncthreads(); \
    }
    const bool sw = Epi::kSwap && epi.swap_tile(nt_);
#define G_EPI_IDS const int t2 = tid_l(); const int r2 = t2 & 31, hh2 = (t2 >> 5) & 1, tw2 = (t2 >> 6) & 3, fw2 = t2 >> 8;
    if (sw) {
      G_KLOOP(G_MFMA4S)
      if constexpr (Epi::kSwap) {
        G_EPI_IDS
        epi.swapped(mt_ * 256 + tw2 * 64, nt_ * 256 + fw2 * 128, acc[0], r2, hh2);
        __builtin_amdgcn_sched_barrier(0);
        epi.swapped(mt_ * 256 + tw2 * 64, nt_ * 256 + fw2 * 128 + 64, acc[1], r2, hh2);
      }
    } else {
      G_KLOOP(G_MFMA4)
      G_EPI_IDS
      if constexpr (Epi::kFull) {
        epi.full(mt_, nt_, acc, tw2, fw2, r2, hh2, lds, t2);
      } else {
        epi(mt_ * 256 + tw2 * 64, nt_ * 256 + fw2 * 128, acc[0], r2, hh2);
        __builtin_amdgcn_sched_barrier(0);
        epi(mt_ * 256 + tw2 * 64, nt_ * 256 + fw2 * 128 + 64, acc[1], r2, hh2);
      }
    }
#undef G_EPI_IDS
#undef G_KLOOP
#undef G_GLOAD
#undef G_LSTORE
#undef G_COMPUTE
#undef G_PART
#undef G_COMPUTE_ST
#undef G_LDX
#undef G_LDW
#undef G_MFMA4
#undef G_MFMA4S
#undef G_STEP
    __builtin_amdgcn_sched_barrier(0);
  }
}

struct EpiEvenIn {
  static constexpr bool kFull = false, kSwap = false;
  DI bool swap_tile(int nt_) const { const int seg = nt_ >> 1; return seg == 2 || seg == 6; }
  char* r1; const float* lb;
#define aq  ((bf16_t*)(r1))
#define alf ((float*)(r1 + 32 * MiB))
#define aiT ((bf16_t*)(r1 + 96 * MiB))
#define ag  ((bf16_t*)(r1 + 128 * MiB))
#define bq  ((bf16_t*)(r1 + 160 * MiB))
#define bk  ((bf16_t*)(r1 + 192 * MiB))
#define bvT ((bf16_t*)(r1 + 224 * MiB))
  DI void operator()(int tok0, int feat0, f32x16 (&acc)[2][2], int r, int hh) const {
    const int seg = feat0 >> 9, c0 = feat0 & 511;
#pragma unroll
    for (int mt = 0; mt < 2; ++mt) {
      const int tok = tok0 + mt * 32 + r, b = tok >> 14, s = tok & (SEQ - 1);
#pragma unroll
      for (int nt = 0; nt < 2; ++nt)
#pragma unroll
        for (int gp = 0; gp < 2; ++gp) {
          const int c = c0 + nt * 32 + 16 * hh + 8 * gp;
          float v[8];
#pragma unroll
          for (int e = 0; e < 8; ++e) v[e] = acc[nt][mt][8 * gp + e];
          if (seg == 0 || seg == 3) {
            u32x4 o = {pk2(siluf_(v[0]), siluf_(v[1])), pk2(siluf_(v[2]), siluf_(v[3])), pk2(siluf_(v[4]), siluf_(v[5])), pk2(siluf_(v[6]), siluf_(v[7]))};
            *(u32x4*)((seg == 0 ? aq : ag) + (size_t)tok * 512 + c) = o;
          } else if (seg == 1) {
#pragma unroll
            for (int h2 = 0; h2 < 2; ++h2) {
              f32x4 lbv = *(const f32x4*)(lb + c + 4 * h2), o;
#pragma unroll
              for (int e = 0; e < 4; ++e) o[e] = __logf(lbv[e] + (1.f - lbv[e]) * sigmoidf_(v[4 * h2 + e]));
              *(f32x4*)(alf + (size_t)tok * 512 + c + 4 * h2) = o;
            }
          } else if (seg == 4 || seg == 5) {
            const float sc = seg == 4 ? 0.125f * LOG2E : 1.f;
            u32x4 o = {pk2(v[0] * sc, v[1] * sc), pk2(v[2] * sc, v[3] * sc), pk2(v[4] * sc, v[5] * sc), pk2(v[6] * sc, v[7] * sc)};
            *(u32x4*)((seg == 4 ? bq : bk) + (size_t)tok * 512 + c) = o;
          } else {
            bf16_t* dst = (seg == 2 ? aiT : bvT) + ((size_t)((b * 4 + (c >> 7)) * 128 + (c & 127))) * SEQ + (seg == 2 ? s : swz32(s));
#pragma unroll
            for (int e = 0; e < 8; ++e) dst[(size_t)e * SEQ] = f2bf(v[e]);
          }
          __builtin_amdgcn_sched_barrier(0);
        }
    }
  }
  DI void swapped(int tok0, int feat0, f32x16 (&acc)[2][2], int r, int hh) const {
    const int seg = feat0 >> 9, c0 = feat0 & 511;
#pragma unroll
    for (int nt = 0; nt < 2; ++nt) {
      const int c = c0 + nt * 32 + r;
#pragma unroll
      for (int mt = 0; mt < 2; ++mt)
#pragma unroll
        for (int g = 0; g < 4; ++g) {
          const int tok = tok0 + mt * 32 + 8 * g + 4 * hh, b = tok >> 14, s = tok & (SEQ - 1);
          u32x2 o = {pk2(acc[nt][mt][4 * g], acc[nt][mt][4 * g + 1]), pk2(acc[nt][mt][4 * g + 2], acc[nt][mt][4 * g + 3])};
          bf16_t* base = (seg == 2 ? aiT : bvT) + ((size_t)((b * 4 + (c >> 7)) * 128 + (c & 127))) * SEQ;
          *(u32x2*)(base + (seg == 2 ? s : swz32(s))) = o;
        }
    }
  }
};

#undef aq
#undef alf
#undef aiT
#undef ag
#undef bq
#undef bk
#undef bvT
struct EpiOddIn {
  static constexpr bool kFull = false, kSwap = false;
  DI bool swap_tile(int nt_) const { return (nt_ >> 2) == 2; }
  char* r1; float* lf; const float *qg, *kg, *bf;
#define fq  ((bf16_t*)(r1))
#define fk  ((bf16_t*)(r1 + 64 * MiB))
#define fvT ((bf16_t*)(r1 + 128 * MiB))
#define fg  ((bf16_t*)(r1 + 192 * MiB))
  DI void operator()(int tok0, int feat0, f32x16 (&acc)[2][2], int r, int hh) const {
    const int seg = feat0 >> 10, c0 = feat0 & 1023;
#pragma unroll
    for (int mt = 0; mt < 2; ++mt) {
      const int tok = tok0 + mt * 32 + r, b = tok >> 14, s = tok & (SEQ - 1);
      if (seg < 2) {
        float ssq = 0.f;
#pragma unroll
        for (int nt = 0; nt < 2; ++nt)
#pragma unroll
          for (int i = 0; i < 16; ++i) ssq += acc[nt][mt][i] * acc[nt][mt][i];
        ssq = xsum32(ssq);
        float rs = rsqrtf(ssq * (1.f / 64.f) + 1e-6f);
        if (seg == 0) rs *= 0.125f * LOG2E;
        const float* gg = seg == 0 ? qg : kg;
        bf16_t* dstb = (seg == 0 ? fq : fk) + (size_t)tok * 1024 + c0;
#pragma unroll
        for (int nt = 0; nt < 2; ++nt)
#pragma unroll
          for (int gp = 0; gp < 2; ++gp) {
            const int d = nt * 32 + 16 * hh + 8 * gp;
            f32x4 g0 = *(const f32x4*)(gg + d), g1 = *(const f32x4*)(gg + d + 4);
            u32x4 o = {pk2(acc[nt][mt][8 * gp] * rs * g0[0], acc[nt][mt][8 * gp + 1] * rs * g0[1]), pk2(acc[nt][mt][8 * gp + 2] * rs * g0[2], acc[nt][mt][8 * gp + 3] * rs * g0[3]),
                       pk2(acc[nt][mt][8 * gp + 4] * rs * g1[0], acc[nt][mt][8 * gp + 5] * rs * g1[1]), pk2(acc[nt][mt][8 * gp + 6] * rs * g1[2], acc[nt][mt][8 * gp + 7] * rs * g1[3])};
            *(u32x4*)(dstb + d) = o;
            __builtin_amdgcn_sched_barrier(0);
          }
      } else if (seg == 2) {
        const int head = c0 >> 6;
#pragma unroll
        for (int nt = 0; nt < 2; ++nt)
#pragma unroll
          for (int i = 0; i < 16; ++i) {
            const int d = nt * 32 + 16 * hh + i;
            fvT[((size_t)((b * 16 + head) * 64 + d)) * SEQ + swz32(s)] = f2bf(acc[nt][mt][i]);
          }
      } else if (seg == 3) {
#pragma unroll
        for (int nt = 0; nt < 2; ++nt)
#pragma unroll
          for (int gp = 0; gp < 2; ++gp) {
            const int c = c0 + nt * 32 + 16 * hh + 8 * gp;
            u32x4 o = {pk2(sigmoidf_(acc[nt][mt][8 * gp]), sigmoidf_(acc[nt][mt][8 * gp + 1])), pk2(sigmoidf_(acc[nt][mt][8 * gp + 2]), sigmoidf_(acc[nt][mt][8 * gp + 3])),
                       pk2(sigmoidf_(acc[nt][mt][8 * gp + 4]), sigmoidf_(acc[nt][mt][8 * gp + 5])), pk2(sigmoidf_(acc[nt][mt][8 * gp + 6]), sigmoidf_(acc[nt][mt][8 * gp + 7]))};
            *(u32x4*)(fg + (size_t)tok * 1024 + c) = o;
            __builtin_amdgcn_sched_barrier(0);
          }
      } else if (feat0 == 4096) {
        if (hh == 0) {
#pragma unroll
          for (int i = 0; i < 16; ++i) {
            const float xv = acc[0][mt][i] + bf[i];
            const float ls = fminf(xv, 0.f) - log1pf(expf(-fabsf(xv)));
            lf[((size_t)(b * 16 + i)) * SEQ + s] = ls;
          }
        }
      }
    }
  }
  DI void swapped(int tok0, int feat0, f32x16 (&acc)[2][2], int r, int hh) const {
    const int head = (feat0 & 1023) >> 6;
#pragma unroll
    for (int nt = 0; nt < 2; ++nt) {
      const int d = nt * 32 + r;
#pragma unroll
      for (int mt = 0; mt < 2; ++mt)
#pragma unroll
        for (int g = 0; g < 4; ++g) {
          const int tok = tok0 + mt * 32 + 8 * g + 4 * hh, b = tok >> 14, s = tok & (SEQ - 1);
          u32x2 o = {pk2(acc[nt][mt][4 * g], acc[nt][mt][4 * g + 1]), pk2(acc[nt][mt][4 * g + 2], acc[nt][mt][4 * g + 3])};
          *(u32x2*)(fvT + ((size_t)((b * 16 + head) * 64 + d)) * SEQ + swz32(s)) = o;
        }
    }
  }
};

#undef fq
#undef fk
#undef fvT
#undef fg
struct EpiRes {
  static constexpr bool kFull = false;
  const float* xin; float* y;
  DI void operator()(int tok0, int feat0, f32x16 (&acc)[2][2], int r, int hh) const {
#pragma unroll
    for (int mt = 0; mt < 2; ++mt) {
      const size_t rowo = (size_t)(tok0 + mt * 32 + r) * 1024;
#pragma unroll
      for (int nt = 0; nt < 2; ++nt)
#pragma unroll
        for (int g = 0; g < 4; ++g) {
          const int c = feat0 + nt * 32 + 8 * g + 4 * hh;
          f32x4 xv = *(const f32x4*)(xin + rowo + c);
          f32x4 o = {ALPHA * xv[0] + acc[nt][mt][4 * g], ALPHA * xv[1] + acc[nt][mt][4 * g + 1], ALPHA * xv[2] + acc[nt][mt][4 * g + 2], ALPHA * xv[3] + acc[nt][mt][4 * g + 3]};
          *(f32x4*)(y + rowo + c) = o;
          if (g & 1) __builtin_amdgcn_sched_barrier(0);
        }
    }
  }
};

struct EpiResLN {
  static constexpr bool kFull = true, kSwap = false;
  DI bool swap_tile(int) const { return false; }
  const float* xin; float* xout; bf16_t* xb; const float *g, *b; float* xchg; unsigned* cnt; unsigned target;
  DI void full(const int mt_, const int nt_, f32x16 (&acc)[2][2][2], const int tw, const int fw, const int r, const int hh, char* lds, const int tid) const {
    float* part = (float*)(lds + G_STAGE);
    const size_t rbase = (size_t)(mt_ * 256 + tw * 64 + r) * 1024 + nt_ * 256 + fw * 128 + 4 * hh;
    f32x4 xa[4], xc[4], xe[4];
#define RL_LOAD(XV, G) { constexpr int mt__ = (G) >> 2, half__ = ((G) >> 1) & 1, nt__ = (G) & 1; \
    _Pragma("unroll") for (int gq = 0; gq < 4; ++gq) XV[gq] = *(const f32x4*)(xin + rbase + (size_t)mt__ * 32 * 1024 + half__ * 64 + nt__ * 32 + 8 * gq); }
#define RL_FOLD(XV, G, SM, SQ) { constexpr int mt__ = (G) >> 2, half__ = ((G) >> 1) & 1, nt__ = (G) & 1; \
    _Pragma("unroll") for (int gq = 0; gq < 4; ++gq) _Pragma("unroll") for (int jj = 0; jj < 4; ++jj) { \
      const float y = ALPHA * XV[gq][jj] + acc[half__][nt__][mt__][4 * gq + jj]; acc[half__][nt__][mt__][4 * gq + jj] = y; SM += y; SQ += y * y; } }
#define SB __builtin_amdgcn_sched_barrier(0)
    float sm0 = 0.f, sq0 = 0.f, sm1 = 0.f, sq1 = 0.f;
    RL_LOAD(xa, 0); RL_LOAD(xc, 1); RL_LOAD(xe, 2); SB;
    RL_FOLD(xa, 0, sm0, sq0); SB; RL_LOAD(xa, 3); SB;
    RL_FOLD(xc, 1, sm0, sq0); SB; RL_LOAD(xc, 4); SB;
    RL_FOLD(xe, 2, sm0, sq0); SB; RL_LOAD(xe, 5); SB;
    RL_FOLD(xa, 3, sm0, sq0); SB; RL_LOAD(xa, 6); SB;
    RL_FOLD(xc, 4, sm1, sq1); SB; RL_LOAD(xc, 7); SB;
    RL_FOLD(xe, 5, sm1, sq1); SB;
    RL_FOLD(xa, 6, sm1, sq1); SB;
    RL_FOLD(xc, 7, sm1, sq1);
#undef SB
#undef RL_LOAD
#undef RL_FOLD
    sm0 += __shfl_xor(sm0, 32, 64); sq0 += __shfl_xor(sq0, 32, 64); sm1 += __shfl_xor(sm1, 32, 64); sq1 += __shfl_xor(sq1, 32, 64);
    if (hh == 0) {
      float* pp = part + ((fw * 256) + tw * 64 + r) * 2; pp[0] = sm0; pp[1] = sq0;
      pp[64] = sm1; pp[65] = sq1;
    }
    __syncthreads();
    if (tid < 256) {
      f32x2 a = *(const f32x2*)(part + tid * 2), c = *(const f32x2*)(part + (256 + tid) * 2);
      const unsigned long long pk = ((unsigned long long)__float_as_uint(a[1] + c[1]) << 32) | (unsigned long long)__float_as_uint(a[0] + c[0]);
      __hip_atomic_store((GAS unsigned long long*)(xchg + ((size_t)(mt_ * 4 + nt_) * 256 + tid) * 2), pk, __ATOMIC_RELAXED, __HIP_MEMORY_SCOPE_AGENT);
    }
    asm volatile("s_waitcnt vmcnt(0)" ::: "memory");
    __syncthreads();
    if (tid == 0) {
      __hip_atomic_fetch_add((GAS unsigned*)(cnt + mt_), 1u, __ATOMIC_RELAXED, __HIP_MEMORY_SCOPE_AGENT);
      while (__hip_atomic_load((GAS unsigned*)(cnt + mt_), __ATOMIC_RELAXED, __HIP_MEMORY_SCOPE_AGENT) < target) __builtin_amdgcn_s_sleep(1);
    }
    __syncthreads();
#pragma unroll
    for (int mt = 0; mt < 2; ++mt) {
      const int tl = tw * 64 + mt * 32 + r;
      float S = 0.f, Q = 0.f;
#pragma unroll
      for (int k = 0; k < 4; ++k) {
        const unsigned long long pk = __hip_atomic_load((GAS unsigned long long*)(xchg + ((size_t)(mt_ * 4 + k) * 256 + tl) * 2), __ATOMIC_RELAXED, __HIP_MEMORY_SCOPE_AGENT);
        S += __uint_as_float((unsigned)pk);
        Q += __uint_as_float((unsigned)(pk >> 32));
      }
      const float mean = S * (1.f / 1024.f);
      const float rstd = rsqrtf(fmaxf(Q * (1.f / 1024.f) - mean * mean, 0.f) + 1e-5f);
      const int c0 = nt_ * 256 + fw * 128 + 4 * hh;
      const size_t rowo = (size_t)(mt_ * 256 + tl) * 1024 + c0;
#pragma unroll
      for (int half = 0; half < 2; ++half)
#pragma unroll
        for (int nt = 0; nt < 2; ++nt) {
#pragma unroll
          for (int gq = 0; gq < 4; ++gq) {
            const int co = half * 64 + nt * 32 + 8 * gq;
            f32x4 gv = *(const f32x4*)(g + c0 + co), bv = *(const f32x4*)(b + c0 + co), o;
#pragma unroll
            for (int jj = 0; jj < 4; ++jj) o[jj] = (acc[half][nt][mt][4 * gq + jj] - mean) * rstd * gv[jj] + bv[jj];
            *(f32x4*)(xout + rowo + co) = o;
            u32x2 ob = {pk2(o[0], o[1]), pk2(o[2], o[3])};
            *(u32x2*)(xb + rowo + co) = ob;
          }
          __builtin_amdgcn_sched_barrier(0);
        }
    }
    __syncthreads();
  }
};

struct EpiW1 {
  static constexpr bool kFull = false, kSwap = false;
  DI bool swap_tile(int) const { return false; }
  DI void swapped(int, int, f32x16 (&)[2][2], int, int) const {}
  bf16_t* act;
  DI void operator()(int tok0, int feat0, f32x16 (&acc)[2][2], int r, int hh) const {
    const int u0 = (feat0 >> 6) * 32;
#pragma unroll
    for (int mt = 0; mt < 2; ++mt) {
      bf16_t* dst = act + (size_t)(tok0 + mt * 32 + r) * DFF + u0 + 16 * hh;
#pragma unroll
      for (int gp = 0; gp < 2; ++gp) {
        u32x4 o;
#pragma unroll
        for (int q = 0; q < 4; ++q) { const int i = 8 * gp + 2 * q; o[q] = pk2(siluf_(acc[0][mt][i]) * acc[1][mt][i], siluf_(acc[0][mt][i + 1]) * acc[1][mt][i + 1]); }
        *(u32x4*)(dst + 8 * gp) = o;
      }
    }
  }
};

DI float wave_sum(float v) {
#pragma unroll
  for (int o = 32; o >= 1; o >>= 1) v += __shfl_xor(v, o, 64);
  return v;
}
DI void ln_phase(float* x, bf16_t* xb, const float* __restrict__ g, const float* __restrict__ bta) {
  const int tid = tid_l(); const int lane = tid & 63, wave = tid >> 6;
  for (int row = blockIdx.x * 8 + wave; row < NTOK; row += gridDim.x * 8) {
    float* xr = x + (size_t)row * 1024;
    f32x4 v[4];
    float s = 0.f;
#pragma unroll
    for (int i = 0; i < 4; ++i) { v[i] = *(const f32x4*)(xr + (i * 64 + lane) * 4); s += v[i][0] + v[i][1] + v[i][2] + v[i][3]; }
    const float mean = wave_sum(s) * (1.f / 1024.f);
    float q = 0.f;
#pragma unroll
    for (int i = 0; i < 4; ++i)
#pragma unroll
      for (int j = 0; j < 4; ++j) { const float d = v[i][j] - mean; q += d * d; }
    const float rstd = rsqrtf(wave_sum(q) * (1.f / 1024.f) + 1e-5f);
#pragma unroll
    for (int i = 0; i < 4; ++i) {
      const int c = (i * 64 + lane) * 4;
      f32x4 gv = *(const f32x4*)(g + c), bv = *(const f32x4*)(bta + c), o;
#pragma unroll
      for (int j = 0; j < 4; ++j) o[j] = (v[i][j] - mean) * rstd * gv[j] + bv[j];
      *(f32x4*)(xr + c) = o;
      u32x2 ob = {pk2(o[0], o[1]), pk2(o[2], o[3])};
      *(u32x2*)(xb + (size_t)row * 1024 + c) = ob;
    }
  }
}

DI void cumsum_phase(const float* __restrict__ lf, float* __restrict__ c2, char* lds) {
  float* wt = (float*)lds;
  const int tid = tid_l(), lane = tid & 63, wave = tid >> 6;
  for (int row = blockIdx.x; row < 32; row += gridDim.x) {
    const float* src = lf + (size_t)row * SEQ + tid * 32;
    float v[32];
#pragma unroll
    for (int i = 0; i < 8; ++i) { f32x4 t = *(const f32x4*)(src + 4 * i); v[4 * i] = t[0]; v[4 * i + 1] = t[1]; v[4 * i + 2] = t[2]; v[4 * i + 3] = t[3]; }
    float run = 0.f;
#pragma unroll
    for (int i = 0; i < 32; ++i) { run += v[i]; v[i] = run; }
    float inc = run;
#pragma unroll
    for (int o = 1; o < 64; o <<= 1) { const float t = __shfl_up(inc, o, 64); if (lane >= o) inc += t; }
    if (lane == 63) wt[wave] = inc;
    __syncthreads();
    float pre = inc - run;
    for (int w = 0; w < wave; ++w) pre += wt[w];
    float* dst = c2 + (size_t)row * SEQ + tid * 32;
#pragma unroll
    for (int i = 0; i < 8; ++i) { f32x4 o = {(pre + v[4 * i]) * LOG2E, (pre + v[4 * i + 1]) * LOG2E, (pre + v[4 * i + 2]) * LOG2E, (pre + v[4 * i + 3]) * LOG2E}; *(f32x4*)(dst + 4 * i) = o; }
    __syncthreads();
  }
}

template <int DVT, bool FOX>
DI void attn_step(const char* kb, const bf16x8 (&qf)[4], f32x16 (&o)[DVT], float& m, float& l, const bool diag, const int j, const int tq, const int r, const int hh) {
  constexpr int VB = DVT * 32 * LROW;
  const char* vb = kb + 64 * LROW; const char* cb = vb + VB;
  f32x16 st[2];
  bf16x8 kf[8];
#pragma unroll
  for (int ks = 0; ks < 4; ++ks)
#pragma unroll
    for (int kt = 0; kt < 2; ++kt) kf[ks * 2 + kt] = *(const bf16x8*)(kb + (kt * 32 + r) * LROW + ks * 32 + hh * 16);
  if (FOX) {
#pragma unroll
    for (int kt = 0; kt < 2; ++kt)
#pragma unroll
      for (int g = 0; g < 4; ++g) {
        f32x4 cs = *(const f32x4*)(cb + (kt * 32 + 8 * g + 4 * hh) * 4);
        st[kt][4 * g] = cs[0]; st[kt][4 * g + 1] = cs[1]; st[kt][4 * g + 2] = cs[2]; st[kt][4 * g + 3] = cs[3];
      }
  } else {
#pragma unroll
    for (int kt = 0; kt < 2; ++kt)
#pragma unroll
      for (int i = 0; i < 16; ++i) st[kt][i] = 0.f;
  }
  __builtin_amdgcn_sched_barrier(0);
#pragma unroll
  for (int ks = 0; ks < 4; ++ks)
#pragma unroll
    for (int kt = 0; kt < 2; ++kt) st[kt] = MFMA32(kf[ks * 2 + kt], qf[ks], st[kt]);
  bf16x8 va[DVT], vn[DVT];
#pragma unroll
  for (int d = 0; d < DVT; ++d) va[d] = *(const bf16x8*)(vb + (d * 32 + r) * LROW + (8 * hh) * 2);
  __builtin_amdgcn_sched_barrier(0);
  {
    const f32x2 mm = {m, m};
#pragma unroll
    for (int kt = 0; kt < 2; ++kt)
#pragma unroll
      for (int i = 0; i < 8; ++i) { f32x2 z = {st[kt][2 * i], st[kt][2 * i + 1]}; z = z - mm; st[kt][2 * i] = z[0]; st[kt][2 * i + 1] = z[1]; }
  }
  if (FOX) {
    if (diag) {
#pragma unroll
      for (int kt = 0; kt < 2; ++kt)
#pragma unroll
        for (int i = 0; i < 16; ++i) {
          const int key = j * 64 + kt * 32 + (i & 3) + 8 * (i >> 2) + 4 * hh;
          if (key > tq) st[kt][i] = -INFINITY;
        }
    }
  }
  float mx;
  {
    float a0 = fmaxf(fmaxf(st[0][0], st[0][1]), st[0][2]), a1 = fmaxf(fmaxf(st[1][0], st[1][1]), st[1][2]);
#pragma unroll
    for (int i = 3; i < 15; i += 2) { a0 = fmaxf(fmaxf(a0, st[0][i]), st[0][i + 1]); a1 = fmaxf(fmaxf(a1, st[1][i]), st[1][i + 1]); }
    mx = fmaxf(fmaxf(a0, a1), fmaxf(st[0][15], st[1][15]));
  }
  mx = xmax32(mx);
  if (__any(diag || mx > 8.f)) {
    const float d = (diag || mx > 0.f) ? mx : 0.f;
    const float alpha = diag ? 0.f : __builtin_amdgcn_exp2f(-d);
    m += d;
    l *= alpha;
#pragma unroll
    for (int dd = 0; dd < DVT; ++dd)
#pragma unroll
      for (int i = 0; i < 16; ++i) o[dd][i] *= alpha;
    const f32x2 d2 = {d, d};
#pragma unroll
    for (int kt = 0; kt < 2; ++kt)
#pragma unroll
      for (int i = 0; i < 8; ++i) { f32x2 z = {st[kt][2 * i], st[kt][2 * i + 1]}; z = z - d2; st[kt][2 * i] = z[0]; st[kt][2 * i + 1] = z[1]; }
  }
  f32x2 ls2 = {0.f, 0.f};
#pragma unroll
  for (int kt = 0; kt < 2; ++kt)
#pragma unroll
    for (int i = 0; i < 8; ++i) {
      f32x2 pv = {__builtin_amdgcn_exp2f(st[kt][2 * i]), __builtin_amdgcn_exp2f(st[kt][2 * i + 1])};
      st[kt][2 * i] = pv[0]; st[kt][2 * i + 1] = pv[1];
      ls2 = ls2 + pv;
    }
  l += ls2[0] + ls2[1];
  __builtin_amdgcn_sched_barrier(0);
#define A_PVGROUP(GK, VC, VN) { constexpr int kt_ = (GK) >> 1, s2_ = (GK) & 1; \
    if ((GK) < 3) { constexpr int kt1_ = ((GK) + 1) >> 1, s21_ = ((GK) + 1) & 1; \
      _Pragma("unroll") for (int d = 0; d < DVT; ++d) VN[d] = *(const bf16x8*)(vb + (d * 32 + r) * LROW + (kt1_ * 32 + 16 * s21_ + 8 * hh) * 2); } \
    u32x4 pw_ = {pk2(st[kt_][8 * s2_], st[kt_][8 * s2_ + 1]), pk2(st[kt_][8 * s2_ + 2], st[kt_][8 * s2_ + 3]), pk2(st[kt_][8 * s2_ + 4], st[kt_][8 * s2_ + 5]), pk2(st[kt_][8 * s2_ + 6], st[kt_][8 * s2_ + 7])}; \
    const bf16x8 pf_ = __builtin_bit_cast(bf16x8, pw_); \
    __builtin_amdgcn_sched_barrier(0); \
    _Pragma("unroll") for (int d = 0; d < DVT; ++d) o[d] = MFMA32(VC[d], pf_, o[d]); \
    __builtin_amdgcn_sched_barrier(0); }
  A_PVGROUP(0, va, vn); A_PVGROUP(1, vn, va); A_PVGROUP(2, va, vn); A_PVGROUP(3, vn, va);
#undef A_PVGROUP
}

template <int DVT, bool FOX>
DI void attn_pass(const bf16_t* __restrict__ qrow, const bf16_t* __restrict__ kbase, const int ldk, const bf16_t* __restrict__ vtbase,
                  const float* __restrict__ cbase, const int j_hi, const int my_last, const int j_lo_diag, const int tq, const float prune_c,
                  f32x16 (&o)[DVT], float& l_out, char* lds) {
  constexpr int VB = DVT * 32 * LROW;
  constexpr int STAGE = 64 * LROW + VB + 256;
  const int tid = tid_l(), lane = tid & 63;
  const int r = lane & 31, hh = lane >> 5;
  const int lrow = tid >> 3, lch = tid & 7;
  bf16x8 qf[4];
#pragma unroll
  for (int ks = 0; ks < 4; ++ks) qf[ks] = *(const bf16x8*)(qrow + ks * 16 + hh * 8);
#pragma unroll
  for (int d = 0; d < DVT; ++d)
#pragma unroll
    for (int i = 0; i < 16; ++i) o[d][i] = 0.f;
  float m = 0.f, l = 0.f;
  u32x4 kr0, kr1, vr0[DVT / 2], vr1[DVT / 2]; f32x4 cr0 = {0.f, 0.f, 0.f, 0.f}, cr1 = {0.f, 0.f, 0.f, 0.f};
  const bf16_t* kp = kbase + (size_t)lrow * ldk + lch * 8;
  const bf16_t* vp = vtbase + (size_t)lrow * SEQ + lch * 8;
#define A_GLOAD(KR, VR, CR, JT) { const int s1_ = (JT) * 64; KR = *(const u32x4*)(kp + (size_t)s1_ * ldk); \
    _Pragma("unroll") for (int i_ = 0; i_ < DVT / 2; ++i_) VR[i_] = *(const u32x4*)(vp + (size_t)(64 * i_) * SEQ + s1_); \
    if (FOX) { if (tid < 16) { f32x4 t_ = *(const f32x4*)(cbase + s1_ + tid * 4); CR[0] = -t_[0]; CR[1] = -t_[1]; CR[2] = -t_[2]; CR[3] = -t_[3]; } } }
#define A_LSTORE(KR, VR, CR, STG) { char* kb_ = lds + (STG) * STAGE; char* vb_ = kb_ + 64 * LROW; char* cb_ = vb_ + VB; \
    *(u32x4*)(kb_ + lrow * LROW + lch * 16) = KR; \
    _Pragma("unroll") for (int i_ = 0; i_ < DVT / 2; ++i_) *(u32x4*)(vb_ + (lrow + 64 * i_) * LROW + lch * 16) = VR[i_]; \
    if (FOX) { if (tid < 16) *(f32x4*)(cb_ + tid * 16) = CR; } }
#define A_PRUNE(STG) (FOX && j < j_lo_diag && (prune_c + *(const float*)(lds + (STG) * STAGE + 64 * LROW + VB + 63 * 4) < -160.f))
  int j = j_hi;
  A_GLOAD(kr0, vr0, cr0, j);
  if (j >= 1) A_GLOAD(kr1, vr1, cr1, j - 1);
  A_LSTORE(kr0, vr0, cr0, 0);
  __syncthreads();
  for (;;) {
    if (A_PRUNE(0)) break;
    if (j >= 2) A_GLOAD(kr0, vr0, cr0, j - 2);
    if (j <= my_last) attn_step<DVT, FOX>(lds, qf, o, m, l, j == my_last, j, tq, r, hh);
    if (j == 0) break;
    A_LSTORE(kr1, vr1, cr1, 1);
    __syncthreads();
    --j;
    if (A_PRUNE(1)) break;
    if (j >= 2) A_GLOAD(kr1, vr1, cr1, j - 2);
    if (j <= my_last) attn_step<DVT, FOX>(lds + STAGE, qf, o, m, l, j == my_last, j, tq, r, hh);
    if (j == 0) break;
    A_LSTORE(kr0, vr0, cr0, 0);
    __syncthreads();
    --j;
  }
  __syncthreads();
#undef A_GLOAD
#undef A_LSTORE
#undef A_PRUNE
  l_out = xsum32(l);
}

DI void fox_phase(const Params& p, const int j_odd, char* lds) {
  char* ws = (char*)launder(p.ws);
  const bf16_t* fq = (const bf16_t*)(ws + OFF_R1);
  const bf16_t* fk = (const bf16_t*)(ws + OFF_R1 + 64 * MiB);
  const bf16_t* fvT = (const bf16_t*)(ws + OFF_R1 + 128 * MiB);
  const bf16_t* fg = (const bf16_t*)(ws + OFF_R1 + 192 * MiB);
  const float* c2 = (const float*)(ws + OFF_C2);
  bf16_t* ab = (bf16_t*)(ws + OFF_AB);
  const float b2 = ((const float*)(ws + OFF_MISC))[1032 + j_odd];
  const int tid = tid_l(); const int lane = tid & 63, wave = __builtin_amdgcn_readfirstlane(tid >> 6), r = lane & 31, hh = lane >> 5;
  for (int rnd = 0; rnd < 4; ++rnd) {
    const int bh = rnd * 8 + (blockIdx.x & 7), pp = blockIdx.x >> 3, b = bh >> 4, h = bh & 15;
    for (int half = 0; half < 2; ++half) {
      const int qb = half == 0 ? 63 - pp : pp;
      const int t0 = qb * 256, tq0 = t0 + wave * 32, tq = tq0 + r;
      const int nkv = (t0 + 256) >> 6, my_last = (tq0 + 31) >> 6;
      const float prune_c = b2 + c2[(size_t)bh * SEQ + t0];
      f32x16 o[2]; float l;
      attn_pass<2, true>(fq + (size_t)(b * SEQ + tq) * 1024 + h * 64, fk + (size_t)(b * SEQ) * 1024 + h * 64, 1024,
                         fvT + (size_t)(bh * 64) * SEQ, c2 + (size_t)bh * SEQ, nkv - 1, my_last, t0 >> 6, tq, prune_c, o, l, lds);
      const float inv = 1.f / l;
      const size_t rowo = (size_t)(b * SEQ + tq) * 1024 + h * 64;
#pragma unroll
      for (int d = 0; d < 2; ++d)
#pragma unroll
        for (int g = 0; g < 4; ++g) {
          const int c = d * 32 + 8 * g + 4 * hh;
          u32x2 gv = *(const u32x2*)(fg + rowo + c);
          const float g0 = __uint_as_float(gv[0] << 16), g1 = __uint_as_float(gv[0] & 0xffff0000u), g2 = __uint_as_float(gv[1] << 16), g3 = __uint_as_float(gv[1] & 0xffff0000u);
          u32x2 ov = {pk2(o[d][4 * g] * inv * g0, o[d][4 * g + 1] * inv * g1), pk2(o[d][4 * g + 2] * inv * g2, o[d][4 * g + 3] * inv * g3)};
          *(u32x2*)(ab + rowo + c) = ov;
        }
    }
  }
}

DI void diff_phase(const Params& p, const int j_even, char* lds) {
  char* ws = (char*)launder(p.ws);
  const bf16_t* bq = (const bf16_t*)(ws + OFF_R1 + 160 * MiB);
  const bf16_t* bk = (const bf16_t*)(ws + OFF_R1 + 192 * MiB);
  const bf16_t* bvT = (const bf16_t*)(ws + OFF_R1 + 224 * MiB);
  bf16_t* ab = (bf16_t*)(ws + OFF_AB);
  const float* misc = (const float*)(ws + OFF_MISC);
  const float lam = misc[1024 + j_even];
  const float lam_init = 0.8f - 0.6f * expf(-0.3f * (float)(2 * j_even));
  const float* dg = ((const float*)p.diff_g) + j_even * 128;
  const int tid = tid_l(); const int lane = tid & 63, wave = __builtin_amdgcn_readfirstlane(tid >> 6), r = lane & 31, hh = lane >> 5;
  {
    const int bh = blockIdx.x & 7, pp = blockIdx.x >> 3, b = bh >> 2, h = bh & 3;
    for (int half = 0; half < 2; ++half) {
      const int qb = half == 0 ? 63 - pp : pp;
      const int t0 = qb * 256, tq0 = t0 + wave * 32, tq = tq0 + r;
      const int nkv = (t0 + 256) >> 6, my_last = tq0 >> 6;
      f32x16 o1[4], o2[4]; float l1, l2;
      attn_pass<4, false>(bq + (size_t)(b * SEQ + tq) * 512 + h * 128, bk + (size_t)(b * SEQ) * 512 + h * 128, 512,
                          bvT + (size_t)(bh * 128) * SEQ, nullptr, nkv - 1, my_last, 0, tq, 0.f, o1, l1, lds);
      const float i1 = 1.f / l1;
      unsigned* o1s = (unsigned*)(lds + DIFF_STASH_OFF) + tid;
#pragma unroll
      for (int d = 0; d < 4; ++d)
#pragma unroll
        for (int i = 0; i < 8; ++i) o1s[(d * 8 + i) * 512] = pk2(o1[d][2 * i] * i1, o1[d][2 * i + 1] * i1);
      attn_pass<4, false>(bq + (size_t)(b * SEQ + tq) * 512 + h * 128 + 64, bk + (size_t)(b * SEQ) * 512 + h * 128 + 64, 512,
                          bvT + (size_t)(bh * 128) * SEQ, nullptr, nkv - 1, my_last, 0, tq, 0.f, o2, l2, lds);
      const float i2 = lam / l2;
      float ssq = 0.f;
#pragma unroll
      for (int d = 0; d < 4; ++d)
#pragma unroll
        for (int i = 0; i < 8; ++i) {
          const unsigned pw = o1s[(d * 8 + i) * 512];
          const float va = __uint_as_float(pw << 16) - i2 * o2[d][2 * i], vb = __uint_as_float(pw & 0xffff0000u) - i2 * o2[d][2 * i + 1];
          o2[d][2 * i] = va; o2[d][2 * i + 1] = vb; ssq += va * va + vb * vb; }
      ssq = xsum32(ssq);
      const float rs = rsqrtf(ssq * (1.f / 128.f) + 1e-6f) * (1.f - lam_init);
      const size_t rowo = (size_t)(b * SEQ + tq) * 1024 + 512 + h * 128;
#pragma unroll
      for (int d = 0; d < 4; ++d)
#pragma unroll
        for (int g = 0; g < 4; ++g) {
          const int c = d * 32 + 8 * g + 4 * hh;
          f32x4 gv = *(const f32x4*)(dg + c);
          u32x2 ov = {pk2(o2[d][4 * g] * rs * gv[0], o2[d][4 * g + 1] * rs * gv[1]), pk2(o2[d][4 * g + 2] * rs * gv[2], o2[d][4 * g + 3] * rs * gv[3])};
          *(u32x2*)(ab + rowo + c) = ov;
        }
    }
  }
}

DI void hgrn_stageA(const Params& p, char* lds) {
  char* ws = (char*)launder(p.ws);
  const float* alf = (const float*)(ws + OFF_R1 + 32 * MiB);
  const bf16_t* aiT = (const bf16_t*)(ws + OFF_R1 + 96 * MiB);
  bf16_t* UT = (bf16_t*)(ws + OFF_UT);
  float* dbuf = (float*)(ws + OFF_DB);
  float* lfT = (float*)lds;
  float* part = (float*)(lds + 32768);
  char* KT = lds + 34816;
  char* IT = KT + 18432;
  const int tid = tid_l(), lane = tid & 63, wave = tid >> 6, r = lane & 31, hh = lane >> 5;
  f32x4 lfr[4]; u32x4 itr[2];
#define HA_FETCH(TASK) { const int bh_ = (TASK) >> 8, c_ = (TASK) & 255, tok0_ = (bh_ >> 2) * SEQ + c_ * 64, h_ = bh_ & 3; \
    _Pragma("unroll") for (int i = 0; i < 4; ++i) { const int idx = tid + 512 * i, row = idx >> 5, c4 = idx & 31; \
      lfr[i] = *(const f32x4*)(alf + (size_t)(tok0_ + row) * 512 + h_ * 128 + c4 * 4); } \
    _Pragma("unroll") for (int i = 0; i < 2; ++i) { const int idx = tid + 512 * i, row = idx >> 3, ch = idx & 7; \
      itr[i] = *(const u32x4*)(aiT + (size_t)(bh_ * 128 + row) * SEQ + c_ * 64 + ch * 8); } }
  if (blockIdx.x < 2048) HA_FETCH(blockIdx.x);
  for (int task = blockIdx.x; task < 2048; task += gridDim.x) {
    const int bh = task >> 8, c = task & 255;
#pragma unroll
    for (int i = 0; i < 4; ++i) { const int idx = tid + 512 * i, row = idx >> 5, c4 = idx & 31; *(f32x4*)(lfT + row * 128 + c4 * 4) = lfr[i]; }
#pragma unroll
    for (int i = 0; i < 2; ++i) { const int idx = tid + 512 * i, row = idx >> 3, ch = idx & 7; *(u32x4*)(IT + row * LROW + ch * 16) = itr[i]; }
    if (task + (int)gridDim.x < 2048) HA_FETCH(task + (int)gridDim.x);
    (void)bh; (void)c;
    __syncthreads();
    const int k = tid & 127, seg = tid >> 7;
    float lv[16], bv[16];
    float run = 0.f;
#pragma unroll
    for (int i = 0; i < 16; ++i) { lv[i] = lfT[(seg * 16 + i) * 128 + k]; run += lv[i]; bv[i] = run; }
    part[seg * 128 + k] = run;
    __syncthreads();
    float pre = 0.f, tot = 0.f;
#pragma unroll
    for (int s2 = 0; s2 < 4; ++s2) { const float pv = part[s2 * 128 + k]; if (s2 < seg) pre += pv; tot += pv; }
    {
      float kv[16];
#pragma unroll
      for (int i = 0; i < 16; ++i) kv[i] = (1.f - __expf(lv[i])) * __expf(tot - (pre + bv[i]));
      u32x4 w0 = {pk2(kv[0], kv[1]), pk2(kv[2], kv[3]), pk2(kv[4], kv[5]), pk2(kv[6], kv[7])};
      u32x4 w1 = {pk2(kv[8], kv[9]), pk2(kv[10], kv[11]), pk2(kv[12], kv[13]), pk2(kv[14], kv[15])};
      *(u32x4*)(KT + k * LROW + seg * 32) = w0;
      *(u32x4*)(KT + k * LROW + seg * 32 + 16) = w1;
    }
    if (seg == 0) dbuf[(size_t)task * 128 + k] = __expf(tot);
    __syncthreads();
    {
      const int ktile = wave & 3, vhalf = wave >> 2;
      f32x16 acc[2];
#pragma unroll
      for (int vt = 0; vt < 2; ++vt)
#pragma unroll
        for (int i = 0; i < 16; ++i) acc[vt][i] = 0.f;
#pragma unroll
      for (int ks = 0; ks < 4; ++ks) {
        bf16x8 a = *(const bf16x8*)(KT + (ktile * 32 + r) * LROW + ks * 32 + hh * 16);
#pragma unroll
        for (int vt = 0; vt < 2; ++vt) {
          bf16x8 bb = *(const bf16x8*)(IT + (vhalf * 64 + vt * 32 + r) * LROW + ks * 32 + hh * 16);
          acc[vt] = MFMA32(a, bb, acc[vt]);
        }
      }
#pragma unroll
      for (int vt = 0; vt < 2; ++vt) {
        bf16_t* dst = UT + ((size_t)task * 128 + vhalf * 64 + vt * 32 + r) * 128 + ktile * 32 + 4 * hh;
#pragma unroll
        for (int g = 0; g < 4; ++g) { u32x2 ov = {pk2(acc[vt][4 * g], acc[vt][4 * g + 1]), pk2(acc[vt][4 * g + 2], acc[vt][4 * g + 3])}; *(u32x2*)(dst + 8 * g) = ov; }
      }
    }
    __syncthreads();
  }
}

#undef HA_FETCH
DI void hgrn_scan(const Params& p) {
  char* ws = (char*)launder(p.ws);
  bf16_t* UT = (bf16_t*)(ws + OFF_UT);
  const float* dbuf = (const float*)(ws + OFF_DB);
  const int gid = blockIdx.x * 512 + tid_l();
  if (gid >= 8 * 16384) return;
  const int bh = gid >> 14, e = gid & 16383;
  bf16_t* up = UT + (size_t)bh * 256 * 16384 + e;
  const float* dp = dbuf + (size_t)bh * 256 * 128 + (e & 127);
  float st = 0.f;
  for (int c0 = 0; c0 < 256; c0 += 32) {
    bf16_t u[32]; float dv[32];
#pragma unroll
    for (int i = 0; i < 32; ++i) { u[i] = up[(size_t)(c0 + i) * 16384]; dv[i] = dp[(size_t)(c0 + i) * 128]; }
#pragma unroll
    for (int i = 0; i < 32; ++i) {
      up[(size_t)(c0 + i) * 16384] = f2bf(st);
      st = dv[i] * st + bf2f(u[i]);
    }
  }
}

constexpr int QROW = 272;
DI void hgrn_stageC(const Params& p, const int j_even, char* lds) {
  char* ws = (char*)launder(p.ws);
  const bf16_t* aq = (const bf16_t*)(ws + OFF_R1);
  const float* alf = (const float*)(ws + OFF_R1 + 32 * MiB);
  const bf16_t* aiT = (const bf16_t*)(ws + OFF_R1 + 96 * MiB);
  const bf16_t* ag = (const bf16_t*)(ws + OFF_R1 + 128 * MiB);
  const bf16_t* UT = (const bf16_t*)(ws + OFF_UT);
  bf16_t* ab = (bf16_t*)(ws + OFF_AB);
  const float* hg = ((const float*)p.hgrn_g) + j_even * 128;
  float* lfT = (float*)lds;
  char* ST = lds;
  char* Q1 = lds + 34816;
  char* Q2 = Q1 + 64 * QROW;
  char* K2 = Q2 + 64 * QROW;
  char* IT = K2 + 64 * QROW;
  float* part = (float*)(IT + 128 * LROW);
  const int tid = tid_l(), lane = tid & 63, wave = tid >> 6, r = lane & 31, hh = lane >> 5;
  f32x4 lfr[4]; u32x4 itr[2]; bf16_t qr[16];
#define HC_FETCH(TASK) { const int bh_ = (TASK) >> 8, c_ = (TASK) & 255, tok0_ = (bh_ >> 2) * SEQ + c_ * 64, h_ = bh_ & 3; \
    _Pragma("unroll") for (int i = 0; i < 4; ++i) { const int idx = tid + 512 * i, row = idx >> 5, c4 = idx & 31; \
      lfr[i] = *(const f32x4*)(alf + (size_t)(tok0_ + row) * 512 + h_ * 128 + c4 * 4); } \
    _Pragma("unroll") for (int i = 0; i < 2; ++i) { const int idx = tid + 512 * i, row = idx >> 3, ch = idx & 7; \
      itr[i] = *(const u32x4*)(aiT + (size_t)(bh_ * 128 + row) * SEQ + c_ * 64 + ch * 8); } \
    _Pragma("unroll") for (int i = 0; i < 16; ++i) qr[i] = aq[(size_t)(tok0_ + (tid >> 7) * 16 + i) * 512 + h_ * 128 + (tid & 127)]; }
  if (blockIdx.x < 2048) HC_FETCH(blockIdx.x);
  for (int task = blockIdx.x; task < 2048; task += gridDim.x) {
    const int bh = task >> 8, c = task & 255, b = bh >> 2, h = bh & 3;
    const int tok0 = b * SEQ + c * 64;
#pragma unroll
    for (int i = 0; i < 4; ++i) { const int idx = tid + 512 * i, row = idx >> 5, c4 = idx & 31; *(f32x4*)(lfT + row * 128 + c4 * 4) = lfr[i]; }
#pragma unroll
    for (int i = 0; i < 2; ++i) { const int idx = tid + 512 * i, row = idx >> 3, ch = idx & 7; *(u32x4*)(IT + row * LROW + ch * 16) = itr[i]; }
    float qcur[16];
#pragma unroll
    for (int i = 0; i < 16; ++i) qcur[i] = bf2f(qr[i]);
    u32x4 sreg[4];
#pragma unroll
    for (int i = 0; i < 4; ++i) sreg[i] = *(const u32x4*)(UT + (size_t)task * 16384 + (size_t)(tid + 512 * i) * 8);
    if (task + (int)gridDim.x < 2048) HC_FETCH(task + (int)gridDim.x);
    __syncthreads();
    const int k = tid & 127, seg = tid >> 7;
    float lv[16], bv[16];
    float run = 0.f;
#pragma unroll
    for (int i = 0; i < 16; ++i) { lv[i] = lfT[(seg * 16 + i) * 128 + k]; run += lv[i]; bv[i] = run; }
    part[seg * 128 + k] = run;
    __syncthreads();
    {
      const float p0 = part[k], p1 = part[128 + k], p2 = part[256 + k];
      const float pre = (seg > 0 ? p0 : 0.f) + (seg > 1 ? p1 : 0.f) + (seg > 2 ? p2 : 0.f);
      const float bmid = p0 + p1;
#pragma unroll
      for (int i = 0; i < 16; ++i) {
        const int t = seg * 16 + i;
        const float bt = pre + bv[i];
        const float qv = qcur[i];
        const float kk = 1.f - __expf(lv[i]);
        *(bf16_t*)(Q1 + t * QROW + k * 2) = f2bf(qv * __expf(bt));
        *(bf16_t*)(Q2 + t * QROW + k * 2) = f2bf(qv * __expf(fminf(bt - bmid, 80.f)));
        *(bf16_t*)(K2 + t * QROW + k * 2) = f2bf(kk * __expf(fminf(bmid - bt, 80.f)));
      }
    }
#pragma unroll
    for (int i = 0; i < 4; ++i) { const int idx = tid + 512 * i, row = idx >> 4, ch = idx & 15; *(u32x4*)(ST + row * QROW + ch * 16) = sreg[i]; }
    __syncthreads();
    {
      const int vt = wave & 3, tt = wave >> 2;
      const int t = tt * 32 + r;
      f32x16 sc[2];
#pragma unroll
      for (int st = 0; st < 2; ++st)
#pragma unroll
        for (int i = 0; i < 16; ++i) sc[st][i] = 0.f;
#pragma unroll
      for (int ks = 0; ks < 8; ++ks) {
        bf16x8 qb = *(const bf16x8*)(Q2 + t * QROW + ks * 32 + hh * 16);
#pragma unroll
        for (int st = 0; st < 2; ++st) {
          if (st <= tt) {
            bf16x8 a = *(const bf16x8*)(K2 + (st * 32 + r) * QROW + ks * 32 + hh * 16);
            sc[st] = MFMA32(a, qb, sc[st]);
          }
        }
      }
      f32x16 acc;
#pragma unroll
      for (int i = 0; i < 16; ++i) acc[i] = 0.f;
#pragma unroll
      for (int st = 0; st < 2; ++st) {
        if (st <= tt) {
#pragma unroll
          for (int i = 0; i < 16; ++i) { const int s = st * 32 + (i & 3) + 8 * (i >> 2) + 4 * hh; if (s > t) sc[st][i] = 0.f; }
#pragma unroll
          for (int s2 = 0; s2 < 2; ++s2) {
            u32x4 pw = {pk2(sc[st][8 * s2], sc[st][8 * s2 + 1]), pk2(sc[st][8 * s2 + 2], sc[st][8 * s2 + 3]), pk2(sc[st][8 * s2 + 4], sc[st][8 * s2 + 5]), pk2(sc[st][8 * s2 + 6], sc[st][8 * s2 + 7])};
            const bf16x8 pf = __builtin_bit_cast(bf16x8, pw);
            const char* ip = IT + (vt * 32 + r) * LROW + (st * 32 + 16 * s2 + 4 * hh) * 2;
            u32x2 lo = *(const u32x2*)ip, hi = *(const u32x2*)(ip + 16);
            u32x4 aw = {lo[0], lo[1], hi[0], hi[1]};
            acc = MFMA32(__builtin_bit_cast(bf16x8, aw), pf, acc);
          }
        }
      }
#pragma unroll
      for (int ks = 0; ks < 8; ++ks) {
        bf16x8 a = *(const bf16x8*)(ST + (vt * 32 + r) * QROW + ks * 32 + hh * 16);
        bf16x8 qb = *(const bf16x8*)(Q1 + t * QROW + ks * 32 + hh * 16);
        acc = MFMA32(a, qb, acc);
      }
      float ssq = 0.f;
#pragma unroll
      for (int i = 0; i < 16; ++i) ssq += acc[i] * acc[i];
      ssq = xsum32(ssq);
      if (hh == 0) part[vt * 64 + t] = ssq;
      __syncthreads();
      const float tot = part[t] + part[64 + t] + part[128 + t] + part[192 + t];
      const float rs = rsqrtf(tot * (1.f / 128.f) + 1e-6f);
      const size_t go = (size_t)(tok0 + t) * 512 + h * 128 + vt * 32 + 4 * hh;
      const size_t oo = (size_t)(tok0 + t) * 1024 + h * 128 + vt * 32 + 4 * hh;
#pragma unroll
      for (int g = 0; g < 4; ++g) {
        f32x4 gn = *(const f32x4*)(hg + vt * 32 + 4 * hh + 8 * g);
        u32x2 gv = *(const u32x2*)(ag + go + 8 * g);
        const float g0 = __uint_as_float(gv[0] << 16), g1 = __uint_as_float(gv[0] & 0xffff0000u), g2 = __uint_as_float(gv[1] << 16), g3 = __uint_as_float(gv[1] & 0xffff0000u);
        u32x2 ov = {pk2(acc[4 * g] * rs * gn[0] * g0, acc[4 * g + 1] * rs * gn[1] * g1), pk2(acc[4 * g + 2] * rs * gn[2] * g2, acc[4 * g + 3] * rs * gn[3] * g3)};
        *(u32x2*)(ab + oo + 8 * g) = ov;
      }
    }
    __syncthreads();
  }
}

#undef HC_FETCH
DI void grid_barrier(unsigned* ctr, const unsigned target) {
  asm volatile("s_waitcnt vmcnt(0)" ::: "memory");
  __syncthreads();
  if (threadIdx.x == 0) {
    __builtin_amdgcn_fence(__ATOMIC_RELEASE, "agent");
    asm volatile("s_waitcnt vmcnt(0)" ::: "memory");
    __hip_atomic_fetch_add((GAS unsigned*)ctr, 1u, __ATOMIC_RELAXED, __HIP_MEMORY_SCOPE_AGENT);
    while (__hip_atomic_load((GAS unsigned*)ctr, __ATOMIC_RELAXED, __HIP_MEMORY_SCOPE_AGENT) < target) __builtin_amdgcn_s_sleep(1);
    __builtin_amdgcn_fence(__ATOMIC_ACQUIRE, "agent");
    asm volatile("s_waitcnt vmcnt(0)" ::: "memory");
  }
  __syncthreads();
}
typedef const __attribute__((address_space(4))) Params* kparams_t;
#if defined(__HIP_DEVICE_COMPILE__)
DI kparams_t launder_k(kparams_t q) { asm volatile("" : "+s"(q)); return q; }
#endif
#if defined(__HIP_DEVICE_COMPILE__)
#define KPARAMS (*launder_k((kparams_t)__builtin_amdgcn_kernarg_segment_ptr()))
#else
#define KPARAMS p_arg
#endif
__global__ void __launch_bounds__(512) fwd_mega(Params p_arg) {
  extern __shared__ __attribute__((aligned(16))) char lds[];
  int ph = 0;
  const int p_lo = p_arg.lo, p_hi = p_arg.hi;
#define PHASE(id, ...) { if (ph >= p_lo && ph < p_hi) { const Params p = KPARAMS; char* ws = (char*)launder(p.ws); float* outp = (float*)launder((GAS char*)p.out); bf16_t* ab = (bf16_t*)(ws + OFF_AB); (void)outp; (void)ab; \
    if (ONLY < 0 || ONLY == id) { __VA_ARGS__; } if ((DUPMASK >> id) & 1) { __syncthreads(); __VA_ARGS__; } if (ph + 1 < p_hi) { if (ph == p_lo) cg::this_grid().sync(); else grid_barrier((unsigned*)(ws + OFF_CNT) + 256, (unsigned)(ph - p_lo) * gridDim.x); } } ++ph; }
  PHASE(0, phase0(p, lds));
  for (int l = 0; l < 4; ++l) {
    const int j = l >> 1;
    if ((l & 1) == 0) {
      PHASE(1,
        EpiEvenIn e;
        e.r1 = ws + OFF_R1; e.lb = (const float*)(ws + OFF_MISC) + j * 512;
        gemm_phase(ab, 1024, (const bf16_t*)(ws + OFF_WEI) + (size_t)j * EVEN_IN * D, EVEN_IN, D, e, lds));
      PHASE(2, hgrn_stageA(p, lds));
      PHASE(3, hgrn_scan(p));
      PHASE(4, hgrn_stageC(p, j, lds); diff_phase(p, j, lds));
      PHASE(6,
        EpiResLN er; er.xin = (l == 0) ? (const float*)launder((GAS char*)p.x_in) : outp; er.xout = outp; er.xb = ab;
        er.g = ((const float*)p.ln1g) + l * D; er.b = ((const float*)p.ln1b) + l * D;
        er.xchg = (float*)(ws + OFF_XCHG); er.cnt = (unsigned*)(ws + OFF_CNT); er.target = 4u * (unsigned)(2 * l + 1);
        gemm_phase(ab, 1024, (const bf16_t*)(ws + OFF_WEO) + (size_t)j * D * D, D, D, er, lds));
    } else {
      PHASE(7,
        EpiOddIn e;
        e.r1 = ws + OFF_R1;
        e.lf = (float*)(ws + OFF_LF); e.qg = ((const float*)p.fox_qg) + j * 64; e.kg = ((const float*)p.fox_kg) + j * 64; e.bf = ((const float*)p.fox_bf) + j * 16;
        gemm_phase(ab, 1024, (const bf16_t*)(ws + OFF_WFI) + (size_t)j * ODD_PAD * D, ODD_PAD, D, e, lds));
      PHASE(8, cumsum_phase((const float*)(ws + OFF_LF), (float*)(ws + OFF_C2), lds));
      PHASE(9, fox_phase(p, j, lds));
      PHASE(6,
        EpiResLN er; er.xin = outp; er.xout = outp; er.xb = ab;
        er.g = ((const float*)p.ln1g) + l * D; er.b = ((const float*)p.ln1b) + l * D;
        er.xchg = (float*)(ws + OFF_XCHG); er.cnt = (unsigned*)(ws + OFF_CNT); er.target = 4u * (unsigned)(2 * l + 1);
        gemm_phase(ab, 1024, (const bf16_t*)(ws + OFF_WFO) + (size_t)j * D * D, D, D, er, lds));
    }
    PHASE(11,
      EpiW1 e1; e1.act = (bf16_t*)(ws + OFF_R1);
      gemm_phase(ab, 1024, (const bf16_t*)(ws + OFF_W1) + (size_t)l * 2 * DFF * D, 2 * DFF, D, e1, lds));
    PHASE(6,
      EpiResLN e2; e2.xin = outp; e2.xout = outp; e2.xb = ab;
      e2.g = ((const float*)p.ln2g) + l * D; e2.b = ((const float*)p.ln2b) + l * D;
      e2.xchg = (float*)(ws + OFF_XCHG); e2.cnt = (unsigned*)(ws + OFF_CNT); e2.target = 4u * (unsigned)(2 * l + 2);
      gemm_phase((const bf16_t*)(ws + OFF_R1), DFF, (const bf16_t*)(ws + OFF_W2) + (size_t)l * D * DFF, D, DFF, e2, lds));
  }
#undef PHASE
}
constexpr int N_PHASES = 1 + 2 * 7 + 2 * 6;

extern "C" void kernel_launch(void* const* d_in, const int* in_sizes, int n_in, void* d_out, int out_size, void* d_ws, size_t ws_size, hipStream_t stream) {
  static bool attr = false;
  if (!attr) { hipFuncSetAttribute((const void*)fwd_mega, hipFuncAttributeMaxDynamicSharedMemorySize, LDS_BYTES); attr = true; }
  Params p{};
  p.x_in = (const GAS float*)d_in[0];
  p.even_w_in = (const GAS float*)d_in[1]; p.even_w_out = (const GAS float*)d_in[2]; p.lb_logits = (const GAS float*)d_in[3];
  p.lq1 = (const GAS float*)d_in[4]; p.lk1 = (const GAS float*)d_in[5]; p.lq2 = (const GAS float*)d_in[6]; p.lk2 = (const GAS float*)d_in[7];
  p.hgrn_g = (const GAS float*)d_in[8]; p.diff_g = (const GAS float*)d_in[9];
  p.fox_w_in = (const GAS float*)d_in[10]; p.fox_w_out = (const GAS float*)d_in[11]; p.fox_bf = (const GAS float*)d_in[12];
  p.fox_qg = (const GAS float*)d_in[13]; p.fox_kg = (const GAS float*)d_in[14];
  p.w1 = (const GAS float*)d_in[15]; p.w2 = (const GAS float*)d_in[16];
  p.ln1g = (const GAS float*)d_in[17]; p.ln1b = (const GAS float*)d_in[18]; p.ln2g = (const GAS float*)d_in[19]; p.ln2b = (const GAS float*)d_in[20];
  p.out = (GAS float*)d_out; p.ws = (GAS char*)d_ws;
#if COOP
  p.lo = 0; p.hi = N_PHASES;
  void* args[] = {&p};
  hipError_t e = hipLaunchCooperativeKernel((const void*)fwd_mega, dim3(256), dim3(512), args, LDS_BYTES, stream);
  if (e != hipSuccess) fprintf(stderr, "cooperative launch failed: %s\n", hipGetErrorString(e));
#else
  for (int ph = 0; ph < N_PHASES; ++ph) {
    p.lo = ph; p.hi = ph + 1;
    hipLaunchKernelGGL(fwd_mega, dim3(256), dim3(512), LDS_BYTES, stream, p);
  }
#endif
}
```

```cpp
#include <hip/hip_runtime.h>
#include <hip/hip_cooperative_groups.h>
#include <cstdio>
#include <cstdint>
namespace cg = cooperative_groups;

#ifndef COOP
#define COOP 1
#endif
#ifndef ONLY
#define ONLY -1
#endif
#ifndef DUPMASK
#define DUPMASK 0
#endif

typedef unsigned short bf16_t;
typedef short bf16x8 __attribute__((ext_vector_type(8)));
typedef float f32x16 __attribute__((ext_vector_type(16)));
typedef float f32x4 __attribute__((ext_vector_type(4)));
typedef float f32x2 __attribute__((ext_vector_type(2)));
typedef unsigned u32x4 __attribute__((ext_vector_type(4)));
typedef unsigned u32x2 __attribute__((ext_vector_type(2)));
typedef __bf16 bf16x2v __attribute__((ext_vector_type(2)));

#define DI __device__ __forceinline__
#define MFMA32(a, b, c) __builtin_amdgcn_mfma_f32_32x32x16_bf16((a), (b), (c), 0, 0, 0)

constexpr int D = 1024, SEQ = 16384, NTOK = 32768, DFF = 2816;
constexpr int EVEN_IN = 3584, ODD_IN = 4112, ODD_PAD = 4352;
constexpr float ALPHA = 1.6817928305074290f;
constexpr float LOG2E = 1.4426950408889634f;
constexpr size_t MiB = 1u << 20;

constexpr size_t OFF_WEI = 0;
constexpr size_t OFF_WEO = OFF_WEI + (size_t)2 * EVEN_IN * D * 2;
constexpr size_t OFF_WFI = OFF_WEO + (size_t)2 * D * D * 2;
constexpr size_t OFF_WFO = OFF_WFI + (size_t)2 * ODD_PAD * D * 2;
constexpr size_t OFF_W1  = OFF_WFO + (size_t)2 * D * D * 2;
constexpr size_t OFF_W2  = OFF_W1 + (size_t)4 * 2 * DFF * D * 2;
constexpr size_t W_END   = OFF_W2 + (size_t)4 * D * DFF * 2;
static_assert(W_END <= 105 * MiB, "weights region");
constexpr size_t OFF_R1 = 105 * MiB;
constexpr size_t OFF_AB = 361 * MiB;
constexpr size_t OFF_UT = 425 * MiB;
constexpr size_t OFF_DB = 489 * MiB;
constexpr size_t OFF_LF = 490 * MiB;
constexpr size_t OFF_C2 = 492 * MiB;
constexpr size_t OFF_MISC = 494 * MiB;
constexpr size_t OFF_CNT = OFF_MISC + 80 * 1024;
constexpr size_t OFF_XCHG = OFF_MISC + 128 * 1024;

#define GAS __attribute__((address_space(1)))
struct Params {
  const GAS float* x_in;
  const GAS float *even_w_in, *even_w_out, *lb_logits, *lq1, *lk1, *lq2, *lk2, *hgrn_g, *diff_g;
  const GAS float *fox_w_in, *fox_w_out, *fox_bf, *fox_qg, *fox_kg;
  const GAS float *w1, *w2, *ln1g, *ln1b, *ln2g, *ln2b;
  GAS float* out;
  GAS char* ws;
  int lo, hi;
};

DI unsigned pk2(float lo, float hi) { f32x2 v = {lo, hi}; bf16x2v b = __builtin_convertvector(v, bf16x2v); return __builtin_bit_cast(unsigned, b); }
DI bf16_t f2bf(float x) { return (bf16_t)(pk2(x, 0.f) & 0xffffu); }
DI float bf2f(bf16_t v) { return __uint_as_float(((unsigned)v) << 16); }
DI float sigmoidf_(float x) { return __builtin_amdgcn_rcpf(1.f + __builtin_amdgcn_exp2f(-LOG2E * x)); }
DI float siluf_(float x) { return x * __builtin_amdgcn_rcpf(1.f + __builtin_amdgcn_exp2f(-LOG2E * x)); }
DI GAS char* launder(GAS char* q) { asm volatile("" : "+s"(q)); return q; }
DI int tid_l() { int t = threadIdx.x; asm volatile("" : "+v"(t)); return t; }
DI int swz32(int s) { return (s & ~12) | ((s & 4) << 1) | ((s & 8) >> 1); }
DI float xsum32(float v) { const u32x2 r_ = __builtin_amdgcn_permlane32_swap(__float_as_uint(v), __float_as_uint(v), false, false); return __uint_as_float(r_[0]) + __uint_as_float(r_[1]); }
DI float xmax32(float v) { const u32x2 r_ = __builtin_amdgcn_permlane32_swap(__float_as_uint(v), __float_as_uint(v), false, false); return fmaxf(__uint_as_float(r_[0]), __uint_as_float(r_[1])); }

DI int perm32(int rho) { return (((rho >> 2) & 1) << 4) + (rho & 3) + ((rho >> 3) << 2); }
DI void convert_w(const float* __restrict__ w, bf16_t* __restrict__ wt, int K, int N, int Npad, int mode, float* tl) {
  const int tid = tid_l();
  const int nkt = K >> 6, nnt = Npad >> 6;
  for (int tile = blockIdx.x; tile < nkt * nnt; tile += gridDim.x) {
    const int k0 = (tile / nnt) << 6, n0 = (tile % nnt) << 6;
#pragma unroll
    for (int i = 0; i < 2; ++i) {
      const int kk = (tid >> 4) + 32 * i, n4 = (tid & 15) << 2;
      const int np = n0 + n4;
      int src = np;
      if (mode == 1) { const int grp = np >> 6, j = np & 63; src = (j < 32) ? grp * 32 + perm32(j) : DFF + grp * 32 + perm32(j - 32); }
      else if (mode == 2) src = (np & ~31) + perm32(np & 31);
      f32x4 v = {0.f, 0.f, 0.f, 0.f};
      if (src < N) v = *(const f32x4*)(w + (size_t)(k0 + kk) * N + src);
      tl[kk * 65 + n4 + 0] = v[0]; tl[kk * 65 + n4 + 1] = v[1]; tl[kk * 65 + n4 + 2] = v[2]; tl[kk * 65 + n4 + 3] = v[3];
    }
    __syncthreads();
    {
      const int n = tid >> 3, kc = (tid & 7) << 3;
      float f[8];
#pragma unroll
      for (int j = 0; j < 8; ++j) f[j] = tl[(kc + j) * 65 + n];
      u32x4 o = {pk2(f[0], f[1]), pk2(f[2], f[3]), pk2(f[4], f[5]), pk2(f[6], f[7])};
      *(u32x4*)(wt + (size_t)(n0 + n) * K + k0 + kc) = o;
    }
    __syncthreads();
  }
}

DI void phase0(const Params& p, char* lds) {
  float* tl = (float*)lds;
  char* ws = (char*)launder(p.ws);
  for (int j = 0; j < 2; ++j) {
    convert_w(((const float*)p.even_w_in) + (size_t)j * D * EVEN_IN, (bf16_t*)(ws + OFF_WEI) + (size_t)j * EVEN_IN * D, D, EVEN_IN, EVEN_IN, 2, tl);
    convert_w(((const float*)p.even_w_out) + (size_t)j * D * D, (bf16_t*)(ws + OFF_WEO) + (size_t)j * D * D, D, D, D, 0, tl);
    convert_w(((const float*)p.fox_w_in) + (size_t)j * D * ODD_IN, (bf16_t*)(ws + OFF_WFI) + (size_t)j * ODD_PAD * D, D, ODD_IN, ODD_PAD, 2, tl);
    convert_w(((const float*)p.fox_w_out) + (size_t)j * D * D, (bf16_t*)(ws + OFF_WFO) + (size_t)j * D * D, D, D, D, 0, tl);
  }
  for (int l = 0; l < 4; ++l) {
    convert_w(((const float*)p.w1) + (size_t)l * D * 2 * DFF, (bf16_t*)(ws + OFF_W1) + (size_t)l * 2 * DFF * D, D, 2 * DFF, 2 * DFF, 1, tl);
    convert_w(((const float*)p.w2) + (size_t)l * DFF * D, (bf16_t*)(ws + OFF_W2) + (size_t)l * D * DFF, DFF, D, D, 0, tl);
  }
  {
    bf16_t* ab = (bf16_t*)(ws + OFF_AB);
    const size_t n8 = (size_t)NTOK * D / 8;
    for (size_t i = (size_t)blockIdx.x * 512 + tid_l(); i < n8; i += (size_t)gridDim.x * 512) {
      f32x4 a = *(const f32x4*)(((const float*)p.x_in) + i * 8), b = *(const f32x4*)(((const float*)p.x_in) + i * 8 + 4);
      u32x4 o = {pk2(a[0], a[1]), pk2(a[2], a[3]), pk2(b[0], b[1]), pk2(b[2], b[3])};
      *(u32x4*)(ab + i * 8) = o;
    }
  }
  if (blockIdx.x == 0) { const int t_ = tid_l(); if (t_ < 128) ((unsigned*)(ws + OFF_CNT))[t_] = 0u; if (t_ == 128) ((unsigned*)(ws + OFF_CNT))[256] = 0u; }
  if (blockIdx.x == 0) {
    float* misc = (float*)(ws + OFF_MISC);
    const int tid = tid_l();
    {
      const float l0 = ((const float*)p.lb_logits)[tid], l1 = ((const float*)p.lb_logits)[512 + tid];
      const float mx = fmaxf(l0, l1);
      const float e0 = expf(l0 - mx), e1 = expf(l1 - mx);
      const float s0 = e0 / (e0 + e1), s1 = e1 / (e0 + e1);
      misc[tid] = s0 - s0;
      misc[512 + tid] = (s0 + s1) - s0;
    }
    if (tid < 2) {
      float d1 = 0.f, d2 = 0.f;
      for (int i = 0; i < 64; ++i) { d1 += ((const float*)p.lq1)[tid * 64 + i] * ((const float*)p.lk1)[tid * 64 + i]; d2 += ((const float*)p.lq2)[tid * 64 + i] * ((const float*)p.lk2)[tid * 64 + i]; }
      const float lam_init = 0.8f - 0.6f * expf(-0.3f * (float)(2 * tid));
      misc[1024 + tid] = expf(d1) - expf(d2) + lam_init;
      float mq = 0.f, mk = 0.f;
      for (int i = 0; i < 64; ++i) { mq = fmaxf(mq, fabsf(((const float*)p.fox_qg)[tid * 64 + i])); mk = fmaxf(mk, fabsf(((const float*)p.fox_kg)[tid * 64 + i])); }
      const float B = 0.125f * LOG2E * 64.f * mq * mk * 1.02f;
      misc[1032 + tid] = 2.f * B + 8.f;
    }
  }
}

constexpr int LROW = 144;
constexpr int G_XB = 256 * LROW, G_WB = 256 * LROW, G_STAGE = G_XB + G_WB;
constexpr int DIFF_STASH_OFF = 2 * (64 * LROW + 128 * LROW + 256);
constexpr int LDS_BYTES = 2 * G_STAGE;
static_assert(LDS_BYTES >= DIFF_STASH_OFF + 512 * 32 * 4, "lds");

template <class Epi>
DI void gemm_phase(const bf16_t* __restrict__ X, const int ldx, const bf16_t* __restrict__ Wt, const int N, const int K, const Epi& epi, char* lds) {
  const int tid = tid_l(), lane = tid & 63, wave = tid >> 6;
  const int r = lane & 31, hh = lane >> 5;
  const int tw = wave & 3, fw = wave >> 2;
  const int nNt = N >> 8;
  const int ntiles = nNt * (NTOK / 256);
  const int nk = K >> 6;
  const int lrow = tid >> 3, lch = tid & 7;
  const int xcd = blockIdx.x & 7, slot = blockIdx.x >> 3, nchunks = 4 * nNt;
  (void)ntiles;
  u32x4 xr0[4], wr0[4];
  for (int chunk = xcd; chunk < nchunks; chunk += 8) {
    const int L = chunk * 32 + slot, band = L / (4 * nNt), rem = L % (4 * nNt);
    const int mt_ = band * 4 + (rem & 3), nt_ = rem >> 2;
    const char* Xt = (const char*)(X + (size_t)(mt_ * 256) * ldx);
    const char* Wtb = (const char*)(Wt + (size_t)(nt_ * 256) * K);
    const unsigned xoff = (unsigned)(lrow * ldx + lch * 8) * 2u, woff = (unsigned)(lrow * K + lch * 8) * 2u;
    const bool has_next = !Epi::kFull && (chunk + 8 < nchunks);
    const int Ln = (has_next ? chunk + 8 : chunk) * 32 + slot, band_n = Ln / (4 * nNt), rem_n = Ln % (4 * nNt);
    const char* Xt_n = (const char*)(X + (size_t)((band_n * 4 + (rem_n & 3)) * 256) * ldx);
    const char* Wtb_n = (const char*)(Wt + (size_t)((rem_n >> 2) * 256) * K);
    f32x16 acc[2][2][2];
#define G_GLOAD(XR, WR, KT) { _Pragma("unroll") for (int i_ = 0; i_ < 4; ++i_) XR[i_] = *(const u32x4*)(Xt + ((size_t)(64 * i_) * ldx + (KT) * 64) * 2 + xoff); \
    _Pragma("unroll") for (int i_ = 0; i_ < 4; ++i_) WR[i_] = *(const u32x4*)(Wtb + ((size_t)(64 * i_) * K + (KT) * 64) * 2 + woff); }
#define G_LSTORE(XR, WR, STG) { char* xs_ = lds + (STG) * G_STAGE; char* ws_ = xs_ + G_XB; \
    _Pragma("unroll") for (int i_ = 0; i_ < 4; ++i_) *(u32x4*)(xs_ + (lrow + 64 * i_) * LROW + lch * 16) = XR[i_]; \
    _Pragma("unroll") for (int i_ = 0; i_ < 4; ++i_) *(u32x4*)(ws_ + (lrow + 64 * i_) * LROW + lch * 16) = WR[i_]; }
#define G_PART(Q, STG, KT, DOLOAD) { char* xs_ = lds + (STG) * G_STAGE; char* ws_ = xs_ + G_XB; \
    if ((Q) < 2) { _Pragma("unroll") for (int i_ = 2 * (Q); i_ < 2 * (Q) + 2; ++i_) { *(u32x4*)(xs_ + (lrow + 64 * i_) * LROW + lch * 16) = xr0[i_]; \
        if (DOLOAD) xr0[i_] = *(const u32x4*)(xb_ + ((size_t)(64 * i_) * ldx + (KT) * 64) * 2 + xoff); } } \
    else { _Pragma("unroll") for (int i_ = 2 * ((Q) - 2); i_ < 2 * ((Q) - 2) + 2; ++i_) { *(u32x4*)(ws_ + (lrow + 64 * i_) * LROW + lch * 16) = wr0[i_]; \
        if (DOLOAD) wr0[i_] = *(const u32x4*)(wb_ + ((size_t)(64 * i_) * K + (KT) * 64) * 2 + woff); } } \
    __builtin_amdgcn_sched_barrier(0); }
#define G_LDX(XF, KS) { _Pragma("unroll") for (int m = 0; m < 2; ++m) XF[m] = *(const bf16x8*)(xs + (tw * 64 + m * 32 + r) * LROW + (KS) * 32 + hh * 16); }
#define G_LDW(WF, N0, KS) { _Pragma("unroll") for (int n = 0; n < 2; ++n) WF[n] = *(const bf16x8*)(wsm + (fw * 128 + ((N0) + n) * 32 + r) * LROW + (KS) * 32 + hh * 16); }
#define G_MFMA4S(XF, WF, H) { _Pragma("unroll") for (int n = 0; n < 2; ++n) _Pragma("unroll") for (int m = 0; m < 2; ++m) acc[H][n][m] = MFMA32(XF[m], WF[n], acc[H][n][m]); }
#define G_MFMA4(XF, WF, H) { _Pragma("unroll") for (int n = 0; n < 2; ++n) _Pragma("unroll") for (int m = 0; m < 2; ++m) acc[H][n][m] = MFMA32(WF[n], XF[m], acc[H][n][m]); }
#define G_STEP(MM, KS, XC, XN) { G_LDW(wc, 2, KS); if ((KS) < 3) { G_LDX(XN, (KS) + 1); } __builtin_amdgcn_sched_barrier(0); \
    MM(XC, w01, 0); __builtin_amdgcn_sched_barrier(0); if ((KS) < 3) { G_LDW(w01, 0, (KS) + 1); } MM(XC, wc, 1); __builtin_amdgcn_sched_barrier(0); }
#define G_COMPUTE_ST(MM, STG, DOSTORE, NSTG, KTL, DOLOAD) { const char* xs = lds + (STG) * G_STAGE; const char* wsm = xs + G_XB; \
    bf16x8 xfa[2], xfb[2], w01[2], wc[2]; \
    G_LDX(xfa, 0); G_LDW(w01, 0, 0); \
    G_STEP(MM, 0, xfa, xfb); if (DOSTORE) { G_PART(0, NSTG, KTL, DOLOAD); G_PART(1, NSTG, KTL, DOLOAD); } \
    G_STEP(MM, 1, xfb, xfa); if (DOSTORE) G_PART(2, NSTG, KTL, DOLOAD); \
    G_STEP(MM, 2, xfa, xfb); if (DOSTORE) G_PART(3, NSTG, KTL, DOLOAD); \
    G_STEP(MM, 3, xfb, xfa); }
#define G_COMPUTE(MM, STG) { const char* xs = lds + (STG) * G_STAGE; const char* wsm = xs + G_XB; \
    bf16x8 xfa[2], xfb[2], w01[2], wc[2]; \
    G_LDX(xfa, 0); G_LDW(w01, 0, 0); \
    G_STEP(MM, 0, xfa, xfb); G_STEP(MM, 1, xfb, xfa); G_STEP(MM, 2, xfa, xfb); G_STEP(MM, 3, xfb, xfa); }
    asm volatile("" ::: "memory");
    if (Epi::kFull || chunk == xcd) {
      G_GLOAD(xr0, wr0, 0);
      G_LSTORE(xr0, wr0, 0);
      __syncthreads();
      G_GLOAD(xr0, wr0, 1);
    }
#pragma unroll
    for (int c = 0; c < 2; ++c)
#pragma unroll
      for (int a = 0; a < 2; ++a)
#pragma unroll
        for (int b = 0; b < 2; ++b)
#pragma unroll
          for (int i = 0; i < 16; ++i) acc[c][a][b][i] = 0.f;
#define G_KLOOP(MM) for (int kt = 0; kt < nk; kt += 2) { \
        \
        \
      { const bool in_ = (kt + 2 < nk); const char* xb_ = in_ ? Xt : Xt_n; const char* wb_ = in_ ? Wtb : Wtb_n; \
        const int k2_ = in_ ? kt + 2 : (has_next ? 0 : nk - 1); G_COMPUTE_ST(MM, 0, true, 1, k2_, true); } \
      __syncthreads(); \
      { const bool in_ = (kt + 3 < nk); const char* xb_ = in_ ? Xt : Xt_n; const char* wb_ = in_ ? Wtb : Wtb_n; \
        const int k3_ = in_ ? kt + 3 : (has_next ? 1 : nk - 1); G_COMPUTE_ST(MM, 1, true, 0, k3_, true); } \
      __syncthreads(); \
    }
    const bool sw = Epi::kSwap && epi.swap_tile(nt_);
#define G_EPI_IDS const int t2 = tid_l(); const int r2 = t2 & 31, hh2 = (t2 >> 5) & 1, tw2 = (t2 >> 6) & 3, fw2 = t2 >> 8;
    if (sw) {
      G_KLOOP(G_MFMA4S)
      if constexpr (Epi::kSwap) {
        G_EPI_IDS
        epi.swapped(mt_ * 256 + tw2 * 64, nt_ * 256 + fw2 * 128, acc[0], r2, hh2);
        __builtin_amdgcn_sched_barrier(0);
        epi.swapped(mt_ * 256 + tw2 * 64, nt_ * 256 + fw2 * 128 + 64, acc[1], r2, hh2);
      }
    } else {
      G_KLOOP(G_MFMA4)
      G_EPI_IDS
      if constexpr (Epi::kFull) {
        epi.full(mt_, nt_, acc, tw2, fw2, r2, hh2, lds, t2);
      } else {
        epi(mt_ * 256 + tw2 * 64, nt_ * 256 + fw2 * 128, acc[0], r2, hh2);
        __builtin_amdgcn_sched_barrier(0);
        epi(mt_ * 256 + tw2 * 64, nt_ * 256 + fw2 * 128 + 64, acc[1], r2, hh2);
      }
    }
#undef G_EPI_IDS
#undef G_KLOOP
#undef G_GLOAD
#undef G_LSTORE
#undef G_COMPUTE
#undef G_PART
#undef G_COMPUTE_ST
#undef G_LDX
#undef G_LDW
#undef G_MFMA4
#undef G_MFMA4S
#undef G_STEP
    __builtin_amdgcn_sched_barrier(0);
  }
}

struct EpiEvenIn {
  static constexpr bool kFull = false, kSwap = false;
  DI bool swap_tile(int nt_) const { const int seg = nt_ >> 1; return seg == 2 || seg == 6; }
  char* r1; const float* lb;
#define aq  ((bf16_t*)(r1))
#define alf ((float*)(r1 + 32 * MiB))
#define aiT ((bf16_t*)(r1 + 96 * MiB))
#define ag  ((bf16_t*)(r1 + 128 * MiB))
#define bq  ((bf16_t*)(r1 + 160 * MiB))
#define bk  ((bf16_t*)(r1 + 192 * MiB))
#define bvT ((bf16_t*)(r1 + 224 * MiB))
  DI void operator()(int tok0, int feat0, f32x16 (&acc)[2][2], int r, int hh) const {
    const int seg = feat0 >> 9, c0 = feat0 & 511;
#pragma unroll
    for (int mt = 0; mt < 2; ++mt) {
      const int tok = tok0 + mt * 32 + r, b = tok >> 14, s = tok & (SEQ - 1);
#pragma unroll
      for (int nt = 0; nt < 2; ++nt)
#pragma unroll
        for (int gp = 0; gp < 2; ++gp) {
          const int c = c0 + nt * 32 + 16 * hh + 8 * gp;
          float v[8];
#pragma unroll
          for (int e = 0; e < 8; ++e) v[e] = acc[nt][mt][8 * gp + e];
          if (seg == 0 || seg == 3) {
            u32x4 o = {pk2(siluf_(v[0]), siluf_(v[1])), pk2(siluf_(v[2]), siluf_(v[3])), pk2(siluf_(v[4]), siluf_(v[5])), pk2(siluf_(v[6]), siluf_(v[7]))};
            *(u32x4*)((seg == 0 ? aq : ag) + (size_t)tok * 512 + c) = o;
          } else if (seg == 1) {
#pragma unroll
            for (int h2 = 0; h2 < 2; ++h2) {
              f32x4 lbv = *(const f32x4*)(lb + c + 4 * h2), o;
#pragma unroll
              for (int e = 0; e < 4; ++e) o[e] = __logf(lbv[e] + (1.f - lbv[e]) * sigmoidf_(v[4 * h2 + e]));
              *(f32x4*)(alf + (size_t)tok * 512 + c + 4 * h2) = o;
            }
          } else if (seg == 4 || seg == 5) {
            const float sc = seg == 4 ? 0.125f * LOG2E : 1.f;
            u32x4 o = {pk2(v[0] * sc, v[1] * sc), pk2(v[2] * sc, v[3] * sc), pk2(v[4] * sc, v[5] * sc), pk2(v[6] * sc, v[7] * sc)};
            *(u32x4*)((seg == 4 ? bq : bk) + (size_t)tok * 512 + c) = o;
          } else {
            bf16_t* dst = (seg == 2 ? aiT : bvT) + ((size_t)((b * 4 + (c >> 7)) * 128 + (c & 127))) * SEQ + (seg == 2 ? s : swz32(s));
#pragma unroll
            for (int e = 0; e < 8; ++e) dst[(size_t)e * SEQ] = f2bf(v[e]);
          }
          __builtin_amdgcn_sched_barrier(0);
        }
    }
  }
  DI void swapped(int tok0, int feat0, f32x16 (&acc)[2][2], int r, int hh) const {
    const int seg = feat0 >> 9, c0 = feat0 & 511;
#pragma unroll
    for (int nt = 0; nt < 2; ++nt) {
      const int c = c0 + nt * 32 + r;
#pragma unroll
      for (int mt = 0; mt < 2; ++mt)
#pragma unroll
        for (int g = 0; g < 4; ++g) {
          const int tok = tok0 + mt * 32 + 8 * g + 4 * hh, b = tok >> 14, s = tok & (SEQ - 1);
          u32x2 o = {pk2(acc[nt][mt][4 * g], acc[nt][mt][4 * g + 1]), pk2(acc[nt][mt][4 * g + 2], acc[nt][mt][4 * g + 3])};
          bf16_t* base = (seg == 2 ? aiT : bvT) + ((size_t)((b * 4 + (c >> 7)) * 128 + (c & 127))) * SEQ;
          *(u32x2*)(base + (seg == 2 ? s : swz32(s))) = o;
        }
    }
  }
};

#undef aq
#undef alf
#undef aiT
#undef ag
#undef bq
#undef bk
#undef bvT
struct EpiOddIn {
  static constexpr bool kFull = false, kSwap = false;
  DI bool swap_tile(int nt_) const { return (nt_ >> 2) == 2; }
  char* r1; float* lf; const float *qg, *kg, *bf;
#define fq  ((bf16_t*)(r1))
#define fk  ((bf16_t*)(r1 + 64 * MiB))
#define fvT ((bf16_t*)(r1 + 128 * MiB))
#define fg  ((bf16_t*)(r1 + 192 * MiB))
  DI void operator()(int tok0, int feat0, f32x16 (&acc)[2][2], int r, int hh) const {
    const int seg = feat0 >> 10, c0 = feat0 & 1023;
#pragma unroll
    for (int mt = 0; mt < 2; ++mt) {
      const int tok = tok0 + mt * 32 + r, b = tok >> 14, s = tok & (SEQ - 1);
      if (seg < 2) {
        float ssq = 0.f;
#pragma unroll
        for (int nt = 0; nt < 2; ++nt)
#pragma unroll
          for (int i = 0; i < 16; ++i) ssq += acc[nt][mt][i] * acc[nt][mt][i];
        ssq = xsum32(ssq);
        float rs = rsqrtf(ssq * (1.f / 64.f) + 1e-6f);
        if (seg == 0) rs *= 0.125f * LOG2E;
        const float* gg = seg == 0 ? qg : kg;
        bf16_t* dstb = (seg == 0 ? fq : fk) + (size_t)tok * 1024 + c0;
#pragma unroll
        for (int nt = 0; nt < 2; ++nt)
#pragma unroll
          for (int gp = 0; gp < 2; ++gp) {
            const int d = nt * 32 + 16 * hh + 8 * gp;
            f32x4 g0 = *(const f32x4*)(gg + d), g1 = *(const f32x4*)(gg + d + 4);
            u32x4 o = {pk2(acc[nt][mt][8 * gp] * rs * g0[0], acc[nt][mt][8 * gp + 1] * rs * g0[1]), pk2(acc[nt][mt][8 * gp + 2] * rs * g0[2], acc[nt][mt][8 * gp + 3] * rs * g0[3]),
                       pk2(acc[nt][mt][8 * gp + 4] * rs * g1[0], acc[nt][mt][8 * gp + 5] * rs * g1[1]), pk2(acc[nt][mt][8 * gp + 6] * rs * g1[2], acc[nt][mt][8 * gp + 7] * rs * g1[3])};
            *(u32x4*)(dstb + d) = o;
            __builtin_amdgcn_sched_barrier(0);
          }
      } else if (seg == 2) {
        const int head = c0 >> 6;
#pragma unroll
        for (int nt = 0; nt < 2; ++nt)
#pragma unroll
          for (int i = 0; i < 16; ++i) {
            const int d = nt * 32 + 16 * hh + i;
            fvT[((size_t)((b * 16 + head) * 64 + d)) * SEQ + swz32(s)] = f2bf(acc[nt][mt][i]);
          }
      } else if (seg == 3) {
#pragma unroll
        for (int nt = 0; nt < 2; ++nt)
#pragma unroll
          for (int gp = 0; gp < 2; ++gp) {
            const int c = c0 + nt * 32 + 16 * hh + 8 * gp;
            u32x4 o = {pk2(sigmoidf_(acc[nt][mt][8 * gp]), sigmoidf_(acc[nt][mt][8 * gp + 1])), pk2(sigmoidf_(acc[nt][mt][8 * gp + 2]), sigmoidf_(acc[nt][mt][8 * gp + 3])),
                       pk2(sigmoidf_(acc[nt][mt][8 * gp + 4]), sigmoidf_(acc[nt][mt][8 * gp + 5])), pk2(sigmoidf_(acc[nt][mt][8 * gp + 6]), sigmoidf_(acc[nt][mt][8 * gp + 7]))};
            *(u32x4*)(fg + (size_t)tok * 1024 + c) = o;
            __builtin_amdgcn_sched_barrier(0);
          }
      } else if (feat0 == 4096) {
        if (hh == 0) {
#pragma unroll
          for (int i = 0; i < 16; ++i) {
            const float xv = acc[0][mt][i] + bf[i];
            const float ls = fminf(xv, 0.f) - log1pf(expf(-fabsf(xv)));
            lf[((size_t)(b * 16 + i)) * SEQ + s] = ls;
          }
        }
      }
    }
  }
  DI void swapped(int tok0, int feat0, f32x16 (&acc)[2][2], int r, int hh) const {
    const int head = (feat0 & 1023) >> 6;
#pragma unroll
    for (int nt = 0; nt < 2; ++nt) {
      const int d = nt * 32 + r;
#pragma unroll
      for (int mt = 0; mt < 2; ++mt)
#pragma unroll
        for (int g = 0; g < 4; ++g) {
          const int tok = tok0 + mt * 32 + 8 * g + 4 * hh, b = tok >> 14, s = tok & (SEQ - 1);
          u32x2 o = {pk2(acc[nt][mt][4 * g], acc[nt][mt][4 * g + 1]), pk2(acc[nt][mt][4 * g + 2], acc[nt][mt][4 * g + 3])};
          *(u32x2*)(fvT + ((size_t)((b * 16 + head) * 64 + d)) * SEQ + swz32(s)) = o;
        }
    }
  }
};

#undef fq
#undef fk
#undef fvT
#undef fg
struct EpiRes {
  static constexpr bool kFull = false;
  const float* xin; float* y;
  DI void operator()(int tok0, int feat0, f32x16 (&acc)[2][2], int r, int hh) const {
#pragma unroll
    for (int mt = 0; mt < 2; ++mt) {
      const size_t rowo = (size_t)(tok0 + mt * 32 + r) * 1024;
#pragma unroll
      for (int nt = 0; nt < 2; ++nt)
#pragma unroll
        for (int g = 0; g < 4; ++g) {
          const int c = feat0 + nt * 32 + 8 * g + 4 * hh;
          f32x4 xv = *(const f32x4*)(xin + rowo + c);
          f32x4 o = {ALPHA * xv[0] + acc[nt][mt][4 * g], ALPHA * xv[1] + acc[nt][mt][4 * g + 1], ALPHA * xv[2] + acc[nt][mt][4 * g + 2], ALPHA * xv[3] + acc[nt][mt][4 * g + 3]};
          *(f32x4*)(y + rowo + c) = o;
          if (g & 1) __builtin_amdgcn_sched_barrier(0);
        }
    }
  }
};

struct EpiResLN {
  static constexpr bool kFull = true, kSwap = false;
  DI bool swap_tile(int) const { return false; }
  const float* xin; float* xout; bf16_t* xb; const float *g, *b; float* xchg; unsigned* cnt; unsigned target;
  DI void full(const int mt_, const int nt_, f32x16 (&acc)[2][2][2], const int tw, const int fw, const int r, const int hh, char* lds, const int tid) const {
    float* part = (float*)(lds + G_STAGE);
    const size_t rbase = (size_t)(mt_ * 256 + tw * 64 + r) * 1024 + nt_ * 256 + fw * 128 + 4 * hh;
    f32x4 xa[4], xc[4], xe[4];
#define RL_LOAD(XV, G) { constexpr int mt__ = (G) >> 2, half__ = ((G) >> 1) & 1, nt__ = (G) & 1; \
    _Pragma("unroll") for (int gq = 0; gq < 4; ++gq) XV[gq] = *(const f32x4*)(xin + rbase + (size_t)mt__ * 32 * 1024 + half__ * 64 + nt__ * 32 + 8 * gq); }
#define RL_FOLD(XV, G, SM, SQ) { constexpr int mt__ = (G) >> 2, half__ = ((G) >> 1) & 1, nt__ = (G) & 1; \
    _Pragma("unroll") for (int gq = 0; gq < 4; ++gq) _Pragma("unroll") for (int jj = 0; jj < 4; ++jj) { \
      const float y = ALPHA * XV[gq][jj] + acc[half__][nt__][mt__][4 * gq + jj]; acc[half__][nt__][mt__][4 * gq + jj] = y; SM += y; SQ += y * y; } }
#define SB __builtin_amdgcn_sched_barrier(0)
    float sm0 = 0.f, sq0 = 0.f, sm1 = 0.f, sq1 = 0.f;
    RL_LOAD(xa, 0); RL_LOAD(xc, 1); RL_LOAD(xe, 2); SB;
    RL_FOLD(xa, 0, sm0, sq0); SB; RL_LOAD(xa, 3); SB;
    RL_FOLD(xc, 1, sm0, sq0); SB; RL_LOAD(xc, 4); SB;
    RL_FOLD(xe, 2, sm0, sq0); SB; RL_LOAD(xe, 5); SB;
    RL_FOLD(xa, 3, sm0, sq0); SB; RL_LOAD(xa, 6); SB;
    RL_FOLD(xc, 4, sm1, sq1); SB; RL_LOAD(xc, 7); SB;
    RL_FOLD(xe, 5, sm1, sq1); SB;
    RL_FOLD(xa, 6, sm1, sq1); SB;
    RL_FOLD(xc, 7, sm1, sq1);
#undef SB
#undef RL_LOAD
#undef RL_FOLD
    sm0 += __shfl_xor(sm0, 32, 64); sq0 += __shfl_xor(sq0, 32, 64); sm1 += __shfl_xor(sm1, 32, 64); sq1 += __shfl_xor(sq1, 32, 64);
    if (hh == 0) {
      float* pp = part + ((fw * 256) + tw * 64 + r) * 2; pp[0] = sm0; pp[1] = sq0;
      pp[64] = sm1; pp[65] = sq1;
    }
    __syncthreads();
    if (tid < 256) {
      f32x2 a = *(const f32x2*)(part + tid * 2), c = *(const f32x2*)(part + (256 + tid) * 2);
      const unsigned long long pk = ((unsigned long long)__float_as_uint(a[1] + c[1]) << 32) | (unsigned long long)__float_as_uint(a[0] + c[0]);
      __hip_atomic_store((GAS unsigned long long*)(xchg + ((size_t)(mt_ * 4 + nt_) * 256 + tid) * 2), pk, __ATOMIC_RELAXED, __HIP_MEMORY_SCOPE_AGENT);
    }
    asm volatile("s_waitcnt vmcnt(0)" ::: "memory");
    __syncthreads();
    if (tid == 0) {
      __hip_atomic_fetch_add((GAS unsigned*)(cnt + mt_), 1u, __ATOMIC_RELAXED, __HIP_MEMORY_SCOPE_AGENT);
      while (__hip_atomic_load((GAS unsigned*)(cnt + mt_), __ATOMIC_RELAXED, __HIP_MEMORY_SCOPE_AGENT) < target) __builtin_amdgcn_s_sleep(1);
    }
    __syncthreads();
#pragma unroll
    for (int mt = 0; mt < 2; ++mt) {
      const int tl = tw * 64 + mt * 32 + r;
      float S = 0.f, Q = 0.f;
#pragma unroll
      for (int k = 0; k < 4; ++k) {
        const unsigned long long pk = __hip_atomic_load((GAS unsigned long long*)(xchg + ((size_t)(mt_ * 4 + k) * 256 + tl) * 2), __ATOMIC_RELAXED, __HIP_MEMORY_SCOPE_AGENT);
        S += __uint_as_float((unsigned)pk);
        Q += __uint_as_float((unsigned)(pk >> 32));
      }
      const float mean = S * (1.f / 1024.f);
      const float rstd = rsqrtf(fmaxf(Q * (1.f / 1024.f) - mean * mean, 0.f) + 1e-5f);
      const int c0 = nt_ * 256 + fw * 128 + 4 * hh;
      const size_t rowo = (size_t)(mt_ * 256 + tl) * 1024 + c0;
#pragma unroll
      for (int half = 0; half < 2; ++half)
#pragma unroll
        for (int nt = 0; nt < 2; ++nt) {
#pragma unroll
          for (int gq = 0; gq < 4; ++gq) {
            const int co = half * 64 + nt * 32 + 8 * gq;
            f32x4 gv = *(const f32x4*)(g + c0 + co), bv = *(const f32x4*)(b + c0 + co), o;
#pragma unroll
            for (int jj = 0; jj < 4; ++jj) o[jj] = (acc[half][nt][mt][4 * gq + jj] - mean) * rstd * gv[jj] + bv[jj];
            *(f32x4*)(xout + rowo + co) = o;
            u32x2 ob = {pk2(o[0], o[1]), pk2(o[2], o[3])};
            *(u32x2*)(xb + rowo + co) = ob;
          }
          __builtin_amdgcn_sched_barrier(0);
        }
    }
    __syncthreads();
  }
};

struct EpiW1 {
  static constexpr bool kFull = false, kSwap = false;
  DI bool swap_tile(int) const { return false; }
  DI void swapped(int, int, f32x16 (&)[2][2], int, int) const {}
  bf16_t* act;
  DI void operator()(int tok0, int feat0, f32x16 (&acc)[2][2], int r, int hh) const {
    const int u0 = (feat0 >> 6) * 32;
#pragma unroll
    for (int mt = 0; mt < 2; ++mt) {
      bf16_t* dst = act + (size_t)(tok0 + mt * 32 + r) * DFF + u0 + 16 * hh;
#pragma unroll
      for (int gp = 0; gp < 2; ++gp) {
        u32x4 o;
#pragma unroll
        for (int q = 0; q < 4; ++q) { const int i = 8 * gp + 2 * q; o[q] = pk2(siluf_(acc[0][mt][i]) * acc[1][mt][i], siluf_(acc[0][mt][i + 1]) * acc[1][mt][i + 1]); }
        *(u32x4*)(dst + 8 * gp) = o;
      }
    }
  }
};

DI float wave_sum(float v) {
#pragma unroll
  for (int o = 32; o >= 1; o >>= 1) v += __shfl_xor(v, o, 64);
  return v;
}
DI void ln_phase(float* x, bf16_t* xb, const float* __restrict__ g, const float* __restrict__ bta) {
  const int tid = tid_l(); const int lane = tid & 63, wave = tid >> 6;
  for (int row = blockIdx.x * 8 + wave; row < NTOK; row += gridDim.x * 8) {
    float* xr = x + (size_t)row * 1024;
    f32x4 v[4];
    float s = 0.f;
#pragma unroll
    for (int i = 0; i < 4; ++i) { v[i] = *(const f32x4*)(xr + (i * 64 + lane) * 4); s += v[i][0] + v[i][1] + v[i][2] + v[i][3]; }
    const float mean = wave_sum(s) * (1.f / 1024.f);
    float q = 0.f;
#pragma unroll
    for (int i = 0; i < 4; ++i)
#pragma unroll
      for (int j = 0; j < 4; ++j) { const float d = v[i][j] - mean; q += d * d; }
    const float rstd = rsqrtf(wave_sum(q) * (1.f / 1024.f) + 1e-5f);
#pragma unroll
    for (int i = 0; i < 4; ++i) {
      const int c = (i * 64 + lane) * 4;
      f32x4 gv = *(const f32x4*)(g + c), bv = *(const f32x4*)(bta + c), o;
#pragma unroll
      for (int j = 0; j < 4; ++j) o[j] = (v[i][j] - mean) * rstd * gv[j] + bv[j];
      *(f32x4*)(xr + c) = o;
      u32x2 ob = {pk2(o[0], o[1]), pk2(o[2], o[3])};
      *(u32x2*)(xb + (size_t)row * 1024 + c) = ob;
    }
  }
}

DI void cumsum_phase(const float* __restrict__ lf, float* __restrict__ c2, char* lds) {
  float* wt = (float*)lds;
  const int tid = tid_l(), lane = tid & 63, wave = tid >> 6;
  for (int row = blockIdx.x; row < 32; row += gridDim.x) {
    const float* src = lf + (size_t)row * SEQ + tid * 32;
    float v[32];
#pragma unroll
    for (int i = 0; i < 8; ++i) { f32x4 t = *(const f32x4*)(src + 4 * i); v[4 * i] = t[0]; v[4 * i + 1] = t[1]; v[4 * i + 2] = t[2]; v[4 * i + 3] = t[3]; }
    float run = 0.f;
#pragma unroll
    for (int i = 0; i < 32; ++i) { run += v[i]; v[i] = run; }
    float inc = run;
#pragma unroll
    for (int o = 1; o < 64; o <<= 1) { const float t = __shfl_up(inc, o, 64); if (lane >= o) inc += t; }
    if (lane == 63) wt[wave] = inc;
    __syncthreads();
    float pre = inc - run;
    for (int w = 0; w < wave; ++w) pre += wt[w];
    float* dst = c2 + (size_t)row * SEQ + tid * 32;
#pragma unroll
    for (int i = 0; i < 8; ++i) { f32x4 o = {(pre + v[4 * i]) * LOG2E, (pre + v[4 * i + 1]) * LOG2E, (pre + v[4 * i + 2]) * LOG2E, (pre + v[4 * i + 3]) * LOG2E}; *(f32x4*)(dst + 4 * i) = o; }
    __syncthreads();
  }
}

template <int DVT, bool FOX>
DI void attn_step(const char* kb, const bf16x8 (&qf)[4], f32x16 (&o)[DVT], float& m, float& l, const bool diag, const int j, const int tq, const int r, const int hh) {
  constexpr int VB = DVT * 32 * LROW;
  const char* vb = kb + 64 * LROW; const char* cb = vb + VB;
  f32x16 st[2];
  bf16x8 kf[8];
#pragma unroll
  for (int ks = 0; ks < 4; ++ks)
#pragma unroll
    for (int kt = 0; kt < 2; ++kt) kf[ks * 2 + kt] = *(const bf16x8*)(kb + (kt * 32 + r) * LROW + ks * 32 + hh * 16);
  if (FOX) {
#pragma unroll
    for (int kt = 0; kt < 2; ++kt)
#pragma unroll
      for (int g = 0; g < 4; ++g) {
        f32x4 cs = *(const f32x4*)(cb + (kt * 32 + 8 * g + 4 * hh) * 4);
        st[kt][4 * g] = cs[0]; st[kt][4 * g + 1] = cs[1]; st[kt][4 * g + 2] = cs[2]; st[kt][4 * g + 3] = cs[3];
      }
  } else {
#pragma unroll
    for (int kt = 0; kt < 2; ++kt)
#pragma unroll
      for (int i = 0; i < 16; ++i) st[kt][i] = 0.f;
  }
  __builtin_amdgcn_sched_barrier(0);
#pragma unroll
  for (int ks = 0; ks < 4; ++ks)
#pragma unroll
    for (int kt = 0; kt < 2; ++kt) st[kt] = MFMA32(kf[ks * 2 + kt], qf[ks], st[kt]);
  bf16x8 va[DVT], vn[DVT];
#pragma unroll
  for (int d = 0; d < DVT; ++d) va[d] = *(const bf16x8*)(vb + (d * 32 + r) * LROW + (8 * hh) * 2);
  __builtin_amdgcn_sched_barrier(0);
  {
    const f32x2 mm = {m, m};
#pragma unroll
    for (int kt = 0; kt < 2; ++kt)
#pragma unroll
      for (int i = 0; i < 8; ++i) { f32x2 z = {st[kt][2 * i], st[kt][2 * i + 1]}; z = z - mm; st[kt][2 * i] = z[0]; st[kt][2 * i + 1] = z[1]; }
  }
  if (FOX) {
    if (diag) {
#pragma unroll
      for (int kt = 0; kt < 2; ++kt)
#pragma unroll
        for (int i = 0; i < 16; ++i) {
          const int key = j * 64 + kt * 32 + (i & 3) + 8 * (i >> 2) + 4 * hh;
          if (key > tq) st[kt][i] = -INFINITY;
        }
    }
  }
  float mx;
  {
    float a0 = fmaxf(fmaxf(st[0][0], st[0][1]), st[0][2]), a1 = fmaxf(fmaxf(st[1][0], st[1][1]), st[1][2]);
#pragma unroll
    for (int i = 3; i < 15; i += 2) { a0 = fmaxf(fmaxf(a0, st[0][i]), st[0][i + 1]); a1 = fmaxf(fmaxf(a1, st[1][i]), st[1][i + 1]); }
    mx = fmaxf(fmaxf(a0, a1), fmaxf(st[0][15], st[1][15]));
  }
  mx = xmax32(mx);
  if (__any(diag || mx > 8.f)) {
    const float d = (diag || mx > 0.f) ? mx : 0.f;
    const float alpha = diag ? 0.f : __builtin_amdgcn_exp2f(-d);
    m += d;
    l *= alpha;
#pragma unroll
    for (int dd = 0; dd < DVT; ++dd)
#pragma unroll
      for (int i = 0; i < 16; ++i) o[dd][i] *= alpha;
    const f32x2 d2 = {d, d};
#pragma unroll
    for (int kt = 0; kt < 2; ++kt)
#pragma unroll
      for (int i = 0; i < 8; ++i) { f32x2 z = {st[kt][2 * i], st[kt][2 * i + 1]}; z = z - d2; st[kt][2 * i] = z[0]; st[kt][2 * i + 1] = z[1]; }
  }
  f32x2 ls2 = {0.f, 0.f};
#pragma unroll
  for (int kt = 0; kt < 2; ++kt)
#pragma unroll
    for (int i = 0; i < 8; ++i) {
      f32x2 pv = {__builtin_amdgcn_exp2f(st[kt][2 * i]), __builtin_amdgcn_exp2f(st[kt][2 * i + 1])};
      st[kt][2 * i] = pv[0]; st[kt][2 * i + 1] = pv[1];
      ls2 = ls2 + pv;
    }
  l += ls2[0] + ls2[1];
  __builtin_amdgcn_sched_barrier(0);
#define A_PVGROUP(GK, VC, VN) { constexpr int kt_ = (GK) >> 1, s2_ = (GK) & 1; \
    if ((GK) < 3) { constexpr int kt1_ = ((GK) + 1) >> 1, s21_ = ((GK) + 1) & 1; \
      _Pragma("unroll") for (int d = 0; d < DVT; ++d) VN[d] = *(const bf16x8*)(vb + (d * 32 + r) * LROW + (kt1_ * 32 + 16 * s21_ + 8 * hh) * 2); } \
    u32x4 pw_ = {pk2(st[kt_][8 * s2_], st[kt_][8 * s2_ + 1]), pk2(st[kt_][8 * s2_ + 2], st[kt_][8 * s2_ + 3]), pk2(st[kt_][8 * s2_ + 4], st[kt_][8 * s2_ + 5]), pk2(st[kt_][8 * s2_ + 6], st[kt_][8 * s2_ + 7])}; \
    const bf16x8 pf_ = __builtin_bit_cast(bf16x8, pw_); \
    __builtin_amdgcn_sched_barrier(0); \
    _Pragma("unroll") for (int d = 0; d < DVT; ++d) o[d] = MFMA32(VC[d], pf_, o[d]); \
    __builtin_amdgcn_sched_barrier(0); }
  A_PVGROUP(0, va, vn); A_PVGROUP(1, vn, va); A_PVGROUP(2, va, vn); A_PVGROUP(3, vn, va);
#undef A_PVGROUP
}

template <int DVT, bool FOX>
DI void attn_pass(const bf16_t* __restrict__ qrow, const bf16_t* __restrict__ kbase, const int ldk, const bf16_t* __restrict__ vtbase,
                  const float* __restrict__ cbase, const int j_hi, const int my_last, const int j_lo_diag, const int tq, const float prune_c,
                  f32x16 (&o)[DVT], float& l_out, char* lds) {
  constexpr int VB = DVT * 32 * LROW;
  constexpr int STAGE = 64 * LROW + VB + 256;
  const int tid = tid_l(), lane = tid & 63;
  const int r = lane & 31, hh = lane >> 5;
  const int lrow = tid >> 3, lch = tid & 7;
  bf16x8 qf[4];
#pragma unroll
  for (int ks = 0; ks < 4; ++ks) qf[ks] = *(const bf16x8*)(qrow + ks * 16 + hh * 8);
#pragma unroll
  for (int d = 0; d < DVT; ++d)
#pragma unroll
    for (int i = 0; i < 16; ++i) o[d][i] = 0.f;
  float m = 0.f, l = 0.f;
  u32x4 kr0, kr1, vr0[DVT / 2], vr1[DVT / 2]; f32x4 cr0 = {0.f, 0.f, 0.f, 0.f}, cr1 = {0.f, 0.f, 0.f, 0.f};
  const unsigned koff = (unsigned)(lrow * ldk + lch * 8) * 2u, voff = (unsigned)(lrow * SEQ + lch * 8) * 2u;
#define A_GLOAD(KR, VR, CR, JT) { const int s1_ = (JT) * 64; KR = *(const u32x4*)((const char*)kbase + (size_t)s1_ * ldk * 2 + koff); \
    _Pragma("unroll") for (int i_ = 0; i_ < DVT / 2; ++i_) VR[i_] = *(const u32x4*)((const char*)vtbase + ((size_t)(64 * i_) * SEQ + s1_) * 2 + voff); \
    if (FOX) { if (tid < 16) { f32x4 t_ = *(const f32x4*)(cbase + s1_ + tid * 4); CR[0] = -t_[0]; CR[1] = -t_[1]; CR[2] = -t_[2]; CR[3] = -t_[3]; } } }
#define A_LSTORE(KR, VR, CR, STG) { char* kb_ = lds + (STG) * STAGE; char* vb_ = kb_ + 64 * LROW; char* cb_ = vb_ + VB; \
    *(u32x4*)(kb_ + lrow * LROW + lch * 16) = KR; \
    _Pragma("unroll") for (int i_ = 0; i_ < DVT / 2; ++i_) *(u32x4*)(vb_ + (lrow + 64 * i_) * LROW + lch * 16) = VR[i_]; \
    if (FOX) { if (tid < 16) *(f32x4*)(cb_ + tid * 16) = CR; } }
#define A_PRUNE(STG) (FOX && j < j_lo_diag && (prune_c + *(const float*)(lds + (STG) * STAGE + 64 * LROW + VB + 63 * 4) < -160.f))
  int j = j_hi;
  A_GLOAD(kr0, vr0, cr0, j);
  if (j >= 1) A_GLOAD(kr1, vr1, cr1, j - 1);
  A_LSTORE(kr0, vr0, cr0, 0);
  __syncthreads();
  for (;;) {
    if (A_PRUNE(0)) break;
    if (j >= 2) A_GLOAD(kr0, vr0, cr0, j - 2);
    if (j <= my_last) attn_step<DVT, FOX>(lds, qf, o, m, l, j == my_last, j, tq, r, hh);
    if (j == 0) break;
    A_LSTORE(kr1, vr1, cr1, 1);
    __syncthreads();
    --j;
    if (A_PRUNE(1)) break;
    if (j >= 2) A_GLOAD(kr1, vr1, cr1, j - 2);
    if (j <= my_last) attn_step<DVT, FOX>(lds + STAGE, qf, o, m, l, j == my_last, j, tq, r, hh);
    if (j == 0) break;
    A_LSTORE(kr0, vr0, cr0, 0);
    __syncthreads();
    --j;
  }
  __syncthreads();
#undef A_GLOAD
#undef A_LSTORE
#undef A_PRUNE
  l_out = xsum32(l);
}

DI void fox_phase(const Params& p, const int j_odd, char* lds) {
  char* ws = (char*)launder(p.ws);
  const bf16_t* fq = (const bf16_t*)(ws + OFF_R1);
  const bf16_t* fk = (const bf16_t*)(ws + OFF_R1 + 64 * MiB);
  const bf16_t* fvT = (const bf16_t*)(ws + OFF_R1 + 128 * MiB);
  const bf16_t* fg = (const bf16_t*)(ws + OFF_R1 + 192 * MiB);
  const float* c2 = (const float*)(ws + OFF_C2);
  bf16_t* ab = (bf16_t*)(ws + OFF_AB);
  const float b2 = ((const float*)(ws + OFF_MISC))[1032 + j_odd];
  const int tid = tid_l(); const int lane = tid & 63, wave = __builtin_amdgcn_readfirstlane(tid >> 6), r = lane & 31, hh = lane >> 5;
  for (int rnd = 0; rnd < 4; ++rnd) {
    const int bh = rnd * 8 + (blockIdx.x & 7), pp = blockIdx.x >> 3, b = bh >> 4, h = bh & 15;
    for (int half = 0; half < 2; ++half) {
      const int qb = half == 0 ? 63 - pp : pp;
      const int t0 = qb * 256, tq0 = t0 + wave * 32, tq = tq0 + r;
      const int nkv = (t0 + 256) >> 6, my_last = (tq0 + 31) >> 6;
      const float prune_c = b2 + c2[(size_t)bh * SEQ + t0];
      f32x16 o[2]; float l;
      attn_pass<2, true>(fq + (size_t)(b * SEQ + tq) * 1024 + h * 64, fk + (size_t)(b * SEQ) * 1024 + h * 64, 1024,
                         fvT + (size_t)(bh * 64) * SEQ, c2 + (size_t)bh * SEQ, nkv - 1, my_last, t0 >> 6, tq, prune_c, o, l, lds);
      const float inv = 1.f / l;
      const size_t rowo = (size_t)(b * SEQ + tq) * 1024 + h * 64;
#pragma unroll
      for (int d = 0; d < 2; ++d)
#pragma unroll
        for (int g = 0; g < 4; ++g) {
          const int c = d * 32 + 8 * g + 4 * hh;
          u32x2 gv = *(const u32x2*)(fg + rowo + c);
          const float g0 = __uint_as_float(gv[0] << 16), g1 = __uint_as_float(gv[0] & 0xffff0000u), g2 = __uint_as_float(gv[1] << 16), g3 = __uint_as_float(gv[1] & 0xffff0000u);
          u32x2 ov = {pk2(o[d][4 * g] * inv * g0, o[d][4 * g + 1] * inv * g1), pk2(o[d][4 * g + 2] * inv * g2, o[d][4 * g + 3] * inv * g3)};
          *(u32x2*)(ab + rowo + c) = ov;
        }
    }
  }
}

DI void diff_phase(const Params& p, const int j_even, char* lds) {
  char* ws = (char*)launder(p.ws);
  const bf16_t* bq = (const bf16_t*)(ws + OFF_R1 + 160 * MiB);
  const bf16_t* bk = (const bf16_t*)(ws + OFF_R1 + 192 * MiB);
  const bf16_t* bvT = (const bf16_t*)(ws + OFF_R1 + 224 * MiB);
  bf16_t* ab = (bf16_t*)(ws + OFF_AB);
  const float* misc = (const float*)(ws + OFF_MISC);
  const float lam = misc[1024 + j_even];
  const float lam_init = 0.8f - 0.6f * expf(-0.3f * (float)(2 * j_even));
  const float* dg = ((const float*)p.diff_g) + j_even * 128;
  const int tid = tid_l(); const int lane = tid & 63, wave = __builtin_amdgcn_readfirstlane(tid >> 6), r = lane & 31, hh = lane >> 5;
  {
    const int bh = blockIdx.x & 7, pp = blockIdx.x >> 3, b = bh >> 2, h = bh & 3;
    for (int half = 0; half < 2; ++half) {
      const int qb = half == 0 ? 63 - pp : pp;
      const int t0 = qb * 256, tq0 = t0 + wave * 32, tq = tq0 + r;
      const int nkv = (t0 + 256) >> 6, my_last = tq0 >> 6;
      f32x16 o1[4], o2[4]; float l1, l2;
      attn_pass<4, false>(bq + (size_t)(b * SEQ + tq) * 512 + h * 128, bk + (size_t)(b * SEQ) * 512 + h * 128, 512,
                          bvT + (size_t)(bh * 128) * SEQ, nullptr, nkv - 1, my_last, 0, tq, 0.f, o1, l1, lds);
      const float i1 = 1.f / l1;
      unsigned* o1s = (unsigned*)(lds + DIFF_STASH_OFF) + tid;
#pragma unroll
      for (int d = 0; d < 4; ++d)
#pragma unroll
        for (int i = 0; i < 8; ++i) o1s[(d * 8 + i) * 512] = pk2(o1[d][2 * i] * i1, o1[d][2 * i + 1] * i1);
      attn_pass<4, false>(bq + (size_t)(b * SEQ + tq) * 512 + h * 128 + 64, bk + (size_t)(b * SEQ) * 512 + h * 128 + 64, 512,
                          bvT + (size_t)(bh * 128) * SEQ, nullptr, nkv - 1, my_last, 0, tq, 0.f, o2, l2, lds);
      const float i2 = lam / l2;
      float ssq = 0.f;
#pragma unroll
      for (int d = 0; d < 4; ++d)
#pragma unroll
        for (int i = 0; i < 8; ++i) {
          const unsigned pw = o1s[(d * 8 + i) * 512];
          const float va = __uint_as_float(pw << 16) - i2 * o2[d][2 * i], vb = __uint_as_float(pw & 0xffff0000u) - i2 * o2[d][2 * i + 1];
          o2[d][2 * i] = va; o2[d][2 * i + 1] = vb; ssq += va * va + vb * vb; }
      ssq = xsum32(ssq);
      const float rs = rsqrtf(ssq * (1.f / 128.f) + 1e-6f) * (1.f - lam_init);
      const size_t rowo = (size_t)(b * SEQ + tq) * 1024 + 512 + h * 128;
#pragma unroll
      for (int d = 0; d < 4; ++d)
#pragma unroll
        for (int g = 0; g < 4; ++g) {
          const int c = d * 32 + 8 * g + 4 * hh;
          f32x4 gv = *(const f32x4*)(dg + c);
          u32x2 ov = {pk2(o2[d][4 * g] * rs * gv[0], o2[d][4 * g + 1] * rs * gv[1]), pk2(o2[d][4 * g + 2] * rs * gv[2], o2[d][4 * g + 3] * rs * gv[3])};
          *(u32x2*)(ab + rowo + c) = ov;
        }
    }
  }
}

DI void hgrn_stageA(const Params& p, char* lds) {
  char* ws = (char*)launder(p.ws);
  const float* alf = (const float*)(ws + OFF_R1 + 32 * MiB);
  const bf16_t* aiT = (const bf16_t*)(ws + OFF_R1 + 96 * MiB);
  bf16_t* UT = (bf16_t*)(ws + OFF_UT);
  float* dbuf = (float*)(ws + OFF_DB);
  float* lfT = (float*)lds;
  float* part = (float*)(lds + 32768);
  char* KT = lds + 34816;
  char* IT = KT + 18432;
  const int tid = tid_l(), lane = tid & 63, wave = tid >> 6, r = lane & 31, hh = lane >> 5;
  f32x4 lfr[4]; u32x4 itr[2];
#define HA_FETCH(TASK) { const int bh_ = (TASK) >> 8, c_ = (TASK) & 255, tok0_ = (bh_ >> 2) * SEQ + c_ * 64, h_ = bh_ & 3; \
    _Pragma("unroll") for (int i = 0; i < 4; ++i) { const int idx = tid + 512 * i, row = idx >> 5, c4 = idx & 31; \
      lfr[i] = *(const f32x4*)(alf + (size_t)(tok0_ + row) * 512 + h_ * 128 + c4 * 4); } \
    _Pragma("unroll") for (int i = 0; i < 2; ++i) { const int idx = tid + 512 * i, row = idx >> 3, ch = idx & 7; \
      itr[i] = *(const u32x4*)(aiT + (size_t)(bh_ * 128 + row) * SEQ + c_ * 64 + ch * 8); } }
  if (blockIdx.x < 2048) HA_FETCH(blockIdx.x);
  for (int task = blockIdx.x; task < 2048; task += gridDim.x) {
    const int bh = task >> 8, c = task & 255;
#pragma unroll
    for (int i = 0; i < 4; ++i) { const int idx = tid + 512 * i, row = idx >> 5, c4 = idx & 31; *(f32x4*)(lfT + row * 128 + c4 * 4) = lfr[i]; }
#pragma unroll
    for (int i = 0; i < 2; ++i) { const int idx = tid + 512 * i, row = idx >> 3, ch = idx & 7; *(u32x4*)(IT + row * LROW + ch * 16) = itr[i]; }
    if (task + (int)gridDim.x < 2048) HA_FETCH(task + (int)gridDim.x);
    (void)bh; (void)c;
    __syncthreads();
    const int k = tid & 127, seg = tid >> 7;
    float lv[16], bv[16];
    float run = 0.f;
#pragma unroll
    for (int i = 0; i < 16; ++i) { lv[i] = lfT[(seg * 16 + i) * 128 + k]; run += lv[i]; bv[i] = run; }
    part[seg * 128 + k] = run;
    __syncthreads();
    float pre = 0.f, tot = 0.f;
#pragma unroll
    for (int s2 = 0; s2 < 4; ++s2) { const float pv = part[s2 * 128 + k]; if (s2 < seg) pre += pv; tot += pv; }
    {
      float kv[16];
#pragma unroll
      for (int i = 0; i < 16; ++i) kv[i] = (1.f - __expf(lv[i])) * __expf(tot - (pre + bv[i]));
      u32x4 w0 = {pk2(kv[0], kv[1]), pk2(kv[2], kv[3]), pk2(kv[4], kv[5]), pk2(kv[6], kv[7])};
      u32x4 w1 = {pk2(kv[8], kv[9]), pk2(kv[10], kv[11]), pk2(kv[12], kv[13]), pk2(kv[14], kv[15])};
      *(u32x4*)(KT + k * LROW + seg * 32) = w0;
      *(u32x4*)(KT + k * LROW + seg * 32 + 16) = w1;
    }
    if (seg == 0) dbuf[(size_t)task * 128 + k] = __expf(tot);
    __syncthreads();
    {
      const int ktile = wave & 3, vhalf = wave >> 2;
      f32x16 acc[2];
#pragma unroll
      for (int vt = 0; vt < 2; ++vt)
#pragma unroll
        for (int i = 0; i < 16; ++i) acc[vt][i] = 0.f;
#pragma unroll
      for (int ks = 0; ks < 4; ++ks) {
        bf16x8 a = *(const bf16x8*)(KT + (ktile * 32 + r) * LROW + ks * 32 + hh * 16);
#pragma unroll
        for (int vt = 0; vt < 2; ++vt) {
          bf16x8 bb = *(const bf16x8*)(IT + (vhalf * 64 + vt * 32 + r) * LROW + ks * 32 + hh * 16);
          acc[vt] = MFMA32(a, bb, acc[vt]);
        }
      }
#pragma unroll
      for (int vt = 0; vt < 2; ++vt) {
        bf16_t* dst = UT + ((size_t)task * 128 + vhalf * 64 + vt * 32 + r) * 128 + ktile * 32 + 4 * hh;
#pragma unroll
        for (int g = 0; g < 4; ++g) { u32x2 ov = {pk2(acc[vt][4 * g], acc[vt][4 * g + 1]), pk2(acc[vt][4 * g + 2], acc[vt][4 * g + 3])}; *(u32x2*)(dst + 8 * g) = ov; }
      }
    }
    __syncthreads();
  }
}

#undef HA_FETCH
DI void hgrn_scan(const Params& p) {
  char* ws = (char*)launder(p.ws);
  bf16_t* UT = (bf16_t*)(ws + OFF_UT);
  const float* dbuf = (const float*)(ws + OFF_DB);
  const int gid = blockIdx.x * 512 + tid_l();
  if (gid >= 8 * 16384) return;
  const int bh = gid >> 14, e = gid & 16383;
  bf16_t* up = UT + (size_t)bh * 256 * 16384 + e;
  const float* dp = dbuf + (size_t)bh * 256 * 128 + (e & 127);
  float st = 0.f;
  for (int c0 = 0; c0 < 256; c0 += 32) {
    bf16_t u[32]; float dv[32];
#pragma unroll
    for (int i = 0; i < 32; ++i) { u[i] = up[(size_t)(c0 + i) * 16384]; dv[i] = dp[(size_t)(c0 + i) * 128]; }
#pragma unroll
    for (int i = 0; i < 32; ++i) {
      up[(size_t)(c0 + i) * 16384] = f2bf(st);
      st = dv[i] * st + bf2f(u[i]);
    }
  }
}

constexpr int QROW = 272;
DI void hgrn_stageC(const Params& p, const int j_even, char* lds) {
  char* ws = (char*)launder(p.ws);
  const bf16_t* aq = (const bf16_t*)(ws + OFF_R1);
  const float* alf = (const float*)(ws + OFF_R1 + 32 * MiB);
  const bf16_t* aiT = (const bf16_t*)(ws + OFF_R1 + 96 * MiB);
  const bf16_t* ag = (const bf16_t*)(ws + OFF_R1 + 128 * MiB);
  const bf16_t* UT = (const bf16_t*)(ws + OFF_UT);
  bf16_t* ab = (bf16_t*)(ws + OFF_AB);
  const float* hg = ((const float*)p.hgrn_g) + j_even * 128;
  float* lfT = (float*)lds;
  char* ST = lds;
  char* Q1 = lds + 34816;
  char* Q2 = Q1 + 64 * QROW;
  char* K2 = Q2 + 64 * QROW;
  char* IT = K2 + 64 * QROW;
  float* part = (float*)(IT + 128 * LROW);
  const int tid = tid_l(), lane = tid & 63, wave = tid >> 6, r = lane & 31, hh = lane >> 5;
  f32x4 lfr[4]; u32x4 itr[2]; bf16_t qr[16];
#define HC_FETCH(TASK) { const int bh_ = (TASK) >> 8, c_ = (TASK) & 255, tok0_ = (bh_ >> 2) * SEQ + c_ * 64, h_ = bh_ & 3; \
    _Pragma("unroll") for (int i = 0; i < 4; ++i) { const int idx = tid + 512 * i, row = idx >> 5, c4 = idx & 31; \
      lfr[i] = *(const f32x4*)(alf + (size_t)(tok0_ + row) * 512 + h_ * 128 + c4 * 4); } \
    _Pragma("unroll") for (int i = 0; i < 2; ++i) { const int idx = tid + 512 * i, row = idx >> 3, ch = idx & 7; \
      itr[i] = *(const u32x4*)(aiT + (size_t)(bh_ * 128 + row) * SEQ + c_ * 64 + ch * 8); } \
    _Pragma("unroll") for (int i = 0; i < 16; ++i) qr[i] = aq[(size_t)(tok0_ + (tid >> 7) * 16 + i) * 512 + h_ * 128 + (tid & 127)]; }
  if (blockIdx.x < 2048) HC_FETCH(blockIdx.x);
  for (int task = blockIdx.x; task < 2048; task += gridDim.x) {
    const int bh = task >> 8, c = task & 255, b = bh >> 2, h = bh & 3;
    const int tok0 = b * SEQ + c * 64;
#pragma unroll
    for (int i = 0; i < 4; ++i) { const int idx = tid + 512 * i, row = idx >> 5, c4 = idx & 31; *(f32x4*)(lfT + row * 128 + c4 * 4) = lfr[i]; }
#pragma unroll
    for (int i = 0; i < 2; ++i) { const int idx = tid + 512 * i, row = idx >> 3, ch = idx & 7; *(u32x4*)(IT + row * LROW + ch * 16) = itr[i]; }
    float qcur[16];
#pragma unroll
    for (int i = 0; i < 16; ++i) qcur[i] = bf2f(qr[i]);
    u32x4 sreg[4];
#pragma unroll
    for (int i = 0; i < 4; ++i) sreg[i] = *(const u32x4*)(UT + (size_t)task * 16384 + (size_t)(tid + 512 * i) * 8);
    if (task + (int)gridDim.x < 2048) HC_FETCH(task + (int)gridDim.x);
    __syncthreads();
    const int k = tid & 127, seg = tid >> 7;
    float lv[16], bv[16];
    float run = 0.f;
#pragma unroll
    for (int i = 0; i < 16; ++i) { lv[i] = lfT[(seg * 16 + i) * 128 + k]; run += lv[i]; bv[i] = run; }
    part[seg * 128 + k] = run;
    __syncthreads();
    {
      const float p0 = part[k], p1 = part[128 + k], p2 = part[256 + k];
      const float pre = (seg > 0 ? p0 : 0.f) + (seg > 1 ? p1 : 0.f) + (seg > 2 ? p2 : 0.f);
      const float bmid = p0 + p1;
#pragma unroll
      for (int i = 0; i < 16; ++i) {
        const int t = seg * 16 + i;
        const float bt = pre + bv[i];
        const float qv = qcur[i];
        const float kk = 1.f - __expf(lv[i]);
        *(bf16_t*)(Q1 + t * QROW + k * 2) = f2bf(qv * __expf(bt));
        *(bf16_t*)(Q2 + t * QROW + k * 2) = f2bf(qv * __expf(fminf(bt - bmid, 80.f)));
        *(bf16_t*)(K2 + t * QROW + k * 2) = f2bf(kk * __expf(fminf(bmid - bt, 80.f)));
      }
    }
#pragma unroll
    for (int i = 0; i < 4; ++i) { const int idx = tid + 512 * i, row = idx >> 4, ch = idx & 15; *(u32x4*)(ST + row * QROW + ch * 16) = sreg[i]; }
    __syncthreads();
    {
      const int vt = wave & 3, tt = wave >> 2;
      const int t = tt * 32 + r;
      f32x16 sc[2];
#pragma unroll
      for (int st = 0; st < 2; ++st)
#pragma unroll
        for (int i = 0; i < 16; ++i) sc[st][i] = 0.f;
#pragma unroll
      for (int ks = 0; ks < 8; ++ks) {
        bf16x8 qb = *(const bf16x8*)(Q2 + t * QROW + ks * 32 + hh * 16);
#pragma unroll
        for (int st = 0; st < 2; ++st) {
          if (st <= tt) {
            bf16x8 a = *(const bf16x8*)(K2 + (st * 32 + r) * QROW + ks * 32 + hh * 16);
            sc[st] = MFMA32(a, qb, sc[st]);
          }
        }
      }
      f32x16 acc;
#pragma unroll
      for (int i = 0; i < 16; ++i) acc[i] = 0.f;
#pragma unroll
      for (int st = 0; st < 2; ++st) {
        if (st <= tt) {
#pragma unroll
          for (int i = 0; i < 16; ++i) { const int s = st * 32 + (i & 3) + 8 * (i >> 2) + 4 * hh; if (s > t) sc[st][i] = 0.f; }
#pragma unroll
          for (int s2 = 0; s2 < 2; ++s2) {
            u32x4 pw = {pk2(sc[st][8 * s2], sc[st][8 * s2 + 1]), pk2(sc[st][8 * s2 + 2], sc[st][8 * s2 + 3]), pk2(sc[st][8 * s2 + 4], sc[st][8 * s2 + 5]), pk2(sc[st][8 * s2 + 6], sc[st][8 * s2 + 7])};
            const bf16x8 pf = __builtin_bit_cast(bf16x8, pw);
            const char* ip = IT + (vt * 32 + r) * LROW + (st * 32 + 16 * s2 + 4 * hh) * 2;
            u32x2 lo = *(const u32x2*)ip, hi = *(const u32x2*)(ip + 16);
            u32x4 aw = {lo[0], lo[1], hi[0], hi[1]};
            acc = MFMA32(__builtin_bit_cast(bf16x8, aw), pf, acc);
          }
        }
      }
#pragma unroll
      for (int ks = 0; ks < 8; ++ks) {
        bf16x8 a = *(const bf16x8*)(ST + (vt * 32 + r) * QROW + ks * 32 + hh * 16);
        bf16x8 qb = *(const bf16x8*)(Q1 + t * QROW + ks * 32 + hh * 16);
        acc = MFMA32(a, qb, acc);
      }
      float ssq = 0.f;
#pragma unroll
      for (int i = 0; i < 16; ++i) ssq += acc[i] * acc[i];
      ssq = xsum32(ssq);
      if (hh == 0) part[vt * 64 + t] = ssq;
      __syncthreads();
      const float tot = part[t] + part[64 + t] + part[128 + t] + part[192 + t];
      const float rs = rsqrtf(tot * (1.f / 128.f) + 1e-6f);
      const size_t go = (size_t)(tok0 + t) * 512 + h * 128 + vt * 32 + 4 * hh;
      const size_t oo = (size_t)(tok0 + t) * 1024 + h * 128 + vt * 32 + 4 * hh;
#pragma unroll
      for (int g = 0; g < 4; ++g) {
        f32x4 gn = *(const f32x4*)(hg + vt * 32 + 4 * hh + 8 * g);
        u32x2 gv = *(const u32x2*)(ag + go + 8 * g);
        const float g0 = __uint_as_float(gv[0] << 16), g1 = __uint_as_float(gv[0] & 0xffff0000u), g2 = __uint_as_float(gv[1] << 16), g3 = __uint_as_float(gv[1] & 0xffff0000u);
        u32x2 ov = {pk2(acc[4 * g] * rs * gn[0] * g0, acc[4 * g + 1] * rs * gn[1] * g1), pk2(acc[4 * g + 2] * rs * gn[2] * g2, acc[4 * g + 3] * rs * gn[3] * g3)};
        *(u32x2*)(ab + oo + 8 * g) = ov;
      }
    }
    __syncthreads();
  }
}

#undef HC_FETCH
DI void grid_barrier(unsigned* ctr, const unsigned target) {
  asm volatile("s_waitcnt vmcnt(0)" ::: "memory");
  __syncthreads();
  if (threadIdx.x == 0) {
    __builtin_amdgcn_fence(__ATOMIC_RELEASE, "agent");
    asm volatile("s_waitcnt vmcnt(0)" ::: "memory");
    __hip_atomic_fetch_add((GAS unsigned*)ctr, 1u, __ATOMIC_RELAXED, __HIP_MEMORY_SCOPE_AGENT);
    while (__hip_atomic_load((GAS unsigned*)ctr, __ATOMIC_RELAXED, __HIP_MEMORY_SCOPE_AGENT) < target) __builtin_amdgcn_s_sleep(1);
    __builtin_amdgcn_fence(__ATOMIC_ACQUIRE, "agent");
    asm volatile("s_waitcnt vmcnt(0)" ::: "memory");
  }
  __syncthreads();
}
typedef const __attribute__((address_space(4))) Params* kparams_t;
#if defined(__HIP_DEVICE_COMPILE__)
DI kparams_t launder_k(kparams_t q) { asm volatile("" : "+s"(q)); return q; }
#endif
#if defined(__HIP_DEVICE_COMPILE__)
#define KPARAMS (*launder_k((kparams_t)__builtin_amdgcn_kernarg_segment_ptr()))
#else
#define KPARAMS p_arg
#endif
__global__ void __launch_bounds__(512) fwd_mega(Params p_arg) {
  extern __shared__ __attribute__((aligned(16))) char lds[];
  int ph = 0;
  const int p_lo = p_arg.lo, p_hi = p_arg.hi;
#define PHASE(id, ...) { if (ph >= p_lo && ph < p_hi) { const Params p = KPARAMS; char* ws = (char*)launder(p.ws); float* outp = (float*)launder((GAS char*)p.out); bf16_t* ab = (bf16_t*)(ws + OFF_AB); (void)outp; (void)ab; \
    if (ONLY < 0 || ONLY == id) { __VA_ARGS__; } if ((DUPMASK >> id) & 1) { __syncthreads(); __VA_ARGS__; } if (ph + 1 < p_hi) { if (ph == p_lo) cg::this_grid().sync(); else grid_barrier((unsigned*)(ws + OFF_CNT) + 256, (unsigned)(ph - p_lo) * gridDim.x); } } ++ph; }
  PHASE(0, phase0(p, lds));
  for (int l = 0; l < 4; ++l) {
    const int j = l >> 1;
    if ((l & 1) == 0) {
      PHASE(1,
        EpiEvenIn e;
        e.r1 = ws + OFF_R1; e.lb = (const float*)(ws + OFF_MISC) + j * 512;
        gemm_phase(ab, 1024, (const bf16_t*)(ws + OFF_WEI) + (size_t)j * EVEN_IN * D, EVEN_IN, D, e, lds));
      PHASE(2, hgrn_stageA(p, lds));
      PHASE(3, hgrn_scan(p));
      PHASE(4, hgrn_stageC(p, j, lds); diff_phase(p, j, lds));
      PHASE(6,
        EpiResLN er; er.xin = (l == 0) ? (const float*)launder((GAS char*)p.x_in) : outp; er.xout = outp; er.xb = ab;
        er.g = ((const float*)p.ln1g) + l * D; er.b = ((const float*)p.ln1b) + l * D;
        er.xchg = (float*)(ws + OFF_XCHG); er.cnt = (unsigned*)(ws + OFF_CNT); er.target = 4u * (unsigned)(2 * l + 1);
        gemm_phase(ab, 1024, (const bf16_t*)(ws + OFF_WEO) + (size_t)j * D * D, D, D, er, lds));
    } else {
      PHASE(7,
        EpiOddIn e;
        e.r1 = ws + OFF_R1;
        e.lf = (float*)(ws + OFF_LF); e.qg = ((const float*)p.fox_qg) + j * 64; e.kg = ((const float*)p.fox_kg) + j * 64; e.bf = ((const float*)p.fox_bf) + j * 16;
        gemm_phase(ab, 1024, (const bf16_t*)(ws + OFF_WFI) + (size_t)j * ODD_PAD * D, ODD_PAD, D, e, lds));
      PHASE(8, cumsum_phase((const float*)(ws + OFF_LF), (float*)(ws + OFF_C2), lds));
      PHASE(9, fox_phase(p, j, lds));
      PHASE(6,
        EpiResLN er; er.xin = outp; er.xout = outp; er.xb = ab;
        er.g = ((const float*)p.ln1g) + l * D; er.b = ((const float*)p.ln1b) + l * D;
        er.xchg = (float*)(ws + OFF_XCHG); er.cnt = (unsigned*)(ws + OFF_CNT); er.target = 4u * (unsigned)(2 * l + 1);
        gemm_phase(ab, 1024, (const bf16_t*)(ws + OFF_WFO) + (size_t)j * D * D, D, D, er, lds));
    }
    PHASE(11,
      EpiW1 e1; e1.act = (bf16_t*)(ws + OFF_R1);
      gemm_phase(ab, 1024, (const bf16_t*)(ws + OFF_W1) + (size_t)l * 2 * DFF * D, 2 * DFF, D, e1, lds));
    PHASE(6,
      EpiResLN e2; e2.xin = outp; e2.xout = outp; e2.xb = ab;
      e2.g = ((const float*)p.ln2g) + l * D; e2.b = ((const float*)p.ln2b) + l * D;
      e2.xchg = (float*)(ws + OFF_XCHG); e2.cnt = (unsigned*)(ws + OFF_CNT); e2.target = 4u * (unsigned)(2 * l + 2);
      gemm_phase((const bf16_t*)(ws + OFF_R1), DFF, (const bf16_t*)(ws + OFF_W2) + (size_t)l * D * DFF, D, DFF, e2, lds));
  }
#undef PHASE
}
constexpr int N_PHASES = 1 + 2 * 7 + 2 * 6;

extern "C" void kernel_launch(void* const* d_in, const int* in_sizes, int n_in, void* d_out, int out_size, void* d_ws, size_t ws_size, hipStream_t stream) {
  static bool attr = false;
  if (!attr) { hipFuncSetAttribute((const void*)fwd_mega, hipFuncAttributeMaxDynamicSharedMemorySize, LDS_BYTES); attr = true; }
  Params p{};
  p.x_in = (const GAS float*)d_in[0];
  p.even_w_in = (const GAS float*)d_in[1]; p.even_w_out = (const GAS float*)d_in[2]; p.lb_logits = (const GAS float*)d_in[3];
  p.lq1 = (const GAS float*)d_in[4]; p.lk1 = (const GAS float*)d_in[5]; p.lq2 = (const GAS float*)d_in[6]; p.lk2 = (const GAS float*)d_in[7];
  p.hgrn_g = (const GAS float*)d_in[8]; p.diff_g = (const GAS float*)d_in[9];
  p.fox_w_in = (const GAS float*)d_in[10]; p.fox_w_out = (const GAS float*)d_in[11]; p.fox_bf = (const GAS float*)d_in[12];
  p.fox_qg = (const GAS float*)d_in[13]; p.fox_kg = (const GAS float*)d_in[14];
  p.w1 = (const GAS float*)d_in[15]; p.w2 = (const GAS float*)d_in[16];
  p.ln1g = (const GAS float*)d_in[17]; p.ln1b = (const GAS float*)d_in[18]; p.ln2g = (const GAS float*)d_in[19]; p.ln2b = (const GAS float*)d_in[20];
  p.out = (GAS float*)d_out; p.ws = (GAS char*)d_ws;
#if COOP
  p.lo = 0; p.hi = N_PHASES;
  void* args[] = {&p};
  hipError_t e = hipLaunchCooperativeKernel((const void*)fwd_mega, dim3(256), dim3(512), args, LDS_BYTES, stream);
  if (e != hipSuccess) fprintf(stderr, "cooperative launch failed: %s\n", hipGetErrorString(e));
#else
  for (int ph = 0; ph < N_PHASES; ++ph) {
    p.lo = ph; p.hi = ph + 1;
    hipLaunchKernelGGL(fwd_mega, dim3(256), dim3(512), LDS_BYTES, stream, p);
  }
#endif
}
```
